# Optimizing an MI355X kernel written in HIP

```python
import jax, jax.numpy as jnp
from jax import lax
import numpy as np

D_MODEL = 1024
BATCH = 8
SEQ = 4096
DEPTH = 4

RET_HEADS = 4
RET_HEAD_DIM = 128
RET_WIDTH = RET_HEADS * RET_HEAD_DIM
POOL_WINDOWS = (2, 4, 8, 16)
POOL_GROUPS = len(POOL_WINDOWS)
POOL_WIDTH = D_MODEL - RET_WIDTH
POOL_GROUP_CH = POOL_WIDTH // POOL_GROUPS
POOL_MAX_W = max(POOL_WINDOWS)
MIX_WIDTH = RET_WIDTH + POOL_WIDTH
IN_WIDTH = 4 * RET_WIDTH + POOL_WIDTH
CHUNK = 128
ROPE_BASE = 10000.0
D_FF = ((8 * D_MODEL // 3 + 255) // 256) * 256
PLE_DIM = 256
EPS = 1e-6

kernel_name = "hybrid_retention_pool_swiglu_ple"


def rmsnorm(x, g):
    xf = x.astype(jnp.float32)
    y = xf * lax.rsqrt(jnp.mean(xf * xf, axis=-1, keepdims=True) + EPS)
    return (y * g.astype(jnp.float32)).astype(x.dtype)


def rotary(x, positions):
    half = RET_HEAD_DIM // 2
    inv = 1.0 / (ROPE_BASE ** (jnp.arange(half, dtype=jnp.float32) * (2.0 / RET_HEAD_DIM)))
    ang = positions.astype(jnp.float32)[..., None] * inv
    cos = jnp.cos(ang)[:, :, None, :]
    sin = jnp.sin(ang)[:, :, None, :]
    xf = x.astype(jnp.float32)
    x1, x2 = xf[..., :half], xf[..., half:]
    return jnp.concatenate([x1 * cos - x2 * sin, x2 * cos + x1 * sin], axis=-1)


def retention(q, k, v, g):
    B, S, H, Dh = q.shape
    N = S // CHUNK
    log_gamma = jnp.log1p(-(2.0 ** (-5.0 - jnp.arange(H, dtype=jnp.float32))))
    qc = (q * (Dh ** -0.5)).reshape(B, N, CHUNK, H, Dh)
    kc = k.reshape(B, N, CHUNK, H, Dh)
    vc = v.astype(jnp.float32).reshape(B, N, CHUNK, H, Dh)
    idx = jnp.arange(CHUNK, dtype=jnp.float32)
    rel = idx[:, None] - idx[None, :]
    decay_in = jnp.where(rel[None] >= 0,
                         jnp.exp(jnp.maximum(rel, 0.0)[None] * log_gamma[:, None, None]), 0.0)
    scores = jnp.einsum('bnqhd,bnkhd->bnhqk', qc, kc) * decay_in[None, None]
    inner = jnp.einsum('bnhqk,bnkhd->bnqhd', scores, vc)
    zeta = jnp.exp((CHUNK - 1.0 - idx)[:, None] * log_gamma[None, :])
    kv = jnp.einsum('bnkhd,bnkhe->nbhde', kc * zeta[None, None, :, :, None], vc)
    chunk_decay = jnp.exp(CHUNK * log_gamma)[None, :, None, None]

    def step(state, kv_i):
        return state * chunk_decay + kv_i, state

    _, state_prev = lax.scan(step, jnp.zeros((B, H, Dh, Dh), jnp.float32), kv)
    xi = jnp.exp((idx + 1.0)[:, None] * log_gamma[None, :])
    cross = jnp.einsum('bnqhd,nbhde->bnqhe', qc * xi[None, None, :, :, None], state_prev)
    y = (inner + cross).reshape(B, S, H, Dh)
    y = y * lax.rsqrt(jnp.mean(y * y, axis=-1, keepdims=True) + EPS)
    y = y.reshape(B, S, H * Dh)
    return (jax.nn.silu(g.astype(jnp.float32)) * y).astype(g.dtype)


def pool_mixer(u, w_grp, scale):
    B, S, _ = u.shape
    uf = u.astype(jnp.float32).reshape(B, S, POOL_GROUPS, POOL_GROUP_CH)
    cs = jnp.cumsum(uf, axis=1)
    csp = jnp.pad(cs, ((0, 0), (POOL_MAX_W, 0), (0, 0), (0, 0)))
    t = jnp.arange(S)
    means = []
    for gi, w in enumerate(POOL_WINDOWS):
        win = csp[:, POOL_MAX_W:, gi] - csp[:, POOL_MAX_W - w:POOL_MAX_W - w + S, gi]
        cnt = jnp.minimum(t + 1, w).astype(jnp.float32)[None, :, None]
        means.append(win / cnt)
    pooled = jnp.stack(means, axis=2) - uf
    y = jnp.einsum('bsgc,gcd->bsgd', pooled, w_grp.astype(jnp.float32)).reshape(B, S, POOL_WIDTH)
    return (y * scale.astype(jnp.float32)).astype(u.dtype)


def setup_inputs(seed: int = 0) -> dict:
    key = jax.random.key(seed)
    ks = jax.random.split(key, 16)
    f32 = jnp.float32

    def nrm(k, shape, fan_in):
        return jax.random.normal(k, shape, f32) * (fan_in ** -0.5)

    def gain(k, shape):
        return 1.0 + 0.02 * jax.random.normal(k, shape, f32)

    x = jax.random.normal(ks[0], (BATCH, SEQ, D_MODEL), f32)
    p = jax.random.normal(ks[1], (DEPTH, BATCH, SEQ, PLE_DIM), f32)
    positions = jnp.broadcast_to(jnp.arange(SEQ, dtype=jnp.int32), (BATCH, SEQ))
    return {
        "x": x,
        "p": p,
        "positions": positions,
        "g_mix": gain(ks[2], (DEPTH, D_MODEL)),
        "w_in": nrm(ks[3], (DEPTH, D_MODEL, IN_WIDTH), D_MODEL),
        "pool_w": nrm(ks[4], (DEPTH, POOL_GROUPS, POOL_GROUP_CH, POOL_GROUP_CH), POOL_GROUP_CH),
        "pool_scale": 0.5 + 0.1 * jax.random.normal(ks[5], (DEPTH, POOL_WIDTH), f32),
        "w_out": nrm(ks[6], (DEPTH, MIX_WIDTH, D_MODEL), MIX_WIDTH),
        "g_ffn": gain(ks[7], (DEPTH, D_MODEL)),
        "w_gate": nrm(ks[8], (DEPTH, D_MODEL, D_FF), D_MODEL),
        "w_up": nrm(ks[9], (DEPTH, D_MODEL, D_FF), D_MODEL),
        "w_down": nrm(ks[10], (DEPTH, D_FF, D_MODEL), D_FF),
        "g_ple": gain(ks[11], (DEPTH, D_MODEL)),
        "w_ple_gate": nrm(ks[12], (DEPTH, D_MODEL, D_MODEL), D_MODEL),
        "w_ple_proj": nrm(ks[13], (DEPTH, PLE_DIM, D_MODEL), PLE_DIM),
        "g_final": gain(ks[14], (D_MODEL,)),
    }


def reference(x, p, positions, g_mix, w_in, pool_w, pool_scale, w_out, g_ffn,
              w_gate, w_up, w_down, g_ple, w_ple_gate, w_ple_proj, g_final):
    B, S, _ = x.shape
    for i in range(DEPTH):
        h = rmsnorm(x, g_mix[i])
        z = h @ w_in[i]
        q, k, v, g, u = jnp.split(z, [RET_WIDTH, 2 * RET_WIDTH, 3 * RET_WIDTH, 4 * RET_WIDTH], axis=-1)
        q = rotary(q.reshape(B, S, RET_HEADS, RET_HEAD_DIM), positions)
        k = rotary(k.reshape(B, S, RET_HEADS, RET_HEAD_DIM), positions)
        v = v.reshape(B, S, RET_HEADS, RET_HEAD_DIM)
        y_ret = retention(q, k, v, g)
        y_pool = pool_mixer(u, pool_w[i], pool_scale[i])
        mix = jnp.concatenate([y_ret, y_pool], axis=-1)
        x = x + (mix @ w_out[i]).astype(x.dtype)
        h2 = rmsnorm(x, g_ffn[i])
        ff = (jax.nn.silu(h2 @ w_gate[i]) * (h2 @ w_up[i])) @ w_down[i]
        x = x + ff.astype(x.dtype)
        gate = jax.nn.sigmoid((rmsnorm(x, g_ple[i]) @ w_ple_gate[i]).astype(jnp.float32))
        e = (p[i] @ w_ple_proj[i]).astype(jnp.float32)
        x = x + (gate * e).astype(x.dtype)
    return rmsnorm(x, g_final)
```

```cpp
#include <hip/hip_runtime.h>
#include <cstdio>
#include <cstdint>
namespace pg8 {
#define PG8_LAS __attribute__((address_space(3)))
typedef unsigned short bf16_t;
typedef short bf16x8 __attribute__((ext_vector_type(8)));
typedef float f32x4 __attribute__((ext_vector_type(4)));
typedef unsigned u32x4 __attribute__((ext_vector_type(4)));
constexpr int BM = 256, BK = 64, HALF = 128, HTB = HALF * BK * 2  , STAGE_BYTES = 8 * HTB, NXCD = 8, WGM = 8;

__host__ __device__ __forceinline__ int lds_byte(int r, int c) { const int st = (r >> 4) * 2 + (c >> 5), rr = r & 15, cc = c & 31, ob = rr * 64 + cc * 2; return st * 1024 + (ob ^ (((ob >> 9) & 1) << 5)); }
__host__ __device__ __forceinline__ void stage_rc(int b, int& R, int& C) { const int st = b / 1024, sb = b % 1024, swz = sb ^ (((sb >> 9) & 1) << 5); R = (st >> 1) * 16 + swz / 64; C = (st & 1) * 32 + (swz % 64) / 2; }
__host__ __device__ __forceinline__ int perm32(int rho) { const int n = rho >> 4, i = rho & 15; return 8 * (i >> 2) + 4 * n + (i & 3); }

struct Unit { int pm, pn; };
struct Gemm { const bf16_t* A; const bf16_t* Bt; int M, N, K; };

struct StaticOrder {
    int nM, nN, nwg, G, c;
    __host__ __device__ void init(int M, int N, int G_, int c_) { nM = M / BM; nN = N / BM; nwg = nM * nN; G = G_; c = c_; }
    __host__ __device__ bool next(int i, Unit& u) const {
        const long L = (long)i * G + c; if (L >= nwg) return false;
        int wgid = (int)L; { const int q = nwg / NXCD, r = nwg % NXCD, xcd = wgid % NXCD, off = wgid / NXCD; wgid = (xcd < r ? xcd * (q + 1) : r * (q + 1) + (xcd - r) * q) + off; }
        const int nig = WGM * nN, gid = wgid / nig, fm = gid * WGM, gsz = (nM - fm) < WGM ? (nM - fm) : WGM;
        u.pm = fm + ((wgid % nig) % gsz); u.pn = (wgid % nig) / gsz; return true;
    }
    __device__ __forceinline__ void a_ready(const Unit&) const {}
    __device__ __forceinline__ void done(const Unit&) const {}
};

typedef float f32x2_t __attribute__((ext_vector_type(2))); typedef __bf16 bf16x2_t __attribute__((ext_vector_type(2)));
__device__ __forceinline__ unsigned cvt_pk_bf16(float lo, float hi) { f32x2_t v = {lo, hi}; bf16x2_t b = __builtin_convertvector(v, bf16x2_t); return __builtin_bit_cast(unsigned, b); }
template <class Epi, class Sched, bool ALIGN_EPI = false, bool SP2 = false>
__device__ __forceinline__ void gemm_phase(PG8_LAS unsigned char* lds, const Gemm g, const Sched& S, const Epi& E, const int tid_in) {
    const int tid = tid_in, wid = __builtin_amdgcn_readfirstlane(tid >> 6), lane = tid & 63, wr = wid >> 2, wc = wid & 3, fr = lane & 15, fq = lane >> 4;
    const int K = g.K, nt = K / BK;
    unsigned voffA[2], voffB[2];
#pragma unroll
    for (int i = 0; i < 2; ++i) { int R, C; stage_rc(tid * 16 + i * 8192, R, C); const int Rb = Epi::PERM ? ((R & ~31) + perm32(R & 31)) : R;
        voffA[i] = (unsigned)(R * K + C) * 2u; voffB[i] = (unsigned)(Rb * K + C) * 2u; }
    const size_t kstep = (size_t)(BK * 2);
    const size_t hstep = (size_t)HALF * K * 2;
    const size_t tstep = 2 * hstep;
    const unsigned ldsw = (unsigned)wid * 1024u;
    const int aoff = lds_byte(wr * 64 + fr, fq * 8), boff = lds_byte(wc * 32 + fr, fq * 8);
#define PG8_SA(b, h) (((b) * 2 + (h)) * HTB)
#define PG8_SB(b, h) ((4 + (b) * 2 + (h)) * HTB)
#define PG8_STAGE(bufoff, gbase, voff) do { _Pragma("unroll") for (int _i = 0; _i < 2; ++_i) \
        __builtin_amdgcn_global_load_lds((const unsigned*)((const char*)(gbase) + (voff)[_i]), (PG8_LAS unsigned*)(lds + (bufoff) + ldsw + _i * 8192), 16, 0, 0); } while (0)
#define PG8_LDA(dst, b, h) do { _Pragma("unroll") for (int m = 0; m < 4; ++m) _Pragma("unroll") for (int k = 0; k < 2; ++k) dst[m][k] = *(const PG8_LAS bf16x8*)(lds + PG8_SA(b, h) + aoff + m * 2048 + k * 1024); } while (0)
#define PG8_LDB(dst, b, h) do { _Pragma("unroll") for (int n = 0; n < 2; ++n) _Pragma("unroll") for (int k = 0; k < 2; ++k) dst[n][k] = *(const PG8_LAS bf16x8*)(lds + PG8_SB(b, h) + boff + n * 2048 + k * 1024); } while (0)
#define PG8_MMA(ai, bj, At, Bt) do { __builtin_amdgcn_s_setprio(1); _Pragma("unroll") for (int m = 0; m < 4; ++m) _Pragma("unroll") for (int n = 0; n < 2; ++n) _Pragma("unroll") for (int k = 0; k < 2; ++k) \
        acc[ai][bj][m][n] = __builtin_amdgcn_mfma_f32_16x16x32_bf16(Bt[n][k], At[m][k], acc[ai][bj][m][n], 0, 0, 0); __builtin_amdgcn_s_setprio(0); } while (0)
#define PG8_WAIT_V(n) asm volatile("s_waitcnt vmcnt(" #n ")" ::: "memory")
#define PG8_WAIT_L(n) asm volatile("s_waitcnt lgkmcnt(" #n ")" ::: "memory")
#define PG8_BAR __builtin_amdgcn_s_barrier()
#define PG8_SCHED __builtin_amdgcn_sched_barrier(0)
    Unit cur, nxt; int ui = 0;
    if (!S.next(0, cur)) return;
    f32x4 acc[2][2][4][2];
    E.init(acc, cur, wr, wc, fr, fq);
    bf16x8 At[4][2], B0[2][2], B1[2][2];
    const char* cA = (const char*)g.A + (size_t)cur.pm * tstep; const char* cB = (const char*)g.Bt + (size_t)cur.pn * tstep;
    S.a_ready(cur);
    if constexpr (SP2) {
        PG8_STAGE(PG8_SB(0, 0), cB, voffB); PG8_STAGE(PG8_SB(0, 1), cB + hstep, voffB); PG8_STAGE(PG8_SA(0, 0), cA, voffA); PG8_STAGE(PG8_SA(0, 1), cA + hstep, voffA);
        if (wr == 1) PG8_BAR;
        PG8_WAIT_V(2); PG8_BAR;
        PG8_STAGE(PG8_SB(1, 0), cB + kstep, voffB); PG8_STAGE(PG8_SA(1, 0), cA + kstep, voffA); PG8_STAGE(PG8_SB(1, 1), cB + hstep + kstep, voffB);
        PG8_WAIT_V(6); PG8_BAR;
    } else {
        PG8_STAGE(PG8_SB(0, 0), cB, voffB); PG8_STAGE(PG8_SA(0, 0), cA, voffA); PG8_STAGE(PG8_SB(0, 1), cB + hstep, voffB); PG8_STAGE(PG8_SA(0, 1), cA + hstep, voffA);
        if (wr == 1) PG8_BAR;
        PG8_WAIT_V(4); PG8_BAR;
        PG8_STAGE(PG8_SB(1, 0), cB + kstep, voffB); PG8_STAGE(PG8_SA(1, 0), cA + kstep, voffA); PG8_STAGE(PG8_SB(1, 1), cB + hstep + kstep, voffB);
        PG8_WAIT_V(6); PG8_BAR;
    }
    for (;;) {
        const bool has_next = S.next(ui + 1, nxt);
        const char* nA = has_next ? (const char*)g.A + (size_t)nxt.pm * tstep : cA; const char* nB = has_next ? (const char*)g.Bt + (size_t)nxt.pn * tstep : cB;
#pragma unroll 1
        for (int t = 0; t < nt; t += 2) {
            const bool last = (t == nt - 2);
            const char* a1 = cA + (size_t)(t + 1) * kstep;
            const char* a2 = last ? nA : cA + (size_t)(t + 2) * kstep; const char* b2 = last ? nB : cB + (size_t)(t + 2) * kstep;
            const char* a3 = a2 + kstep; const char* b3 = b2 + kstep;
            if (last && has_next) S.a_ready(nxt);
            if constexpr (SP2) {
            PG8_LDB(B0, 0, 0); PG8_LDB(B1, 0, 1); PG8_SCHED; PG8_LDA(At, 0, 0); PG8_STAGE(PG8_SA(1, 1), a1 + hstep, voffA);
            PG8_WAIT_V(8); PG8_WAIT_L(0); PG8_BAR; PG8_MMA(0, 0, At, B0); PG8_MMA(0, 1, At, B1); PG8_BAR; PG8_SCHED;
            PG8_LDA(At, 0, 1); PG8_STAGE(PG8_SB(0, 0), b2, voffB); PG8_STAGE(PG8_SB(0, 1), b2 + hstep, voffB); PG8_STAGE(PG8_SA(0, 0), a2, voffA);
            PG8_WAIT_V(8); PG8_WAIT_L(0); PG8_BAR; PG8_MMA(1, 0, At, B0); PG8_MMA(1, 1, At, B1); PG8_BAR; PG8_SCHED;
            PG8_LDB(B0, 1, 0); PG8_LDB(B1, 1, 1); PG8_SCHED; PG8_LDA(At, 1, 0); PG8_STAGE(PG8_SA(0, 1), a2 + hstep, voffA);
            PG8_WAIT_V(8); PG8_WAIT_L(0); PG8_BAR; PG8_MMA(0, 0, At, B0); PG8_MMA(0, 1, At, B1); PG8_BAR; PG8_SCHED;
            PG8_LDA(At, 1, 1); PG8_STAGE(PG8_SB(1, 0), b3, voffB); PG8_STAGE(PG8_SB(1, 1), b3 + hstep, voffB); PG8_STAGE(PG8_SA(1, 0), a3, voffA);
            PG8_WAIT_V(8); PG8_WAIT_L(0); PG8_BAR; PG8_MMA(1, 0, At, B0); PG8_MMA(1, 1, At, B1); PG8_BAR; PG8_SCHED;
            } else {
            PG8_LDB(B0, 0, 0); PG8_SCHED; PG8_LDA(At, 0, 0); PG8_STAGE(PG8_SA(1, 1), a1 + hstep, voffA);
            PG8_WAIT_L(8); PG8_BAR; PG8_WAIT_L(0); PG8_MMA(0, 0, At, B0); PG8_BAR; PG8_SCHED;
            PG8_LDB(B1, 0, 1); PG8_STAGE(PG8_SB(0, 0), b2, voffB);
            PG8_BAR; PG8_WAIT_L(0); PG8_MMA(0, 1, At, B1); PG8_BAR;
            PG8_LDA(At, 0, 1); PG8_STAGE(PG8_SA(0, 0), a2, voffA);
            PG8_BAR; PG8_WAIT_L(0); PG8_MMA(1, 0, At, B0); PG8_BAR; PG8_SCHED;
            PG8_STAGE(PG8_SB(0, 1), b2 + hstep, voffB);
            PG8_WAIT_V(6); PG8_BAR; PG8_MMA(1, 1, At, B1); PG8_BAR;
            PG8_LDB(B0, 1, 0); PG8_SCHED; PG8_LDA(At, 1, 0); PG8_STAGE(PG8_SA(0, 1), a2 + hstep, voffA);
            PG8_WAIT_L(8); PG8_BAR; PG8_WAIT_L(0); PG8_MMA(0, 0, At, B0); PG8_BAR; PG8_SCHED;
            PG8_LDB(B1, 1, 1); PG8_STAGE(PG8_SB(1, 0), b3, voffB);
            PG8_BAR; PG8_WAIT_L(0); PG8_MMA(0, 1, At, B1); PG8_BAR;
            PG8_LDA(At, 1, 1); PG8_STAGE(PG8_SA(1, 0), a3, voffA);
            PG8_BAR; PG8_WAIT_L(0); PG8_MMA(1, 0, At, B0); PG8_BAR; PG8_SCHED;
            PG8_STAGE(PG8_SB(1, 1), b3 + hstep, voffB);
            PG8_WAIT_V(6); PG8_BAR; PG8_MMA(1, 1, At, B1); PG8_BAR;
            }
        }
        if constexpr (ALIGN_EPI) { if (wr == 0) PG8_BAR; }
        if constexpr (!Epi::AFTER_DRAIN) { E(acc, cur, wr, wc, fr, fq, ui); S.done(cur); }
        if (!has_next) break;
        E.init(acc, nxt, wr, wc, fr, fq);
        cur = nxt; cA = nA; cB = nB; ++ui;
        if constexpr (ALIGN_EPI) { if (wr == 1) PG8_BAR; }
    }
    PG8_WAIT_V(0);
    if constexpr (!ALIGN_EPI) { if (wr == 0) PG8_BAR; }
    PG8_BAR;
    if constexpr (Epi::AFTER_DRAIN) { E.fused(acc, cur, wr, wc, fr, fq, lds, wid, lane); S.done(cur); }
#undef PG8_SA
#undef PG8_SB
#undef PG8_STAGE
#undef PG8_LDA
#undef PG8_LDB
#undef PG8_MMA
#undef PG8_WAIT_V
#undef PG8_WAIT_L
#undef PG8_BAR
#undef PG8_SCHED
}
}

constexpr int BATCH = 8, SEQ = 4096, D = 1024, DEPTH = 4, M = BATCH * SEQ;
constexpr int NH = 4, DH = 128, RW = 512, CHUNK = 128, NCH = SEQ / CHUNK;
constexpr int INW = 2560, FF = 2816, PLE = 256;
constexpr float EPS = 1e-6f;
constexpr int NWAVES = 8;

constexpr size_t MiB = 1u << 20;
constexpr size_t WS_CTL = 0, CTL_ZERO_BYTES = 1 * MiB;
constexpr size_t WS_SSQA = 1 * MiB, WS_SSQB = 3 * MiB;
constexpr size_t WS_W = 8 * MiB, W_LAYER = 26 * MiB;
constexpr size_t WO_IN = 0, WO_OUT = 5 * MiB, WO_GU = 7 * MiB, WO_DOWN = 18 * MiB, WO_PG = 18 * MiB + 5632 * 1024, WO_PP = WO_PG + 2 * MiB;
static_assert(WO_PP + 512 * 1024 == W_LAYER, "weight map");
constexpr size_t WS_XB = 112 * MiB;
constexpr size_t WS_PB = 176 * MiB;
constexpr size_t WS_R = 192 * MiB;
constexpr size_t R_Q = 0, R_K = 32 * MiB, R_V = 64 * MiB, R_G = 96 * MiB, R_UW = 128 * MiB, R_KV = 160 * MiB, R_MIX = 192 * MiB;
constexpr size_t R_H = 0, R_E = 192 * MiB, R_UT = 0;
constexpr size_t WS_XB1 = WS_R + 256 * MiB;
constexpr size_t WS_END = WS_XB1 + 64 * MiB;
static_assert((size_t)M * FF * 2 <= R_MIX, "hmid overlay");
constexpr int CW_BAR = 4096;

constexpr int RING_BYTES = 131072;
constexpr int LDSCTL_OFF = RING_BYTES, MISC_OFF = LDSCTL_OFF + 320;
constexpr int SIDE_OFF = LDSCTL_OFF + 1024;
#if defined(RET_RECURRENT)
constexpr int LDS_BYTES = 163840;
#else
constexpr int LDS_BYTES = 147456;
#endif

#define GAS __attribute__((address_space(1)))
#define LAS __attribute__((address_space(3)))
typedef unsigned short bf16;
typedef unsigned v4u __attribute__((ext_vector_type(4)));
typedef unsigned v2u __attribute__((ext_vector_type(2)));
typedef float f32x4 __attribute__((ext_vector_type(4)));
typedef float f32x16 __attribute__((ext_vector_type(16)));
typedef short bf16x8 __attribute__((ext_vector_type(8)));
typedef short s16x4 __attribute__((ext_vector_type(4)));
typedef GAS unsigned gu32;
#define RLX_AGENT __ATOMIC_RELAXED, __HIP_MEMORY_SCOPE_AGENT
#define LDS_WAIT() asm volatile("s_waitcnt lgkmcnt(0)" ::: "memory")
#define VM_WAIT() asm volatile("s_waitcnt vmcnt(0)" ::: "memory")
__device__ __forceinline__ unsigned f2bf(float f) { unsigned u = __builtin_bit_cast(unsigned, f); return (u + 0x7fffu + ((u >> 16) & 1u)) >> 16; }
__device__ __forceinline__ unsigned pk2(float lo, float hi) { return f2bf(lo) | (f2bf(hi) << 16); }
__device__ __forceinline__ float bf_lo(unsigned w) { return __builtin_bit_cast(float, w << 16); }
__device__ __forceinline__ float bf_hi(unsigned w) { return __builtin_bit_cast(float, w & 0xffff0000u); }

__device__ const float ROPE_HI[64] = {1.591186523e-01f, 1.378173828e-01f, 1.193237305e-01f, 1.033325195e-01f, 8.947753906e-02f, 7.748413086e-02f, 6.710815430e-02f, 5.810546875e-02f, 5.032348633e-02f, 4.357910156e-02f, 3.773498535e-02f, 3.266906738e-02f, 2.829742432e-02f, 2.450561523e-02f, 2.121734619e-02f, 1.837158203e-02f, 1.591491699e-02f, 1.377868652e-02f, 1.193237305e-02f, 1.033401489e-02f, 8.949279785e-03f, 7.749557495e-03f, 6.710052490e-03f, 5.811691284e-03f, 5.031585693e-03f, 4.358291626e-03f, 3.773689270e-03f, 3.268241882e-03f, 2.829551697e-03f, 2.449989319e-03f, 2.121925354e-03f, 1.837730408e-03f, 1.591205597e-03f, 1.378059387e-03f, 1.193046570e-03f, 1.033306122e-03f, 8.947849274e-04f, 7.748603821e-04f, 6.711483002e-04f, 5.810260773e-04f, 5.030632019e-04f, 4.358291626e-04f, 3.772974014e-04f, 3.267526627e-04f, 2.830028534e-04f, 2.449750900e-04f, 2.121925354e-04f, 1.837611198e-04f, 1.591444016e-04f, 1.378059387e-04f, 1.193284988e-04f, 1.033246517e-04f, 8.949637413e-05f, 7.748603821e-05f, 6.711483002e-05f, 5.811452866e-05f, 5.032122135e-05f, 4.357099533e-05f, 3.772974014e-05f, 3.267824650e-05f, 2.829730511e-05f, 2.450495958e-05f, 2.121925354e-05f, 1.837313175e-05f};
__device__ const float ROPE_LO[64] = {3.629074854e-05f, 5.119791695e-06f, 2.563974340e-05f, 1.977708780e-05f, 2.186254642e-05f, 1.915789653e-05f, 6.928708444e-06f, 1.379869173e-05f, 5.725776191e-06f, 4.200542662e-06f, 6.599365861e-06f, 1.379848982e-05f, 4.771514341e-06f, 3.076627763e-06f, 6.306573596e-06f, 7.344074220e-06f, 5.773169960e-07f, 3.563736982e-06f, 2.563974249e-06f, 1.214769213e-06f, 6.603757470e-07f, 7.713804280e-07f, 1.455810320e-06f, 2.354600070e-07f, 1.335517140e-06f, 3.858455244e-08f, 4.692017228e-07f, 4.470491177e-08f, 6.678862974e-07f, 8.798673434e-07f, 4.399224736e-07f, 1.622028520e-07f, 3.438339888e-07f, 1.656388378e-07f, 4.471322939e-07f, 2.168443558e-07f, 2.090887250e-07f, 1.725054801e-07f, 2.529881415e-09f, 1.665971467e-07f, 2.289191343e-07f, 3.858455333e-09f, 1.184457474e-07f, 7.599606278e-08f, 1.910491321e-08f, 1.118285908e-07f, 4.399224807e-08f, 2.814121380e-08f, 1.054154186e-08f, 1.656388271e-08f, 2.087137041e-08f, 2.764489970e-08f, 3.027478712e-09f, 1.725054766e-08f, 2.529881304e-10f, 4.738785808e-09f, 7.990752948e-09f, 1.230677427e-08f, 1.184457421e-08f, 4.619374216e-09f, 4.890723382e-09f, 3.732278930e-09f, 4.399224540e-09f, 5.794353886e-09f};
__device__ __forceinline__ float lg2gamma(int h) { return h == 0 ? -0.04580368961312479f : h == 1 ? -0.02272007650008353f : h == 2 ? -0.011315313227834146f : -0.005646563141142063f; }

__device__ __forceinline__ float add_xor16(float v) { return v + __builtin_bit_cast(float, __builtin_amdgcn_ds_swizzle(__builtin_bit_cast(int, v), 0x401F)); }
__device__ __forceinline__ float add_xor32(float v) { float a_ = v, b_ = v; asm volatile("s_nop 1\n\tv_permlane32_swap_b32 %0, %1" : "+v"(a_), "+v"(b_)); return a_ + b_; }
namespace pg8 {
__device__ __forceinline__ void load_rstd(const PG8_LAS float* side, int ui, int wr, int fr, float (&rs)[2][4]) {
#pragma unroll
    for (int ai = 0; ai < 2; ++ai)
#pragma unroll
        for (int m = 0; m < 4; ++m) rs[ai][m] = side[ui * 256 + ai * HALF + wr * 64 + m * 16 + fr];
}
template <class Sched> __device__ __forceinline__ void fill_rstd(const Sched& S, const float* ssq, PG8_LAS float* side, const int* pos, PG8_LAS float* posf, int tid) {
    Unit u;
    for (int i = 0; S.next(i, u); ++i) {
        const int row = u.pm * BM + (tid >> 1), hf = tid & 1;
        const f32x4 a = *(const f32x4*)(ssq + (size_t)row * 16 + 8 * hf), b = *(const f32x4*)(ssq + (size_t)row * 16 + 8 * hf + 4);
        float s = ((a[0] + a[1]) + (a[2] + a[3])) + ((b[0] + b[1]) + (b[2] + b[3]));
        s += __builtin_bit_cast(float, __builtin_amdgcn_ds_swizzle(__builtin_bit_cast(int, s), 0x041F));
        if (hf == 0) { side[i * 256 + (tid >> 1)] = rsqrtf(s * (1.0f / 1024.0f) + 1e-6f); if (pos) posf[i * 256 + (tid >> 1)] = (float)pos[row]; }
    }
}
#ifndef WTM
#define WTM 0
#endif
template <int BIT> __device__ __forceinline__ void st16(void* p, const u32x4 v) {
    if constexpr ((WTM >> BIT) & 1) asm volatile("global_store_dwordx4 %0, %1, off sc1\n\ts_nop 0" :: "v"(p), "v"(v) : "memory");
    else *(u32x4*)p = v;
}
__device__ __forceinline__ u32x4 pack8(const f32x4 a, const f32x4 b) { u32x4 w; w.x = cvt_pk_bf16(a[0], a[1]); w.y = cvt_pk_bf16(a[2], a[3]); w.z = cvt_pk_bf16(b[0], b[1]); w.w = cvt_pk_bf16(b[2], b[3]); return w; }

struct EpiInProj {
    static constexpr bool PERM = true, AFTER_DRAIN = false;
    const PG8_LAS float* side; const PG8_LAS float* posf; const PG8_LAS float* rope; bf16_t *q, *k, *v, *g, *uw;
    __device__ __forceinline__ void init(f32x4 (&acc)[2][2][4][2], const Unit&, int, int, int, int) const {
#pragma unroll
        for (int a = 0; a < 2; ++a)
#pragma unroll
            for (int b = 0; b < 2; ++b)
#pragma unroll
                for (int m = 0; m < 4; ++m)
#pragma unroll
                    for (int n = 0; n < 2; ++n) acc[a][b][m][n] = (f32x4){0.f, 0.f, 0.f, 0.f};
    }
    __device__ __forceinline__ void operator()(const f32x4 (&acc)[2][2][4][2], const Unit& u, int wr, int wc, int fr, int fq, int ui) const {
        const int rowbase = u.pm * BM + wr * 64 + fr;
        float rs[2][4]; load_rstd(side, ui, wr, fr, rs);
        if (u.pn < 4) {
            const int sec = u.pn >> 1, head = 2 * (u.pn & 1) + (wc >> 1), dd0 = 32 * (wc & 1) + 8 * fq;
            bf16_t* dst = sec ? k : q;
            const f32x4 h0 = *(const PG8_LAS f32x4*)(rope + dd0), h1 = *(const PG8_LAS f32x4*)(rope + dd0 + 4), l0 = *(const PG8_LAS f32x4*)(rope + 64 + dd0), l1 = *(const PG8_LAS f32x4*)(rope + 64 + dd0 + 4);
            const float lg = lg2gamma(head);
#pragma unroll
            for (int ai = 0; ai < 2; ++ai)
#pragma unroll
                for (int m = 0; m < 4; ++m) {
                    const int row = rowbase + ai * HALF + m * 16, b = row >> 12, s = row & 4095;
                    const float p = posf[ui * 256 + ai * HALF + wr * 64 + m * 16 + fr];
                    const float sc = rs[ai][m] * (sec ? __builtin_amdgcn_exp2f((float)(127 - (s & 127)) * lg) : 1.0f);
                    f32x4 o1[2], o2[2];
#pragma unroll
                    for (int n = 0; n < 2; ++n) { const f32x4 fh = n ? h1 : h0, fl = n ? l1 : l0;
#pragma unroll
                        for (int j = 0; j < 4; ++j) { const float ph = p * fh[j]; const float rev = (ph - __builtin_floorf(ph)) + p * fl[j];
                            const float cs = __builtin_amdgcn_cosf(rev), sn = __builtin_amdgcn_sinf(rev);
                            const float x1 = acc[ai][0][m][n][j] * sc, x2 = acc[ai][1][m][n][j] * sc;
                            o1[n][j] = x1 * cs - x2 * sn; o2[n][j] = x2 * cs + x1 * sn; } }
                    bf16_t* rp = dst + ((size_t)((b * NH_ + head) * SEQ_ + s)) * 128 + dd0;
                    st16<0>(rp, pack8(o1[0], o1[1])); st16<0>((rp + 64), pack8(o2[0], o2[1]));
                    asm volatile("" ::: "memory");
                }
        } else {
            const int sec = (u.pn - 4) >> 1;
            const int c0 = 256 * (u.pn & 1) + 32 * wc + 8 * fq;
#pragma unroll
            for (int ai = 0; ai < 2; ++ai)
#pragma unroll
                for (int m = 0; m < 4; ++m) {
                    const int row = rowbase + ai * HALF + m * 16, b = row >> 12, s = row & 4095; const float sc = rs[ai][m];
#pragma unroll
                    for (int bj = 0; bj < 2; ++bj) { const u32x4 w = pack8(acc[ai][bj][m][0] * sc, acc[ai][bj][m][1] * sc); const int c = c0 + 128 * bj;
                        if (sec == 2) st16<0>((uw + (size_t)row * 512 + c), w);
                        else { bf16_t* dst = sec ? g : v; st16<0>((dst + ((size_t)((b * NH_ + (c >> 7)) * SEQ_ + s)) * 128 + (c & 127)), w); } }
                }
        }
    }
    static constexpr int NH_ = 4, SEQ_ = 4096;
};

__device__ __forceinline__ void unpack8(const u32x4 w, f32x4& a, f32x4& b) {
    a[0] = __builtin_bit_cast(float, w.x << 16); a[1] = __builtin_bit_cast(float, w.x & 0xffff0000u); a[2] = __builtin_bit_cast(float, w.y << 16); a[3] = __builtin_bit_cast(float, w.y & 0xffff0000u);
    b[0] = __builtin_bit_cast(float, w.z << 16); b[1] = __builtin_bit_cast(float, w.z & 0xffff0000u); b[2] = __builtin_bit_cast(float, w.w << 16); b[3] = __builtin_bit_cast(float, w.w & 0xffff0000u);
}
struct EpiResid {
    static constexpr bool PERM = true, AFTER_DRAIN = false;
    const bf16_t* xin; bf16_t* xout; float* ssq_out;
    __device__ __forceinline__ void init(f32x4 (&acc)[2][2][4][2], const Unit& u, int wr, int wc, int fr, int fq) const {
        const int rowbase = u.pm * BM + wr * 64 + fr, col0 = u.pn * BM + 32 * wc + 8 * fq;
        u32x4 w[2][4][2];
#pragma unroll
        for (int ai = 0; ai < 2; ++ai)
#pragma unroll
            for (int m = 0; m < 4; ++m)
#pragma unroll
                for (int bj = 0; bj < 2; ++bj) w[ai][m][bj] = *(const u32x4*)(xin + (size_t)(rowbase + ai * HALF + m * 16) * 1024 + col0 + bj * HALF);
#pragma unroll
        for (int ai = 0; ai < 2; ++ai)
#pragma unroll
            for (int m = 0; m < 4; ++m)
#pragma unroll
                for (int bj = 0; bj < 2; ++bj) unpack8(w[ai][m][bj], acc[ai][bj][m][0], acc[ai][bj][m][1]);
    }
    __device__ __forceinline__ void operator()(const f32x4 (&acc)[2][2][4][2], const Unit& u, int wr, int wc, int fr, int fq, int) const {
        const int rowbase = u.pm * BM + wr * 64 + fr, col0 = u.pn * BM + 32 * wc + 8 * fq;
#pragma unroll
        for (int ai = 0; ai < 2; ++ai)
#pragma unroll
            for (int m = 0; m < 4; ++m) {
                const int row = rowbase + ai * HALF + m * 16; const size_t off = (size_t)row * 1024 + col0; float ss = 0.f;
#pragma unroll
                for (int bj = 0; bj < 2; ++bj) {
                    const f32x4 v0 = acc[ai][bj][m][0], v1 = acc[ai][bj][m][1];
                    st16<1>((xout + off + bj * HALF), pack8(v0, v1));
                    ss += (v0[0] * v0[0] + v0[1] * v0[1]) + (v0[2] * v0[2] + v0[3] * v0[3]) + (v1[0] * v1[0] + v1[1] * v1[1]) + (v1[2] * v1[2] + v1[3] * v1[3]); }
                ss = add_xor32(add_xor16(ss));
                if (fq == 0) ssq_out[(size_t)row * 16 + u.pn * 4 + wc] = ss;
            }
    }
};

struct EpiSwiGLU {
    static constexpr bool PERM = true, AFTER_DRAIN = false;
    const PG8_LAS float* side; bf16_t* h;
    __device__ __forceinline__ void init(f32x4 (&acc)[2][2][4][2], const Unit&, int, int, int, int) const {
#pragma unroll
        for (int a = 0; a < 2; ++a)
#pragma unroll
            for (int b = 0; b < 2; ++b)
#pragma unroll
                for (int m = 0; m < 4; ++m)
#pragma unroll
                    for (int n = 0; n < 2; ++n) acc[a][b][m][n] = (f32x4){0.f, 0.f, 0.f, 0.f};
    }
    __device__ __forceinline__ void operator()(const f32x4 (&acc)[2][2][4][2], const Unit& u, int wr, int wc, int fr, int fq, int ui) const {
        const int rowbase = u.pm * BM + wr * 64 + fr, col0 = u.pn * HALF + 32 * wc + 8 * fq;
        float rs[2][4]; load_rstd(side, ui, wr, fr, rs);
#pragma unroll
        for (int ai = 0; ai < 2; ++ai)
#pragma unroll
            for (int m = 0; m < 4; ++m) { const float sc = rs[ai][m], c1 = -1.4426950408889634f * sc, sc2 = sc * sc; f32x4 o[2];
#pragma unroll
                for (int n = 0; n < 2; ++n)
#pragma unroll
                    for (int jp = 0; jp < 2; ++jp) { const f32x2_t av = {acc[ai][0][m][n][2 * jp], acc[ai][0][m][n][2 * jp + 1]}, bv = {acc[ai][1][m][n][2 * jp], acc[ai][1][m][n][2 * jp + 1]};
                        const f32x2_t t = av * c1; f32x2_t ex; ex.x = __builtin_amdgcn_exp2f(t.x); ex.y = __builtin_amdgcn_exp2f(t.y);
                        const f32x2_t d = ex + 1.0f; f32x2_t r; r.x = __builtin_amdgcn_rcpf(d.x); r.y = __builtin_amdgcn_rcpf(d.y);
                        const f32x2_t ov = (av * bv) * (r * sc2); o[n][2 * jp] = ov.x; o[n][2 * jp + 1] = ov.y; }
#if defined(ABL_FFN)
                o[0] = (f32x4){0.f, 0.f, 0.f, 0.f}; o[1] = o[0];
#endif
                st16<2>((h + (size_t)(rowbase + ai * HALF + m * 16) * 2816 + col0), pack8(o[0], o[1])); }
    }
};

struct EpiPlain {
    static constexpr bool PERM = true, AFTER_DRAIN = false;
    bf16_t* O; int ldc;
    __device__ __forceinline__ void init(f32x4 (&acc)[2][2][4][2], const Unit&, int, int, int, int) const {
#pragma unroll
        for (int a = 0; a < 2; ++a)
#pragma unroll
            for (int b = 0; b < 2; ++b)
#pragma unroll
                for (int m = 0; m < 4; ++m)
#pragma unroll
                    for (int n = 0; n < 2; ++n) acc[a][b][m][n] = (f32x4){0.f, 0.f, 0.f, 0.f};
    }
    __device__ __forceinline__ void operator()(const f32x4 (&acc)[2][2][4][2], const Unit& u, int wr, int wc, int fr, int fq, int) const {
        const int rowbase = u.pm * BM + wr * 64 + fr, col0 = u.pn * BM + 32 * wc + 8 * fq;
#pragma unroll
        for (int ai = 0; ai < 2; ++ai)
#pragma unroll
            for (int m = 0; m < 4; ++m)
#pragma unroll
#if defined(ABL_PLE)
                for (int bj = 0; bj < 2; ++bj) st16<3>((O + (size_t)(rowbase + ai * HALF + m * 16) * ldc + col0 + bj * HALF), (u32x4){0u, 0u, 0u, 0u});
#else
                for (int bj = 0; bj < 2; ++bj) st16<3>((O + (size_t)(rowbase + ai * HALF + m * 16) * ldc + col0 + bj * HALF), pack8(acc[ai][bj][m][0], acc[ai][bj][m][1]));
#endif
    }
};

struct EpiPle {
    static constexpr bool PERM = true, AFTER_DRAIN = false;
    const PG8_LAS float* side; const bf16_t* e; const bf16_t* xin; bf16_t* xout; float* ssq_out;
    __device__ __forceinline__ void init(f32x4 (&acc)[2][2][4][2], const Unit&, int, int, int, int) const {
#pragma unroll
        for (int a = 0; a < 2; ++a)
#pragma unroll
            for (int b = 0; b < 2; ++b)
#pragma unroll
                for (int m = 0; m < 4; ++m)
#pragma unroll
                    for (int n = 0; n < 2; ++n) acc[a][b][m][n] = (f32x4){0.f, 0.f, 0.f, 0.f};
    }
    __device__ __forceinline__ void operator()(const f32x4 (&acc)[2][2][4][2], const Unit& u, int wr, int wc, int fr, int fq, int ui) const {
        const int rowbase = u.pm * BM + wr * 64 + fr, col0 = u.pn * BM + 32 * wc + 8 * fq;
        float rs[2][4]; load_rstd(side, ui, wr, fr, rs);
#pragma unroll
        for (int ai = 0; ai < 2; ++ai)
#pragma unroll
            for (int m = 0; m < 4; ++m) {
                const int row = rowbase + ai * HALF + m * 16; const size_t off = (size_t)row * 1024 + col0; float ss = 0.f; const float sc = -1.4426950408889634f * rs[ai][m];
#pragma unroll
                for (int bj = 0; bj < 2; ++bj) {
                    f32x4 e0, e1, x0, x1; unpack8(*(const u32x4*)(e + off + bj * HALF), e0, e1); unpack8(*(const u32x4*)(xin + off + bj * HALF), x0, x1);
                    f32x4 v0, v1;
#pragma unroll
                    for (int j = 0; j < 4; ++j) {
                        v0[j] = x0[j] + __builtin_amdgcn_rcpf(1.0f + __builtin_amdgcn_exp2f(sc * acc[ai][bj][m][0][j])) * e0[j];
                        v1[j] = x1[j] + __builtin_amdgcn_rcpf(1.0f + __builtin_amdgcn_exp2f(sc * acc[ai][bj][m][1][j])) * e1[j]; }
                    st16<4>((xout + off + bj * HALF), pack8(v0, v1));
                    ss += (v0[0] * v0[0] + v0[1] * v0[1]) + (v0[2] * v0[2] + v0[3] * v0[3]) + (v1[0] * v1[0] + v1[1] * v1[1]) + (v1[2] * v1[2] + v1[3] * v1[3]); }
                ss = add_xor32(add_xor16(ss));
                if (fq == 0) ssq_out[(size_t)row * 16 + u.pn * 4 + wc] = ss;
            }
    }
};
}
#define XB_TMO      128
#define XB_XCNT(j)  (256  + 64 * (j))
#define XB_XSUB(j)  (1280 + 64 * (j))
#define XB_XGEN(j)  (2304 + 64 * (j))
#define XB_TOP      3328
#define XB_TOPGEN   3392
#define XCD_BAR_WORDS 3456
#define XB_SPIN_CAP (1u << 18)

__device__ __forceinline__ unsigned xb_ld(unsigned* p)              { return __hip_atomic_load(p, __ATOMIC_RELAXED, __HIP_MEMORY_SCOPE_AGENT); }
__device__ __forceinline__ unsigned xb_add(unsigned* p, unsigned v) { return __hip_atomic_fetch_add(p, v, __ATOMIC_RELAXED, __HIP_MEMORY_SCOPE_AGENT); }
__device__ __forceinline__ unsigned xb_xcc_id() { return (unsigned)__builtin_amdgcn_s_getreg((3 << 11) | 20) & 0xFu; }
#define XB_SPIN(cond, bar) do { unsigned _sp = 0; while (cond) { __builtin_amdgcn_s_sleep(1); \
    if ((++_sp & 255u) == 0u) { if (xb_ld(&(bar)[XB_TMO])) break; if (_sp > XB_SPIN_CAP) { atomicAdd(&(bar)[XB_TMO], 1u); break; } } } } while (0)

struct XcdBarrier {
    unsigned* bar; unsigned x;
    volatile LAS unsigned* st;
};

__device__ __forceinline__ XcdBarrier xcd_barrier_post(unsigned* bar, volatile LAS unsigned* st) {
    XcdBarrier b; b.bar = bar; b.x = xb_xcc_id(); b.st = st;
    if (threadIdx.x == 0) (void)xb_add(&bar[XB_XCNT(b.x)], 1u);
    return b;
}
__device__ __forceinline__ void xcd_barrier_complete(unsigned* bar, unsigned x, unsigned& nloc, unsigned& nx) {
    const unsigned G = gridDim.x * gridDim.y * gridDim.z;
    unsigned sum, cnt, mine, sp = 0u;
    for (;;) {
        sum = 0u; cnt = 0u; mine = 0u;
#pragma unroll
        for (unsigned j = 0; j < 16; ++j) { const unsigned c = xb_ld(&bar[XB_XCNT(j)]); sum += c; cnt += (c > 0u) ? 1u : 0u; mine = (j == x) ? c : mine; }
        if (sum == G) break;
        __builtin_amdgcn_s_sleep(1);
        if ((++sp & 255u) == 0u) { if (xb_ld(&bar[XB_TMO])) break; if (sp > XB_SPIN_CAP) { atomicAdd(&bar[XB_TMO], 1u); break; } }
    }
    nloc = mine > 0u ? mine : 1u; nx = cnt > 0u ? cnt : 1u;
}

__device__ __forceinline__ void xcd_barrier(const XcdBarrier& b) {
    asm volatile("s_waitcnt vmcnt(0)" ::: "memory");
    __syncthreads();
    if (threadIdx.x == 0) {
        unsigned* bar = b.bar; unsigned bx_ = b.x; asm volatile("" : "+s"(bar), "+s"(bx_));
        __builtin_amdgcn_s_waitcnt(0);
        unsigned nloc = b.st[0], nx = b.st[1];
        if (nloc == 0u) { xcd_barrier_complete(bar, bx_, nloc, nx); b.st[0] = nloc; b.st[1] = nx; }
        const unsigned old = xb_add(&bar[XB_XSUB(bx_)], 1u);
        const unsigned gen = old / nloc;
        if (old + 1u == (gen + 1u) * nloc) {
            __builtin_amdgcn_fence(__ATOMIC_RELEASE, "agent");
            asm volatile("s_waitcnt vmcnt(0)" ::: "memory");
            const unsigned og = xb_add(&bar[XB_TOP], 1u);
            const unsigned tg = og / nx;
            if (og + 1u == (tg + 1u) * nx) xb_add(&bar[XB_TOPGEN], 1u);
            else XB_SPIN(xb_ld(&bar[XB_TOPGEN]) == tg, bar);
            __builtin_amdgcn_fence(__ATOMIC_ACQUIRE, "agent");
            xb_add(&bar[XB_XGEN(bx_)], 1u);
            asm volatile("s_waitcnt vmcnt(0)" ::: "memory");
        } else {
            XB_SPIN(xb_ld(&bar[XB_XGEN(bx_)]) == gen, bar);
            __builtin_amdgcn_fence(__ATOMIC_ACQUIRE, "agent");
            asm volatile("s_waitcnt vmcnt(0)" ::: "memory");
        }
    }
    __syncthreads();
}

__device__ __forceinline__ float wave_sum(float v) {
    v += __builtin_bit_cast(float, __builtin_amdgcn_ds_swizzle(__builtin_bit_cast(int, v), 0x041F));
    v += __builtin_bit_cast(float, __builtin_amdgcn_ds_swizzle(__builtin_bit_cast(int, v), 0x081F));
    v += __builtin_bit_cast(float, __builtin_amdgcn_ds_swizzle(__builtin_bit_cast(int, v), 0x101F));
    v += __builtin_bit_cast(float, __builtin_amdgcn_ds_swizzle(__builtin_bit_cast(int, v), 0x201F));
    return add_xor32(add_xor16(v));
}
__device__ __forceinline__ unsigned off_b(unsigned row, unsigned ch) { return 256u * row + 16u * (ch ^ (((row & 3u) << 2) | ((row >> 2) & 3u))); }
__device__ __forceinline__ unsigned tr_addr_nat(unsigned lane, unsigned c, unsigned ks, unsigned t) {
    const unsigned h = lane >> 5, blk = (lane >> 4) & 1u, q = (lane & 15u) >> 2, p = lane & 3u;
    return off_b(16u * ks + 8u * h + 4u * t + q, 4u * c + 2u * blk + (p >> 1)) + 8u * (p & 1u);
}
__device__ __forceinline__ unsigned tr_addr_perm(unsigned lane, unsigned c, unsigned ks, unsigned t) {
    const unsigned h = lane >> 5, blk = (lane >> 4) & 1u, q = (lane & 15u) >> 2, p = lane & 3u;
    return off_b(16u * ks + 8u * t + 4u * h + q, 4u * c + 2u * blk + (p >> 1)) + 8u * (p & 1u);
}
__device__ __forceinline__ unsigned tr_addr16(unsigned lane, unsigned c, unsigned ks, unsigned t) {
    const unsigned g = lane >> 4, q = (lane & 15u) >> 2, p = lane & 3u;
    return off_b(32u * ks + 8u * g + 4u * t + q, 2u * c + (p >> 1)) + 8u * (p & 1u);
}
__device__ __forceinline__ void glds16(const void* gsrc, unsigned lds_dst) { unsigned keep;
    asm volatile("s_mov_b32 %0, m0\n\ts_mov_b32 m0, %2\n\ts_nop 0\n\tglobal_load_lds_dwordx4 %1, off\n\ts_mov_b32 m0, %0" : "=&s"(keep) : "v"(gsrc), "s"(lds_dst) : "memory"); }
typedef short v4i16_t __attribute__((ext_vector_type(4)));
__device__ __forceinline__ s16x4 tr_read(LAS unsigned char* p) { return __builtin_bit_cast(s16x4, __builtin_amdgcn_ds_read_tr16_b64_v4i16((LAS v4i16_t*)p)); }
__device__ __forceinline__ bf16x8 cat4(s16x4 a, s16x4 b) { return (bf16x8){a[0], a[1], a[2], a[3], b[0], b[1], b[2], b[3]}; }
__device__ __forceinline__ unsigned cvtpk(float lo, float hi) { return pg8::cvt_pk_bf16(lo, hi); }
__device__ __forceinline__ int crow(int r, int hi) { return (r & 3) + 8 * (r >> 2) + 4 * hi; }
__device__ __forceinline__ bf16x8 pack_acc(const f32x16& a, int s) {
    v4u w; w.x = cvtpk(a[8 * s + 0], a[8 * s + 1]); w.y = cvtpk(a[8 * s + 2], a[8 * s + 3]); w.z = cvtpk(a[8 * s + 4], a[8 * s + 5]); w.w = cvtpk(a[8 * s + 6], a[8 * s + 7]);
    return __builtin_bit_cast(bf16x8, w);
}

__device__ __forceinline__ void tr_item(const float* W, int ldw, int srccol0, int k0, const float* gain, float scal, bf16* WT, int K, int dstrow0, LAS float* scr, int lane) {
    float r[32], gv[32];
    const float* wp = W + (size_t)(k0 + (lane >> 5)) * ldw + srccol0 + (lane & 31);
#pragma unroll
    for (int i = 0; i < 32; ++i) r[i] = __builtin_nontemporal_load(wp + (size_t)(2 * i) * ldw);
    if (gain) {
#pragma unroll
        for (int i = 0; i < 32; ++i) gv[i] = gain[k0 + 2 * i + (lane >> 5)] * scal;
    } else {
#pragma unroll
        for (int i = 0; i < 32; ++i) gv[i] = scal;
    }
#pragma unroll
    for (int i = 0; i < 32; ++i) scr[(2 * i + (lane >> 5)) * 33 + (lane & 31)] = r[i] * gv[i];
    LDS_WAIT(); asm volatile("" ::: "memory");
    const int c = lane & 7;
#pragma unroll
    for (int j = 0; j < 4; ++j) { const int n = (lane >> 3) + 8 * j; const LAS float* s = scr + (8 * c) * 33 + n;
        v4u o; o.x = pk2(s[0 * 33], s[1 * 33]); o.y = pk2(s[2 * 33], s[3 * 33]); o.z = pk2(s[4 * 33], s[5 * 33]); o.w = pk2(s[6 * 33], s[7 * 33]);
        *(GAS v4u*)(WT + (size_t)(dstrow0 + n) * K + k0 + 8 * c) = o; }
    LDS_WAIT(); asm volatile("" ::: "memory");
}

struct Args { const float* x; const float* p; const int* pos; const float* g_mix; const float* w_in; const float* pool_w; const float* pool_scale; const float* w_out; const float* g_ffn;
              const float* w_gate; const float* w_up; const float* w_down; const float* g_ple; const float* w_ple_gate; const float* w_ple_proj; const float* g_final; float* out; unsigned char* ws; };

template <int W> __device__ __forceinline__ void pool_rows(const bf16* uw, bf16* mix, int b, int s0, int c0) {
    constexpr int NR = W - 1 + 16;
    v2u xr[NR];
#pragma unroll
    for (int i = 0; i < NR; ++i) { const int s = s0 - (W - 1) + i;
        xr[i] = (s >= 0) ? *(const GAS v2u*)(uw + (size_t)(b * SEQ + s) * 512 + c0) : (v2u){0u, 0u}; }
    float sum[4];
#pragma unroll
    for (int j = 0; j < 4; ++j) sum[j] = 0.f;
#pragma unroll
    for (int i = 0; i < W - 1; ++i)
#pragma unroll
        for (int j = 0; j < 2; ++j) { sum[2 * j] += bf_lo(xr[i][j]); sum[2 * j + 1] += bf_hi(xr[i][j]); }
#pragma unroll
    for (int i = 0; i < 16; ++i) {
        const int s = s0 + i; const float inv = 1.0f / (float)((s + 1 < W) ? (s + 1) : W);
        float o[4];
#pragma unroll
        for (int j = 0; j < 2; ++j) { const float a = bf_lo(xr[W - 1 + i][j]), c = bf_hi(xr[W - 1 + i][j]);
            sum[2 * j] += a; sum[2 * j + 1] += c; o[2 * j] = sum[2 * j] * inv - a; o[2 * j + 1] = sum[2 * j + 1] * inv - c;
            sum[2 * j] -= bf_lo(xr[i][j]); sum[2 * j + 1] -= bf_hi(xr[i][j]); }
#if defined(ABL_POOL)
        o[0] = o[1] = o[2] = o[3] = 0.f;
#endif
        *(GAS v2u*)(mix + (size_t)(b * SEQ + s) * 1024 + 512 + c0) = (v2u){pk2(o[0], o[1]), pk2(o[2], o[3])};
    }
}

__global__ void __launch_bounds__(NWAVES * 64, 2) fwd(Args a_in) {
    extern __shared__ __attribute__((aligned(16))) unsigned char lds_raw[];
    LAS unsigned char* lds = (LAS unsigned char*)lds_raw;
    volatile LAS unsigned* MISC = (volatile LAS unsigned*)(lds + MISC_OFF);
    const int tid = threadIdx.x, lane = tid & 63, wave = __builtin_amdgcn_readfirstlane(tid >> 6);
    const int G = gridDim.x, bx = blockIdx.x;
    const int gw = bx * NWAVES + wave, NGW = G * NWAVES;
    typedef const __attribute__((address_space(4))) Args CArgs;
#define PHASE_ENV() CArgs* ap_ = (CArgs*)__builtin_amdgcn_kernarg_segment_ptr(); asm volatile("" : "+s"(ap_)); CArgs& a = *ap_; \
    unsigned char* const ws = a.ws; float* const ssqA = (float*)(ws + WS_SSQA); float* const ssqB = (float*)(ws + WS_SSQB); \
    bf16* const xb = (bf16*)(ws + WS_XB); bf16* const xb1 = (bf16*)(ws + WS_XB1); bf16* const pb = (bf16*)(ws + WS_PB); unsigned char* const R = ws + WS_R; \
    bf16* const qb = (bf16*)(R + R_Q); bf16* const kb = (bf16*)(R + R_K); bf16* const vb = (bf16*)(R + R_V); bf16* const gb = (bf16*)(R + R_G); bf16* const uwb = (bf16*)(R + R_UW); \
    bf16* const kvb = (bf16*)(R + R_KV); bf16* const mix = (bf16*)(R + R_MIX); bf16* const hmid = (bf16*)(R + R_H); bf16* const eb = (bf16*)(R + R_E); float* const utmp = (float*)(R + R_UT); \
    (void)ssqA; (void)ssqB; (void)xb; (void)xb1; (void)pb; (void)qb; (void)kb; (void)vb; (void)gb; (void)uwb; (void)kvb; (void)mix; (void)hmid; (void)eb; (void)utmp
    gu32* ctl = (gu32*)(a_in.ws + WS_CTL);
    for (int u = tid; u < (LDS_BYTES - LDSCTL_OFF) / 4; u += NWAVES * 64) ((LAS unsigned*)(lds + LDSCTL_OFF))[u] = 0u;
    __syncthreads();
    XcdBarrier bar = xcd_barrier_post((unsigned*)(ctl + CW_BAR), MISC + 8);

#ifndef PHMASK
#define PHMASK 0xFFFF
#endif
#define PH(n) ((PHMASK >> (n)) & 1)
#define FRESH_TID(name) int name = threadIdx.x; asm volatile("" : "+v"(name))
#ifndef REP_P0
#define REP_P0 1
#endif
#pragma unroll 1
    for (int rep0_ = 0; rep0_ < REP_P0; ++rep0_) {
    if (PH(0)) { PHASE_ENV();
    for (int task = gw; task < DEPTH * 4 * 2 * 128; task += NGW) {
        const int kb8 = task & 127, dh = (task >> 7) & 1, g = (task >> 8) & 3, L = task >> 10;
        const int d = dh * 64 + lane;
        const float* pw = a.pool_w + (size_t)((L * 4 + g) * 128) * 128 + d;
        const float* wi = a.w_in + (size_t)(L * 1024 + kb8 * 8) * INW + 2048 + g * 128;
        float acc[8];
#pragma unroll
        for (int i = 0; i < 8; ++i) acc[i] = 0.f;
#pragma unroll 4
        for (int c = 0; c < 128; ++c) { const float bv = pw[(size_t)c * 128];
#pragma unroll
            for (int i = 0; i < 8; ++i) acc[i] += wi[(size_t)i * INW + c] * bv; }
        const float sc = a.pool_scale[L * 512 + g * 128 + d];
#pragma unroll
        for (int i = 0; i < 8; ++i) utmp[(size_t)(L * 1024 + kb8 * 8 + i) * 512 + g * 128 + d] = acc[i] * sc;
    }
    }
    xcd_barrier(bar);

    if (PH(1)) { PHASE_ENV();
        LAS float* scr = (LAS float*)(lds + wave * 16384);
        constexpr int I_IN = 16 * 80, I_OUT = 16 * 32, I_GU = 16 * 176, I_DN = 44 * 32, I_PG = 16 * 32, I_PP = 4 * 32, I_L = I_IN + I_OUT + I_GU + I_DN + I_PG + I_PP;
        for (int it = gw; it < DEPTH * I_L; it += NGW) {
            const int L = it / I_L; int r = it % I_L;
            unsigned char* wl = ws + WS_W + (size_t)L * W_LAYER;
            if (r < I_IN) { const int kbk = r / 80, nb = r % 80, n0 = 32 * nb, k0 = 64 * kbk; const float* gn = a.g_mix + L * 1024;
                if (n0 < 1024) { const int sec = n0 >> 9, w = n0 & 511, t = w >> 8, bj = (w >> 7) & 1, hh = (w >> 6) & 1, dd0 = w & 63;
                    tr_item(a.w_in + (size_t)L * 1024 * INW, INW, sec * 512 + (2 * t + hh) * 128 + bj * 64 + dd0, k0, gn, sec == 0 ? 0.08838834764831845f : 1.0f, (bf16*)(wl + WO_IN), 1024, n0, scr, lane); }
                else if (n0 < 2048) tr_item(a.w_in + (size_t)L * 1024 * INW, INW, n0, k0, gn, 1.0f, (bf16*)(wl + WO_IN), 1024, n0, scr, lane);
                else tr_item(utmp + (size_t)L * 1024 * 512, 512, n0 - 2048, k0, gn, 1.0f, (bf16*)(wl + WO_IN), 1024, n0, scr, lane);
                continue; } r -= I_IN;
            if (r < I_OUT) { const int kbk = r / 32, nb = r % 32; tr_item(a.w_out + (size_t)L * 1024 * 1024, 1024, 32 * nb, 64 * kbk, nullptr, 1.0f, (bf16*)(wl + WO_OUT), 1024, 32 * nb, scr, lane); continue; } r -= I_OUT;
            if (r < I_GU) { const int kbk = r / 176, nb = r % 176, n0 = 32 * nb, t = n0 >> 8, bj = (n0 >> 7) & 1, j0 = n0 & 127;
                tr_item((bj ? a.w_up : a.w_gate) + (size_t)L * 1024 * FF, FF, 128 * t + j0, 64 * kbk, a.g_ffn + L * 1024, 1.0f, (bf16*)(wl + WO_GU), 1024, n0, scr, lane); continue; } r -= I_GU;
            if (r < I_DN) { const int kbk = r / 32, nb = r % 32; tr_item(a.w_down + (size_t)L * FF * 1024, 1024, 32 * nb, 64 * kbk, nullptr, 1.0f, (bf16*)(wl + WO_DOWN), FF, 32 * nb, scr, lane); continue; } r -= I_DN;
            if (r < I_PG) { const int kbk = r / 32, nb = r % 32; tr_item(a.w_ple_gate + (size_t)L * 1024 * 1024, 1024, 32 * nb, 64 * kbk, a.g_ple + L * 1024, 1.0f, (bf16*)(wl + WO_PG), 1024, 32 * nb, scr, lane); continue; } r -= I_PG;
            { const int kbk = r / 32, nb = r % 32; tr_item(a.w_ple_proj + (size_t)L * PLE * 1024, 1024, 32 * nb, 64 * kbk, nullptr, 1.0f, (bf16*)(wl + WO_PP), PLE, 32 * nb, scr, lane); }
        }
        for (int m = 2 * gw; m < M; m += 2 * NGW) {
            const GAS f32x4* xr = (const GAS f32x4*)(a.x + (size_t)m * D) + lane; GAS v2u* o8 = (GAS v2u*)(xb1 + (size_t)m * D) + lane;
            f32x4 v[8];
#pragma unroll
            for (int j = 0; j < 8; ++j) v[j] = __builtin_nontemporal_load(xr + 64 * j);
            float ss0 = 0.f, ss1 = 0.f;
#pragma unroll
            for (int j = 0; j < 4; ++j) { ss0 += (v[j][0] * v[j][0] + v[j][1] * v[j][1]) + (v[j][2] * v[j][2] + v[j][3] * v[j][3]); o8[64 * j] = (v2u){pk2(v[j][0], v[j][1]), pk2(v[j][2], v[j][3])}; }
#pragma unroll
            for (int j = 4; j < 8; ++j) { ss1 += (v[j][0] * v[j][0] + v[j][1] * v[j][1]) + (v[j][2] * v[j][2] + v[j][3] * v[j][3]); o8[64 * j] = (v2u){pk2(v[j][0], v[j][1]), pk2(v[j][2], v[j][3])}; }
            ss0 = wave_sum(ss0); ss1 = wave_sum(ss1);
            if (lane < 32) ssqB[(size_t)m * 16 + lane] = (lane == 0) ? ss0 : (lane == 16) ? ss1 : 0.f;
        }
        for (size_t i = (size_t)bx * 512 + tid; i < (size_t)M * PLE / 8; i += (size_t)G * 512) {
            const f32x4 v0 = ((const GAS f32x4*)a.p)[2 * i], v1 = ((const GAS f32x4*)a.p)[2 * i + 1];
            ((GAS v4u*)pb)[i] = (v4u){pk2(v0[0], v0[1]), pk2(v0[2], v0[3]), pk2(v1[0], v1[1]), pk2(v1[2], v1[3])};
        }
    }
    xcd_barrier(bar);
    }


#if defined(PROBE)
#define PROBE_POINT(n) if ((n) == PROBE_AT && L == PROBE_L) { \
            PHASE_ENV(); unsigned* flag = (unsigned*)(ws + WS_CTL) + 64; unsigned mask = 0u; \
            const size_t gt = (size_t)bx * 512 + threadIdx.x, GT = (size_t)G * 512; \
            SCAN_BF(xb1, (size_t)M * D, 0) SCAN_BF(ws + WS_W, (size_t)DEPTH * W_LAYER / 2, 1) SCAN_F32(ssqB, (size_t)M * 16, 2) \
            SCAN_BF(qb, (size_t)M * 512, 3) SCAN_BF(kb, (size_t)M * 512, 4) SCAN_BF(vb, (size_t)M * 512, 5) SCAN_BF(gb, (size_t)M * 512, 6) SCAN_BF(uwb, (size_t)M * 512, 7) \
            if (PROBE_AT >= 2) { SCAN_BF(kvb, (size_t)M * 512, 8) } \
            if (PROBE_AT >= 4) { for (size_t i = gt; i < (size_t)M * 512; i += GT) { const size_t r = i >> 9, c = i & 511; const unsigned w = ((const GAS unsigned*)mix)[r * 512 + c]; if (BADBF(w)) mask |= 1u << (c < 256 ? 9 : 10); } } \
            if (PROBE_AT >= 5) { SCAN_F32(a.out, (size_t)M * D, 11) SCAN_F32(ssqA, (size_t)M * 16, 12) SCAN_BF(xb, (size_t)M * D, 13) } \
            if (PROBE_AT >= 6) { SCAN_BF(hmid, (size_t)M * FF, 14) } \
            if (PROBE_AT >= 7) { SCAN_BF(eb, (size_t)M * D, 15) } \
            if (mask) atomicOr(flag, mask); \
            xcd_barrier(bar); \
            const unsigned mres = __hip_atomic_load(flag, RLX_AGENT); \
            float val = 0.5f; for (int i = 15; i >= 0; --i) if ((mres >> i) & 1u) val = (float)(2u << i); \
            for (size_t i = gt; i < (size_t)M * D; i += GT) a.out[i] = val; \
            return; }
#define BADBF1(h) ((((h) & 0x7f80u) == 0x7f80u) || (((h) & 0x7f80u) > 0x4e00u))
#define BADBF(w) (BADBF1((w) & 0xffffu) || BADBF1((w) >> 16))
#define SCAN_BF(ptr, n, bit) for (size_t i = gt; i < (size_t)(n) / 2; i += GT) { const unsigned w = ((const GAS unsigned*)(ptr))[i]; if (BADBF(w)) mask |= 1u << (bit); }
#define SCAN_F32(ptr, n, bit) for (size_t i = gt; i < (size_t)(n); i += GT) { const unsigned w = ((const GAS unsigned*)(ptr))[i]; if ((w & 0x7f800000u) >= 0x4e000000u) mask |= 1u << (bit); }
#else
#define PROBE_POINT(n)
#endif

#if defined(PROBE_CHK)
#define CHK_ACC(got, want, sec) do { const float e_ = __builtin_fabsf((got) - (want)), w_ = __builtin_fabsf(want); cerr[sec] = e_ > cerr[sec] ? e_ : cerr[sec]; cmax[sec] = w_ > cmax[sec] ? w_ : cmax[sec]; } while (0)
#define CHK_FINISH() do { unsigned* flag = (unsigned*)(ws + WS_CTL) + 64; \
            for (int i_ = 0; i_ < 4; ++i_) { atomicMax(flag + 64 * i_, __builtin_bit_cast(unsigned, cerr[i_])); atomicMax(flag + 64 * (4 + i_), __builtin_bit_cast(unsigned, cmax[i_])); } \
            xcd_barrier(bar); unsigned mask_ = 0u; \
            for (int i_ = 0; i_ < 4; ++i_) { const float e_ = __builtin_bit_cast(float, __hip_atomic_load(flag + 64 * i_, RLX_AGENT)), w_ = __builtin_bit_cast(float, __hip_atomic_load(flag + 64 * (4 + i_), RLX_AGENT)); if (!(e_ <= CHK_TOL * w_)) mask_ |= 1u << i_; } \
            const float val_ = 100.0f * (float)(16u + mask_); \
            for (size_t i_ = (size_t)bx * 512 + threadIdx.x; i_ < (size_t)M * D; i_ += (size_t)G * 512) a.out[i_] = val_; return; } while (0)
#ifndef CHK_TOL
#define CHK_TOL 0.05f
#endif
#endif
    for (int L = 0; L < DEPTH; ++L) {

#ifndef REP_P1
#define REP_P1 1
#endif
#pragma unroll 1
        for (int rep_ = 0; rep_ < REP_P1; ++rep_) {
        if (PH(2)) {
            PHASE_ENV(); const unsigned char* wl = ws + WS_W + (size_t)L * W_LAYER; (void)wl; FRESH_TID(ptid); pg8::Gemm g{xb1, (const bf16*)(wl + WO_IN), M, INW, D}; pg8::StaticOrder S; S.init(M, INW, G, bx);
            PG8_LAS float* side = (PG8_LAS float*)(lds + SIDE_OFF); const int npu = (S.nwg + G - 1) / G;     PG8_LAS float* posf = side + npu * 256; PG8_LAS float* rope = posf + npu * 256;
            pg8::fill_rstd(S, ssqB, side, a.pos, posf, ptid); if (ptid < 64) { rope[ptid] = ROPE_HI[ptid]; rope[64 + ptid] = ROPE_LO[ptid]; } __syncthreads();
            pg8::EpiInProj E{side, posf, rope, qb, kb, vb, gb, uwb};
            pg8::gemm_phase<pg8::EpiInProj, pg8::StaticOrder, true, true>(lds, g, S, E, ptid);
        }
        xcd_barrier(bar);
        PROBE_POINT(1)

#if defined(PROBE_CHK) && PROBE_CHK == 1
        if (L == 0) {
            PHASE_ENV(); float cerr[4] = {0.f, 0.f, 0.f, 0.f}, cmax[4] = {0.f, 0.f, 0.f, 0.f};
            float* ubuf = ssqA;
            const int gt = bx * 512 + threadIdx.x;
            for (int idx = gt; idx < 128 * 2560; idx += G * 512) {
                const int si = idx / 2560, c = idx % 2560, r = (si * 257 + 11) * 61 % M, bb = r >> 12, s = r & 4095;
                if (c < 1024 && (c & 64)) continue;
                const float* xr = a.x + (size_t)r * D; const float* W = a.w_in; const float* gm = a.g_mix;
                float ss = 0.f, d1 = 0.f, d2 = 0.f;
                for (int k = 0; k < D; ++k) { const float xv = xr[k]; ss += xv * xv; const float xg = xv * gm[k]; d1 += xg * W[(size_t)k * INW + c]; if (c < 1024) d2 += xg * W[(size_t)k * INW + c + 64]; }
                const float rstd = 1.0f / sqrtf(ss / 1024.0f + EPS); d1 *= rstd; d2 *= rstd;
                if (c < 1024) {
                    const int sec = c >> 9, h = (c >> 7) & 3, d = c & 63;
                    const float inv = powf(10000.0f, -(float)d / 64.0f), ang = (float)a.pos[r] * inv, cs = cosf(ang), sn = sinf(ang);
                    float o1 = d1 * cs - d2 * sn, o2 = d2 * cs + d1 * sn;
                    const float f = sec ? exp2f((float)(127 - (s & 127)) * lg2gamma(h)) : 0.08838834764831845f; o1 *= f; o2 *= f;
                    const bf16* src = (sec ? kb : qb) + ((size_t)((bb * NH + h) * SEQ + s)) * 128 + d;
                    CHK_ACC(bf_lo((unsigned)src[0]), o1, sec); CHK_ACC(bf_lo((unsigned)src[64]), o2, sec);
                } else if (c < 2048) {
                    const int sec = (c - 1024) >> 9, cc = c & 511, h = cc >> 7, d = cc & 127;
                    const bf16* src = (sec ? gb : vb) + ((size_t)((bb * NH + h) * SEQ + s)) * 128 + d;
                    CHK_ACC(bf_lo((unsigned)src[0]), d1, 2);
                } else ubuf[si * 512 + (c - 2048)] = d1;
            }
            xcd_barrier(bar);
            for (int idx = gt; idx < 128 * 512; idx += G * 512) {
                const int si = idx >> 9, j = idx & 511, g = j >> 7, d = j & 127, r = (si * 257 + 11) * 61 % M;
                float acc = 0.f; for (int c = 0; c < 128; ++c) acc += ubuf[si * 512 + g * 128 + c] * a.pool_w[((size_t)(g * 128 + c)) * 128 + d];
                acc *= a.pool_scale[j];
                CHK_ACC(bf_lo((unsigned)uwb[(size_t)r * 512 + j]), acc, 3);
            }
            CHK_FINISH();
        }
#endif

#if defined(PROBE_MAG)
        if (L == 0) {
            PHASE_ENV(); unsigned* flag = (unsigned*)(ws + WS_CTL) + 64; unsigned mk = 0u, mv = 0u;
            const size_t gt = (size_t)bx * 512 + threadIdx.x, GT = (size_t)G * 512;
            for (size_t i = gt; i < (size_t)M * 256; i += GT) { const unsigned w = ((const GAS unsigned*)PROBE_A)[i], x = ((const GAS unsigned*)PROBE_B)[i];
                const unsigned a0 = (w & 0x7fffu) << 16, a1 = w & 0x7fff0000u, b0 = (x & 0x7fffu) << 16, b1 = x & 0x7fff0000u; mk = max(mk, max(a0, a1)); mv = max(mv, max(b0, b1)); }
            atomicMax(flag, mk); atomicMax(flag + 64, mv);
            xcd_barrier(bar);
            const float fk = __builtin_bit_cast(float, __hip_atomic_load(flag, RLX_AGENT)), fv = __builtin_bit_cast(float, __hip_atomic_load(flag + 64, RLX_AGENT));
            for (size_t i = gt; i < (size_t)M * D; i += GT) a.out[i] = (i < (size_t)M * D / 2) ? fk : fv;
            return;
        }
#endif

        }
#if !defined(RET_RECURRENT)
#ifndef REP_RET
#define REP_RET 1
#endif
#pragma unroll 1
        for (int rep_ = 0; rep_ < REP_RET; ++rep_) {
        if (PH(3)) { PHASE_ENV();
            FRESH_TID(t_); const int tid = t_, lane = t_ & 63, wave = __builtin_amdgcn_readfirstlane(t_ >> 6); (void)tid; (void)lane; (void)wave;
            for (int it = bx; it < BATCH * NCH; it += G) {
                const int b = it >> 5, n = it & 31, gi = wave & 3, half = wave >> 2;
#pragma unroll 1
                for (int ps = 0; ps < 2; ++ps) {
                    const int s0 = n * 128 + half * 64 + ps * 32 + (lane >> 5) * 16, c0 = gi * 128 + (lane & 31) * 4;
                    if (gi == 0) pool_rows<2>(uwb, mix, b, s0, c0); else if (gi == 1) pool_rows<4>(uwb, mix, b, s0, c0); else if (gi == 2) pool_rows<8>(uwb, mix, b, s0, c0); else pool_rows<16>(uwb, mix, b, s0, c0);
                }
            }
            for (int u = bx; u < BATCH * NH * NCH; u += G) {
                const bf16* kt = kb + (size_t)u * 16384; const bf16* vt = vb + (size_t)u * 16384;
                v4u ra[4], rb[4];
#pragma unroll
                for (int i = 0; i < 4; ++i) { const int c = tid + 512 * i; ra[i] = ((const GAS v4u*)kt)[c]; rb[i] = ((const GAS v4u*)vt)[c]; }
#pragma unroll
                for (int i = 0; i < 4; ++i) { const unsigned c = tid + 512 * i, o = off_b(c >> 4, c & 15); *(LAS v4u*)(lds + o) = ra[i]; *(LAS v4u*)(lds + 32768 + o) = rb[i]; }
                __syncthreads();
                const int dt = wave >> 1, et0 = (wave & 1) * 2;
                f32x16 acc0, acc1;
#pragma unroll
                for (int r = 0; r < 16; ++r) { acc0[r] = 0.f; acc1[r] = 0.f; }
#pragma unroll
                for (int ks = 0; ks < 8; ++ks) {
                    const bf16x8 A = cat4(tr_read(lds + tr_addr_nat(lane, dt, ks, 0)), tr_read(lds + tr_addr_nat(lane, dt, ks, 1)));
                    const bf16x8 B0 = cat4(tr_read(lds + 32768 + tr_addr_nat(lane, et0, ks, 0)), tr_read(lds + 32768 + tr_addr_nat(lane, et0, ks, 1)));
                    const bf16x8 B1 = cat4(tr_read(lds + 32768 + tr_addr_nat(lane, et0 + 1, ks, 0)), tr_read(lds + 32768 + tr_addr_nat(lane, et0 + 1, ks, 1)));
                    acc0 = __builtin_amdgcn_mfma_f32_32x32x16_bf16(A, B0, acc0, 0, 0, 0);
                    acc1 = __builtin_amdgcn_mfma_f32_32x32x16_bf16(A, B1, acc1, 0, 0, 0);
                }
                bf16* kvt = kvb + (size_t)u * 16384;
#pragma unroll
                for (int s = 0; s < 2; ++s) {
                    *(GAS bf16x8*)(kvt + ((dt * 4 + et0) * 2 + s) * 512 + lane * 8) = pack_acc(acc0, s);
                    *(GAS bf16x8*)(kvt + ((dt * 4 + et0 + 1) * 2 + s) * 512 + lane * 8) = pack_acc(acc1, s);
                }
                __syncthreads();
            }
            if (L > 0) {
                const GAS f32x4* ps = (const GAS f32x4*)(a.p + (size_t)L * M * PLE);
                for (size_t i = (size_t)bx * 512 + tid; i < (size_t)M * PLE / 8; i += (size_t)G * 512) {
                    const f32x4 v0 = ps[2 * i], v1 = ps[2 * i + 1];
                    ((GAS v4u*)pb)[i] = (v4u){pk2(v0[0], v0[1]), pk2(v0[2], v0[3]), pk2(v1[0], v1[1]), pk2(v1[2], v1[3])};
                }
            }
        }
        xcd_barrier(bar);
        PROBE_POINT(2)

#if defined(PROBE_KV)
        if (L == 0) {
            PHASE_ENV(); unsigned* flag = (unsigned*)(ws + WS_CTL) + 64; unsigned mk = 0u, cnt = 0u;
            const size_t gt = (size_t)bx * 512 + threadIdx.x, GT = (size_t)G * 512;
            for (size_t i = gt; i < (size_t)M * 256; i += GT) { const unsigned w = ((const GAS unsigned*)kvb)[i];
                const unsigned a0 = (w & 0x7fffu) << 16, a1 = w & 0x7fff0000u; if (a0 >= 0x7f800000u) ++cnt; else mk = max(mk, a0); if (a1 >= 0x7f800000u) ++cnt; else mk = max(mk, a1); }
            atomicMax(flag, mk); atomicAdd(flag + 64, cnt);
            xcd_barrier(bar);
            const float fk = __builtin_bit_cast(float, __hip_atomic_load(flag, RLX_AGENT)), fc = 1000.0f * (float)__hip_atomic_load(flag + 64, RLX_AGENT) / (float)((size_t)M * 512);
            for (size_t i = gt; i < (size_t)M * D; i += GT) a.out[i] = (i < (size_t)M * D / 2) ? fc : fk;
            return;
        }
#endif

        if (PH(4)) { PHASE_ENV(); FRESH_TID(t_); const int tid = t_, lane = t_ & 63, wave = __builtin_amdgcn_readfirstlane(t_ >> 6); (void)tid; (void)lane; (void)wave;
        for (int c = bx * 512 + tid; c < BATCH * NH * 4096; c += G * 512) {
            const int bh = c >> 12; const float cd = __builtin_amdgcn_exp2f(128.0f * lg2gamma(bh & 3));
            GAS v2u* base = (GAS v2u*)(kvb + (size_t)bh * NCH * 16384) + (c & 4095);
            v2u t[NCH];
#pragma unroll
            for (int n = 0; n < NCH; ++n) t[n] = base[(size_t)n * 4096];
            float r0 = 0.f, r1 = 0.f, r2 = 0.f, r3 = 0.f;
#pragma unroll
            for (int n = 0; n < NCH; ++n) {
                const v2u in = t[n];
                base[(size_t)n * 4096] = (v2u){pk2(r0, r1), pk2(r2, r3)};
                r0 = cd * (r0 + bf_lo(in[0])); r1 = cd * (r1 + bf_hi(in[0])); r2 = cd * (r2 + bf_lo(in[1])); r3 = cd * (r3 + bf_hi(in[1]));
            }
        }
        }
        xcd_barrier(bar);
        PROBE_POINT(3)

#if defined(P4_OLD)
        if (PH(5)) { PHASE_ENV(); FRESH_TID(t_); const int tid = t_, lane = t_ & 63, wave = __builtin_amdgcn_readfirstlane(t_ >> 6); (void)tid; (void)lane; (void)wave;
        for (int up = bx; up < BATCH * NCH * 2; up += G) {
            const int hp = up & 1, n = (up >> 1) & 31, b = up >> 6;
            {
                v4u rg[16];
#pragma unroll
                for (int ti = 0; ti < 4; ++ti) { const int bh = b * NH + 2 * hp + (ti >> 1); const bf16* src = ((ti & 1) ? vb : kb) + ((size_t)bh * SEQ + n * 128) * 128;
#pragma unroll
                    for (int i = 0; i < 4; ++i) rg[ti * 4 + i] = ((const GAS v4u*)src)[tid + 512 * i]; }
#pragma unroll
                for (int ti = 0; ti < 4; ++ti)
#pragma unroll
                    for (int i = 0; i < 4; ++i) { const unsigned c = tid + 512 * i; *(LAS v4u*)(lds + ti * 32768 + off_b(c >> 4, c & 15)) = rg[ti * 4 + i]; }
            }
            __syncthreads();
            {
                const int us = wave >> 2, qt = wave & 3, h = 2 * hp + us, bh = b * NH + h, ql = lane & 31, hh = lane >> 5;
                LAS unsigned char* kzl = lds + us * 65536; LAS unsigned char* vl = kzl + 32768;
                const size_t tok = (size_t)bh * SEQ + n * 128 + 32 * qt + ql;
                bf16x8 qf[4][2];
#pragma unroll
                for (int dt = 0; dt < 4; ++dt)
#pragma unroll
                    for (int s = 0; s < 2; ++s) { const bf16* qp = qb + tok * 128 + 32 * dt + 16 * s + 4 * hh;
                        const v2u lo = *(const GAS v2u*)qp, hi = *(const GAS v2u*)(qp + 8); qf[dt][s] = __builtin_bit_cast(bf16x8, (v4u){lo[0], lo[1], hi[0], hi[1]}); }
                bf16x8 pf[4][2];
#pragma unroll
                for (int kt = 0; kt < 4; ++kt) {
                    if (kt <= qt) {
                        f32x16 sa;
#pragma unroll
                        for (int r = 0; r < 16; ++r) sa[r] = 0.f;
                        const unsigned krow = 32 * kt + ql;
#pragma unroll
                        for (int dt = 0; dt < 4; ++dt)
#pragma unroll
                            for (int s = 0; s < 2; ++s) {
                                const v2u lo = *(const LAS v2u*)(kzl + off_b(krow, 4 * dt + 2 * s) + 8 * hh), hi = *(const LAS v2u*)(kzl + off_b(krow, 4 * dt + 2 * s + 1) + 8 * hh);
                                sa = __builtin_amdgcn_mfma_f32_32x32x16_bf16(__builtin_bit_cast(bf16x8, (v4u){lo[0], lo[1], hi[0], hi[1]}), qf[dt][s], sa, 0, 0, 0); }
                        if (kt == qt) {
#pragma unroll
                            for (int r = 0; r < 16; ++r) sa[r] = (crow(r, hh) > ql) ? 0.f : sa[r];
                        }
                        pf[kt][0] = pack_acc(sa, 0); pf[kt][1] = pack_acc(sa, 1);
                    } else { pf[kt][0] = (bf16x8){0, 0, 0, 0, 0, 0, 0, 0}; pf[kt][1] = (bf16x8){0, 0, 0, 0, 0, 0, 0, 0}; }
                }
                const bf16* stt = kvb + ((size_t)bh * NCH + n) * 16384;
                f32x16 oacc[4];
#pragma unroll
                for (int et = 0; et < 4; ++et) {
                    f32x16 o;
#pragma unroll
                    for (int r = 0; r < 16; ++r) o[r] = 0.f;
                    bf16x8 sf[4][2];
#pragma unroll
                    for (int dt = 0; dt < 4; ++dt)
#pragma unroll
                        for (int s = 0; s < 2; ++s) sf[dt][s] = *(const GAS bf16x8*)(stt + ((dt * 4 + et) * 2 + s) * 512 + lane * 8);
#pragma unroll
                    for (int kt = 0; kt < 4; ++kt) {
                        if (kt <= qt) {
#pragma unroll
                            for (int s = 0; s < 2; ++s) {
                                const bf16x8 vf = cat4(tr_read(vl + tr_addr_perm(lane, et, 2 * kt + s, 0)), tr_read(vl + tr_addr_perm(lane, et, 2 * kt + s, 1)));
                                o = __builtin_amdgcn_mfma_f32_32x32x16_bf16(vf, pf[kt][s], o, 0, 0, 0); }
                        }
                    }
#pragma unroll
                    for (int dt = 0; dt < 4; ++dt)
#pragma unroll
                        for (int s = 0; s < 2; ++s) o = __builtin_amdgcn_mfma_f32_32x32x16_bf16(sf[dt][s], qf[dt][s], o, 0, 0, 0);
                    oacc[et] = o;
                }
                const float rsc = __builtin_amdgcn_exp2f((float)(32 * qt + ql - 127) * lg2gamma(h));
                float ss = 0.f;
#pragma unroll
                for (int et = 0; et < 4; ++et)
#pragma unroll
                    for (int r = 0; r < 16; ++r) { const float y = oacc[et][r] * rsc; oacc[et][r] = y; ss += y * y; }
                ss = add_xor32(ss);
                const float rn = rsqrtf(ss * (1.0f / 128.0f) + EPS);
                const bf16* gp = gb + tok * 128 + 4 * hh;
                bf16* op = mix + ((size_t)b * SEQ + n * 128 + 32 * qt + ql) * 1024 + h * 128 + 4 * hh;
#pragma unroll
                for (int et = 0; et < 4; ++et)
#pragma unroll
                    for (int rg = 0; rg < 4; ++rg) {
                        const v2u gv = *(const GAS v2u*)(gp + 32 * et + 8 * rg);
                        float o[4];
#pragma unroll
                        for (int j = 0; j < 4; ++j) { const float gt = (j & 1) ? bf_hi(gv[j >> 1]) : bf_lo(gv[j >> 1]);
                            o[j] = gt * __builtin_amdgcn_rcpf(1.0f + __builtin_amdgcn_exp2f(-1.4426950408889634f * gt)) * (oacc[et][4 * rg + j] * rn); }
#if defined(ABL_RET)
                        o[0] = o[1] = o[2] = o[3] = 0.f;
#endif
                        *(GAS v2u*)(op + 32 * et + 8 * rg) = (v2u){pk2(o[0], o[1]), pk2(o[2], o[3])};
                    }
            }
            __syncthreads();
        }
        }
#else
        if (PH(5)) { PHASE_ENV(); FRESH_TID(t_); const int tid = t_, lane = t_ & 63, wave = __builtin_amdgcn_readfirstlane(t_ >> 6);
        LAS float* red = (LAS float*)(lds + SIDE_OFF);
        for (int u = bx; u < BATCH * NH * NCH; u += G) {
            const int bh = u >> 5, n = u & 31, h = bh & 3, b = bh >> 2;
            const int qt = wave & 3, eh = wave >> 2, ql = lane & 31, hh = lane >> 5;
            const size_t tile = ((size_t)bh * SEQ + n * 128) * 128;
            {
                v4u rg[16];
#pragma unroll
                for (int ti = 0; ti < 4; ++ti) { const bf16* src = (ti == 0 ? kb : ti == 1 ? vb : ti == 2 ? qb : gb) + tile;
#pragma unroll
                    for (int i = 0; i < 4; ++i) rg[ti * 4 + i] = ((const GAS v4u*)src)[tid + 512 * i]; }
#pragma unroll
                for (int ti = 0; ti < 4; ++ti)
#pragma unroll
                    for (int i = 0; i < 4; ++i) { const unsigned c = tid + 512 * i; *(LAS v4u*)(lds + ti * 32768 + off_b(c >> 4, c & 15)) = rg[ti * 4 + i]; }
            }
            const bf16* stt = kvb + (size_t)u * 16384;
            bf16x8 sf[2][4][2];
#pragma unroll
            for (int ei = 0; ei < 2; ++ei)
#pragma unroll
                for (int dt = 0; dt < 4; ++dt)
#pragma unroll
                    for (int s = 0; s < 2; ++s) sf[ei][dt][s] = *(const GAS bf16x8*)(stt + ((dt * 4 + 2 * eh + ei) * 2 + s) * 512 + lane * 8);
            __syncthreads();
            LAS unsigned char* kzl = lds; LAS unsigned char* vl = lds + 32768; LAS unsigned char* qlds = lds + 65536; LAS unsigned char* glds = lds + 98304;
            bf16x8 qf[4][2];
            { const unsigned qrow = 32u * qt + (unsigned)ql;
#pragma unroll
              for (int dt = 0; dt < 4; ++dt)
#pragma unroll
                for (int s = 0; s < 2; ++s) { const v2u lo = *(const LAS v2u*)(qlds + off_b(qrow, 4 * dt + 2 * s) + 8 * hh), hi = *(const LAS v2u*)(qlds + off_b(qrow, 4 * dt + 2 * s + 1) + 8 * hh);
                    qf[dt][s] = __builtin_bit_cast(bf16x8, (v4u){lo[0], lo[1], hi[0], hi[1]}); } }
            bf16x8 pf[4][2];
#pragma unroll
            for (int kt = 0; kt < 4; ++kt) {
                if (kt <= qt) {
                    f32x16 sa;
#pragma unroll
                    for (int r = 0; r < 16; ++r) sa[r] = 0.f;
                    const unsigned krow = 32 * kt + ql;
#pragma unroll
                    for (int dt = 0; dt < 4; ++dt)
#pragma unroll
                        for (int s = 0; s < 2; ++s) {
                            const v2u lo = *(const LAS v2u*)(kzl + off_b(krow, 4 * dt + 2 * s) + 8 * hh), hi = *(const LAS v2u*)(kzl + off_b(krow, 4 * dt + 2 * s + 1) + 8 * hh);
                            sa = __builtin_amdgcn_mfma_f32_32x32x16_bf16(__builtin_bit_cast(bf16x8, (v4u){lo[0], lo[1], hi[0], hi[1]}), qf[dt][s], sa, 0, 0, 0); }
                    if (kt == qt) {
#pragma unroll
                        for (int r = 0; r < 16; ++r) sa[r] = (crow(r, hh) > ql) ? 0.f : sa[r];
                    }
                    pf[kt][0] = pack_acc(sa, 0); pf[kt][1] = pack_acc(sa, 1);
                } else { pf[kt][0] = (bf16x8){0, 0, 0, 0, 0, 0, 0, 0}; pf[kt][1] = (bf16x8){0, 0, 0, 0, 0, 0, 0, 0}; }
            }
            f32x16 oacc[2];
#pragma unroll
            for (int ei = 0; ei < 2; ++ei) {
                const int et = 2 * eh + ei; f32x16 o;
#pragma unroll
                for (int r = 0; r < 16; ++r) o[r] = 0.f;
#pragma unroll
                for (int kt = 0; kt < 4; ++kt) {
                    if (kt <= qt) {
#pragma unroll
                        for (int s = 0; s < 2; ++s) {
                            const bf16x8 vf = cat4(tr_read(vl + tr_addr_perm(lane, et, 2 * kt + s, 0)), tr_read(vl + tr_addr_perm(lane, et, 2 * kt + s, 1)));
                            o = __builtin_amdgcn_mfma_f32_32x32x16_bf16(vf, pf[kt][s], o, 0, 0, 0); }
                    }
                }
#pragma unroll
                for (int dt = 0; dt < 4; ++dt)
#pragma unroll
                    for (int s = 0; s < 2; ++s) o = __builtin_amdgcn_mfma_f32_32x32x16_bf16(sf[ei][dt][s], qf[dt][s], o, 0, 0, 0);
                oacc[ei] = o;
            }
            const float rsc = __builtin_amdgcn_exp2f((float)(32 * qt + ql - 127) * lg2gamma(h));
            float ss = 0.f;
#pragma unroll
            for (int ei = 0; ei < 2; ++ei)
#pragma unroll
                for (int r = 0; r < 16; ++r) { const float y = oacc[ei][r] * rsc; oacc[ei][r] = y; ss += y * y; }
            ss = add_xor32(ss);
            if (hh == 0) red[eh * 128 + 32 * qt + ql] = ss;
            __syncthreads();
            const float rn = rsqrtf((red[32 * qt + ql] + red[128 + 32 * qt + ql]) * (1.0f / 128.0f) + EPS);
            { const unsigned yrow = 32u * qt + (unsigned)ql;
#pragma unroll
              for (int ei = 0; ei < 2; ++ei)
#pragma unroll
                for (int rg = 0; rg < 4; ++rg) {
                    const unsigned e0 = 32u * (2 * eh + ei) + 8u * rg + 4u * hh, ch = e0 >> 3, sub = (e0 & 7u) * 2u;
                    const v2u gv = *(const LAS v2u*)(glds + off_b(yrow, ch) + sub);
                    float o[4];
#pragma unroll
                    for (int j = 0; j < 4; ++j) { const float gt = (j & 1) ? bf_hi(gv[j >> 1]) : bf_lo(gv[j >> 1]);
                        o[j] = gt * __builtin_amdgcn_rcpf(1.0f + __builtin_amdgcn_exp2f(-1.4426950408889634f * gt)) * (oacc[ei][4 * rg + j] * rn); }
#if defined(ABL_RET)
                    o[0] = o[1] = o[2] = o[3] = 0.f;
#endif
                    *(LAS v2u*)(qlds + off_b(yrow, ch) + sub) = (v2u){pk2(o[0], o[1]), pk2(o[2], o[3])};
                } }
            __syncthreads();
            { bf16* orow = mix + ((size_t)b * SEQ + n * 128) * 1024 + h * 128;
#pragma unroll
              for (int i = 0; i < 4; ++i) { const unsigned c = tid + 512 * i, row = c >> 4, ch = c & 15; *(GAS v4u*)(orow + (size_t)row * 1024 + ch * 8) = *(const LAS v4u*)(qlds + off_b(row, ch)); } }
            __syncthreads();
        }
        }
#endif
        xcd_barrier(bar);
        PROBE_POINT(4)

        }
#else

        if (PH(3)) { PHASE_ENV();
            FRESH_TID(t_); const int tid = t_, lane = t_ & 63, wave = __builtin_amdgcn_readfirstlane(t_ >> 6); (void)tid;
            if (bx < 128 && G >= 256) {
                const int xcd = bx & 7, slot = bx >> 3, qg = slot & 3, bh = xcd * 4 + (slot >> 2), h = bh & 3, bb = bh >> 2;
                const int c = lane & 15, g = lane >> 4;
                const float lg = lg2gamma(h), cd = __builtin_amdgcn_exp2f(128.0f * lg);
                LAS unsigned char* ptl = lds + SIDE_OFF;
                LAS float* red = (LAS float*)(lds + SIDE_OFF + 32 * 272);
                const bf16* kbase = kb + (size_t)bh * SEQ * 128; const bf16* vbase = vb + (size_t)bh * SEQ * 128;
                const unsigned ldsb = (unsigned)__builtin_amdgcn_readfirstlane((int)(unsigned)(size_t)lds);
                LAS unsigned char* ql = lds + SIDE_OFF + 9728;
                LAS unsigned char* gl = ql + 8192;
                unsigned soff[4];
#pragma unroll
                for (int p = 0; p < 4; ++p) { const unsigned row = 4u * (unsigned)(wave * 4 + p) + ((unsigned)lane >> 4), pc = (unsigned)lane & 15u; soff[p] = 256u * row + 16u * (pc ^ (((row & 3u) << 2) | ((row >> 2) & 3u))); }
                unsigned soffq; { const unsigned row = 4u * (unsigned)wave + ((unsigned)lane >> 4), pc = (unsigned)lane & 15u; soffq = 256u * row + 16u * (pc ^ (((row & 3u) << 2) | ((row >> 2) & 3u))); }
#define PR_DMA(n_, buf_) do { const char* ks_ = (const char*)(kbase + (size_t)(n_) * 16384); const char* vs_ = (const char*)(vbase + (size_t)(n_) * 16384); \
                    _Pragma("unroll") for (int p_ = 0; p_ < 4; ++p_) { \
                        glds16(ks_ + soff[p_], ldsb + (unsigned)((buf_) * 65536 + (wave * 4 + p_) * 1024)); \
                        glds16(vs_ + soff[p_], ldsb + (unsigned)((buf_) * 65536 + 32768 + (wave * 4 + p_) * 1024)); } } while (0)
#define PR_DMAQ(n_) do { glds16((const char*)(qb + (tok0 + (size_t)(n_) * 128) * 128) + soffq, ldsb + (unsigned)(SIDE_OFF + 9728 + wave * 1024)); \
                    glds16((const char*)(gb + (tok0 + (size_t)(n_) * 128) * 128) + soffq, ldsb + (unsigned)(SIDE_OFF + 9728 + 8192 + wave * 1024)); } while (0)
                unsigned kta[2][8], vta[2];
#pragma unroll
                for (int t = 0; t < 2; ++t) { vta[t] = tr_addr16(lane, wave, 0, t); asm volatile("" : "+v"(vta[t]));
#pragma unroll
                    for (int dt = 0; dt < 8; ++dt) { kta[t][dt] = tr_addr16(lane, dt, 0, t); asm volatile("" : "+v"(kta[t][dt])); } }
                f32x4 st[8];
#pragma unroll
                for (int i = 0; i < 8; ++i) st[i] = (f32x4){0.f, 0.f, 0.f, 0.f};
                const size_t tok0 = (size_t)bh * SEQ + 32 * qg;
                PR_DMA(0, 0); PR_DMAQ(0);
                asm volatile("s_waitcnt vmcnt(0)" ::: "memory");
#pragma unroll 1
                for (int n = 0; n < NCH; ++n) {
                    const int buf = n & 1;
                    LAS unsigned char* kzl = lds + buf * 65536; LAS unsigned char* vl = kzl + 32768;
                    asm volatile("s_waitcnt vmcnt(2)" ::: "memory"); __builtin_amdgcn_s_barrier(); asm volatile("" ::: "memory");
                    if (n + 1 < NCH) PR_DMA(n + 1, buf ^ 1);
                    bf16x8 qf[2][4]; v2u gv[2];
#pragma unroll
                    for (int t2 = 0; t2 < 2; ++t2) { const unsigned qrow = 16u * t2 + (unsigned)c;
#pragma unroll
                        for (int s_ = 0; s_ < 4; ++s_) { const v2u lo_ = *(const LAS v2u*)(ql + off_b(qrow, 4 * s_ + (g >> 1)) + 8 * (g & 1)), hi_ = *(const LAS v2u*)(ql + off_b(qrow, 4 * s_ + 2 + (g >> 1)) + 8 * (g & 1));
                            qf[t2][s_] = __builtin_bit_cast(bf16x8, (v4u){lo_[0], lo_[1], hi_[0], hi_[1]}); }
                        gv[t2] = *(const LAS v2u*)(gl + off_b(qrow, 2 * wave + (g >> 1)) + 8 * (g & 1)); }
                    if (16 * wave <= 32 * qg + 31) {
                        f32x4 sa[2] = {(f32x4){0.f, 0.f, 0.f, 0.f}, (f32x4){0.f, 0.f, 0.f, 0.f}};
                        const unsigned krow = 16u * (unsigned)wave + (unsigned)c;
#pragma unroll
                        for (int s_ = 0; s_ < 4; ++s_) {
                            const v2u lo_ = *(const LAS v2u*)(kzl + off_b(krow, 4 * s_ + (g >> 1)) + 8 * (g & 1)), hi_ = *(const LAS v2u*)(kzl + off_b(krow, 4 * s_ + 2 + (g >> 1)) + 8 * (g & 1));
                            const bf16x8 af = __builtin_bit_cast(bf16x8, (v4u){lo_[0], lo_[1], hi_[0], hi_[1]});
                            sa[0] = __builtin_amdgcn_mfma_f32_16x16x32_bf16(af, qf[0][s_], sa[0], 0, 0, 0);
                            sa[1] = __builtin_amdgcn_mfma_f32_16x16x32_bf16(af, qf[1][s_], sa[1], 0, 0, 0); }
#pragma unroll
                        for (int t2 = 0; t2 < 2; ++t2) { const int qlc = 32 * qg + 16 * t2 + c;
#pragma unroll
                            for (int r = 0; r < 4; ++r) if (16 * wave + 4 * g + r > qlc) sa[t2][r] = 0.f;
                            *(LAS v2u*)(ptl + (16 * t2 + c) * 272 + (16 * wave + 4 * g) * 2) = (v2u){cvtpk(sa[t2][0], sa[t2][1]), cvtpk(sa[t2][2], sa[t2][3])}; }
                    }
                    bf16x8 sfr[4];
#pragma unroll
                    for (int s_ = 0; s_ < 4; ++s_) sfr[s_] = __builtin_bit_cast(bf16x8, (v4u){cvtpk(st[2 * s_][0], st[2 * s_][1]), cvtpk(st[2 * s_][2], st[2 * s_][3]), cvtpk(st[2 * s_ + 1][0], st[2 * s_ + 1][1]), cvtpk(st[2 * s_ + 1][2], st[2 * s_ + 1][3])});
                    asm volatile("s_waitcnt lgkmcnt(0)" ::: "memory"); __builtin_amdgcn_s_barrier(); asm volatile("" ::: "memory");
                    if (n + 1 < NCH) PR_DMAQ(n + 1);
                    bf16x8 vf[4];
#pragma unroll
                    for (int s_ = 0; s_ < 4; ++s_) vf[s_] = cat4(tr_read(vl + vta[0] + 8192 * s_), tr_read(vl + vta[1] + 8192 * s_));
                    f32x4 oa[2] = {(f32x4){0.f, 0.f, 0.f, 0.f}, (f32x4){0.f, 0.f, 0.f, 0.f}};
#pragma unroll
                    for (int t2 = 0; t2 < 2; ++t2) {
#pragma unroll
                        for (int s_ = 0; s_ < 4; ++s_) {
                            if (s_ <= qg) { const bf16x8 pfr = *(const LAS bf16x8*)(ptl + (16 * t2 + c) * 272 + (32 * s_ + 8 * g) * 2);
                                oa[t2] = __builtin_amdgcn_mfma_f32_16x16x32_bf16(vf[s_], pfr, oa[t2], 0, 0, 0); }
                            oa[t2] = __builtin_amdgcn_mfma_f32_16x16x32_bf16(sfr[s_], qf[t2][s_], oa[t2], 0, 0, 0); } }
                    float yv[2][4];
#pragma unroll
                    for (int t2 = 0; t2 < 2; ++t2) { const float rsc = __builtin_amdgcn_exp2f((float)(32 * qg + 16 * t2 + c - 127) * lg); float ss = 0.f;
#pragma unroll
                        for (int r = 0; r < 4; ++r) { yv[t2][r] = oa[t2][r] * rsc; ss += yv[t2][r] * yv[t2][r]; }
                        ss = add_xor32(add_xor16(ss));
                        if (g == 0) red[wave * 32 + 16 * t2 + c] = ss; }
#pragma unroll
                    for (int s_ = 0; s_ < 4; ++s_) {
#pragma unroll
                        for (int dt = 0; dt < 8; ++dt) { const bf16x8 kf = cat4(tr_read(kzl + kta[0][dt] + 8192 * s_), tr_read(kzl + kta[1][dt] + 8192 * s_));
                            st[dt] = __builtin_amdgcn_mfma_f32_16x16x32_bf16(kf, vf[s_], st[dt], 0, 0, 0); } }
#pragma unroll
                    for (int dt = 0; dt < 8; ++dt) st[dt] = st[dt] * cd;
#if defined(DUP_STATE)
                    {
                        f32x4 du[8];
#pragma unroll
                        for (int i = 0; i < 8; ++i) du[i] = (f32x4){0.f, 0.f, 0.f, 0.f};
#pragma unroll
                        for (int s_ = 0; s_ < 4; ++s_) {
#pragma unroll
                            for (int dt = 0; dt < 8; ++dt) { const bf16x8 kf = cat4(tr_read(kzl + kta[0][dt] + 8192 * s_), tr_read(kzl + kta[1][dt] + 8192 * s_));
                                du[dt] = __builtin_amdgcn_mfma_f32_16x16x32_bf16(kf, vf[s_], du[dt], 0, 0, 0); } }
#pragma unroll
                        for (int i = 0; i < 8; ++i) asm volatile("" :: "v"(du[i]));
                    }
#endif
                    asm volatile("s_waitcnt lgkmcnt(0)" ::: "memory"); __builtin_amdgcn_s_barrier(); asm volatile("" ::: "memory");
#pragma unroll
                    for (int t2 = 0; t2 < 2; ++t2) { float ss = 0.f;
#pragma unroll
                        for (int w_ = 0; w_ < 8; ++w_) ss += red[w_ * 32 + 16 * t2 + c];
                        const float rn = rsqrtf(ss * (1.0f / 128.0f) + EPS); const v2u gw_ = gv[t2]; float o[4];
#pragma unroll
                        for (int j = 0; j < 4; ++j) { const float gt = (j & 1) ? bf_hi(gw_[j >> 1]) : bf_lo(gw_[j >> 1]);
                            o[j] = gt * __builtin_amdgcn_rcpf(1.0f + __builtin_amdgcn_exp2f(-1.4426950408889634f * gt)) * (yv[t2][j] * rn); }
                        *(GAS v2u*)(mix + ((size_t)bb * SEQ + n * 128 + 32 * qg + 16 * t2 + c) * 1024 + h * 128 + 16 * wave + 4 * g) = (v2u){pk2(o[0], o[1]), pk2(o[2], o[3])}; }
                }
                asm volatile("s_waitcnt vmcnt(0)" ::: "memory"); __syncthreads();
#undef PR_DMAQ
#undef PR_DMA
            } else {
                const int pw = (G >= 256) ? bx - 128 : bx, PW = (G >= 256) ? G - 128 : G;
                for (int it = pw; it < BATCH * NCH; it += PW) {
                    const int b = it >> 5, n = it & 31, gi = wave & 3, half = wave >> 2;
#pragma unroll 1
                    for (int ps = 0; ps < 2; ++ps) {
                        const int s0 = n * 128 + half * 64 + ps * 32 + (lane >> 5) * 16, c0 = gi * 128 + (lane & 31) * 4;
                        if (gi == 0) pool_rows<2>(uwb, mix, b, s0, c0); else if (gi == 1) pool_rows<4>(uwb, mix, b, s0, c0); else if (gi == 2) pool_rows<8>(uwb, mix, b, s0, c0); else pool_rows<16>(uwb, mix, b, s0, c0);
                    }
                }
                if (L > 0) {
                    const GAS f32x4* ps = (const GAS f32x4*)(a.p + (size_t)L * M * PLE);
                    for (size_t i = (size_t)pw * 512 + tid; i < (size_t)M * PLE / 8; i += (size_t)PW * 512) {
                        const f32x4 v0 = __builtin_nontemporal_load(ps + 2 * i), v1 = __builtin_nontemporal_load(ps + 2 * i + 1);
                        ((GAS v4u*)pb)[i] = (v4u){pk2(v0[0], v0[1]), pk2(v0[2], v0[3]), pk2(v1[0], v1[1]), pk2(v1[2], v1[3])};
                    }
                }
            }
        }
        xcd_barrier(bar);
        PROBE_POINT(4)

#endif
        if (PH(6)) {
            PHASE_ENV(); const unsigned char* wl = ws + WS_W + (size_t)L * W_LAYER; (void)wl; FRESH_TID(ptid); pg8::Gemm g{mix, (const bf16*)(wl + WO_OUT), M, D, D}; pg8::StaticOrder S; S.init(M, D, G, bx);
            pg8::EpiResid E{xb1, xb, ssqA};
            pg8::gemm_phase<pg8::EpiResid, pg8::StaticOrder, true, true>(lds, g, S, E, ptid);
        }
        xcd_barrier(bar);
        PROBE_POINT(5)

#if defined(PROBE_CHK) && PROBE_CHK == 2
        if (L == 0) {
            PHASE_ENV(); float cerr[4] = {0.f, 0.f, 0.f, 0.f}, cmax[4] = {0.f, 0.f, 0.f, 0.f};
            const int tid_ = threadIdx.x, gt = bx * 512 + tid_;
            {
                LAS float* wj = (LAS float*)lds; LAS float* part = (LAS float*)(lds + 16384); LAS float* qs = (LAS float*)(lds + 16384 + 2048);
                const int h = bx & 3, bb = (bx >> 2) & 7, s = (bx * 977 + 123) & 4095, bh = bb * NH + h; const float lg = lg2gamma(h);
                if (tid_ < 128) qs[tid_] = bf_lo((unsigned)qb[((size_t)bh * SEQ + s) * 128 + tid_]);
                __syncthreads();
                for (int j = tid_; j < 4096; j += 512) { float w = 0.f;
                    if (j <= s) { const bf16* kr = kb + ((size_t)bh * SEQ + j) * 128; float dot = 0.f; for (int d = 0; d < 128; ++d) dot += qs[d] * bf_lo((unsigned)kr[d]);
                        w = dot * exp2f(((float)(s - j) - (float)(127 - (j & 127))) * lg); }
                    wj[j] = w; }
                __syncthreads();
                { const int e = tid_ & 127, jg = tid_ >> 7; float acc = 0.f;
                  for (int j = jg; j <= s; j += 4) acc += wj[j] * bf_lo((unsigned)vb[((size_t)bh * SEQ + j) * 128 + e]);
                  part[jg * 128 + e] = acc; }
                __syncthreads();
                if (tid_ < 128) { const float y = (part[tid_] + part[128 + tid_]) + (part[256 + tid_] + part[384 + tid_]); qs[tid_] = y; }
                __syncthreads();
                if (tid_ < 128) { float ss = 0.f; for (int e = 0; e < 128; ++e) ss += qs[e] * qs[e]; const float rn = 1.0f / sqrtf(ss / 128.0f + EPS);
                    const float gt_ = bf_lo((unsigned)gb[((size_t)bh * SEQ + s) * 128 + tid_]); const float ref = gt_ / (1.0f + expf(-gt_)) * qs[tid_] * rn;
                    CHK_ACC(bf_lo((unsigned)mix[((size_t)bb * SEQ + s) * 1024 + h * 128 + tid_]), ref, 0); }
                __syncthreads();
            }
            for (int idx = gt; idx < 2048 * 512; idx += G * 512) {
                const int si = idx >> 9, c = idx & 511, r = (si * 1031 + 5) % M, bb = r >> 12, s = r & 4095, w = 2 << (c >> 7);
                float sum = 0.f; int cnt = 0; for (int j = 0; j < w; ++j) if (s - j >= 0) { sum += bf_lo((unsigned)uwb[((size_t)bb * SEQ + s - j) * 512 + c]); ++cnt; }
                const float ref = sum / (float)cnt - bf_lo((unsigned)uwb[(size_t)r * 512 + c]);
                CHK_ACC(bf_lo((unsigned)mix[(size_t)r * 1024 + 512 + c]), ref, 1);
            }
            for (int idx = gt; idx < 128 * 1024; idx += G * 512) {
                const int si = idx >> 10, c = idx & 1023, r = (si * 257 + 11) * 61 % M;
                float acc = 0.f; for (int k = 0; k < 1024; ++k) acc += bf_lo((unsigned)mix[(size_t)r * 1024 + k]) * a.w_out[(size_t)k * 1024 + c];
                const float ref = a.x[(size_t)r * D + c] + acc;
                CHK_ACC(a.out[(size_t)r * D + c], ref, 2);
                if (c == 0) { float s2 = 0.f, s3 = 0.f; for (int k = 0; k < 1024; ++k) { const float v = a.out[(size_t)r * D + k]; s2 += v * v; } for (int k = 0; k < 16; ++k) s3 += ssqA[(size_t)r * 16 + k]; CHK_ACC(s3, s2, 3); }
            }
            CHK_FINISH();
        }
#endif

#if defined(DUP_P5)
        if (PH(6)) {
            PHASE_ENV(); const unsigned char* wl = ws + WS_W + (size_t)L * W_LAYER; FRESH_TID(ptid); pg8::Gemm g{mix, (const bf16*)(wl + WO_OUT), M, D, D}; pg8::StaticOrder S; S.init(M, D, G, bx);
            pg8::EpiPlain E{hmid, D};
            pg8::gemm_phase<pg8::EpiPlain, pg8::StaticOrder, true, true>(lds, g, S, E, ptid);
        }
        xcd_barrier(bar);
#endif
#ifndef REP_P6
#define REP_P6 1
#endif
#pragma unroll 1
        for (int rep_ = 0; rep_ < REP_P6; ++rep_) {
        if (PH(7)) {
            PHASE_ENV(); const unsigned char* wl = ws + WS_W + (size_t)L * W_LAYER; (void)wl; FRESH_TID(ptid); pg8::Gemm g{xb, (const bf16*)(wl + WO_GU), M, 2 * FF, D}; pg8::StaticOrder S; S.init(M, 2 * FF, G, bx);
            PG8_LAS float* side = (PG8_LAS float*)(lds + SIDE_OFF); pg8::fill_rstd(S, ssqA, side, (const int*)nullptr, (PG8_LAS float*)nullptr, ptid); __syncthreads();
            pg8::EpiSwiGLU E{side, hmid};
            pg8::gemm_phase<pg8::EpiSwiGLU, pg8::StaticOrder, true, true>(lds, g, S, E, ptid);
        }
        xcd_barrier(bar);
        PROBE_POINT(6)

        }
        if (PH(8)) {
            PHASE_ENV(); const unsigned char* wl = ws + WS_W + (size_t)L * W_LAYER; (void)wl; FRESH_TID(ptid); pg8::Gemm g{hmid, (const bf16*)(wl + WO_DOWN), M, D, FF}; pg8::StaticOrder S; S.init(M, D, G, bx);
            pg8::EpiResid E{xb, xb, ssqA};
            pg8::gemm_phase<pg8::EpiResid, pg8::StaticOrder, true, true>(lds, g, S, E, ptid);
        }
#if defined(DUP_P7)
        if (PH(8)) {
            PHASE_ENV(); const unsigned char* wl = ws + WS_W + (size_t)L * W_LAYER; FRESH_TID(ptid); pg8::Gemm g{hmid, (const bf16*)(wl + WO_DOWN), M, D, FF}; pg8::StaticOrder S; S.init(M, D, G, bx);
            pg8::EpiPlain E{eb, D};
            pg8::gemm_phase<pg8::EpiPlain, pg8::StaticOrder, true, true>(lds, g, S, E, ptid);
        }
#endif
#ifndef REP_PE
#define REP_PE 1
#endif
#pragma unroll 1
        for (int rep_ = 0; rep_ < REP_PE; ++rep_)
        if (PH(9)) {
            PHASE_ENV(); const unsigned char* wl = ws + WS_W + (size_t)L * W_LAYER; (void)wl; FRESH_TID(ptid); pg8::Gemm g{pb, (const bf16*)(wl + WO_PP), M, D, PLE}; pg8::StaticOrder S; S.init(M, D, G, bx);
            pg8::EpiPlain E{eb, D};
            pg8::gemm_phase<pg8::EpiPlain, pg8::StaticOrder, true, true>(lds, g, S, E, ptid);
        }
        xcd_barrier(bar);
        PROBE_POINT(7)

#if defined(DUP_P8)
        if (PH(10)) {
            PHASE_ENV(); const unsigned char* wl = ws + WS_W + (size_t)L * W_LAYER; FRESH_TID(ptid); pg8::Gemm g{xb, (const bf16*)(wl + WO_PG), M, D, D}; pg8::StaticOrder S; S.init(M, D, G, bx);
            pg8::EpiPlain E{hmid, D};
            pg8::gemm_phase<pg8::EpiPlain, pg8::StaticOrder, true, true>(lds, g, S, E, ptid);
        }
        xcd_barrier(bar);
#endif
        if (PH(10)) {
            PHASE_ENV(); const unsigned char* wl = ws + WS_W + (size_t)L * W_LAYER; (void)wl; FRESH_TID(ptid); pg8::Gemm g{xb, (const bf16*)(wl + WO_PG), M, D, D}; pg8::StaticOrder S; S.init(M, D, G, bx);
            PG8_LAS float* side = (PG8_LAS float*)(lds + SIDE_OFF); pg8::fill_rstd(S, ssqA, side, (const int*)nullptr, (PG8_LAS float*)nullptr, ptid); __syncthreads();
            pg8::EpiPle E{side, eb, xb, xb1, ssqB};
            pg8::gemm_phase<pg8::EpiPle, pg8::StaticOrder, true, true>(lds, g, S, E, ptid);
        }
        xcd_barrier(bar);
        PROBE_POINT(8)
    }

    if (PH(11)) { PHASE_ENV(); FRESH_TID(t_); const int lane = t_ & 63, gw = bx * NWAVES + __builtin_amdgcn_readfirstlane(t_ >> 6);
        const unsigned tmo = __hip_atomic_load((unsigned*)(ws + WS_CTL) + CW_BAR + XB_TMO, RLX_AGENT);
        for (int m = gw; m < M; m += NGW) {
            float s = (lane < 16) ? ssqB[(size_t)m * 16 + lane] : 0.f; s = wave_sum(s);
            float rs = rsqrtf(s * (1.0f / 1024.0f) + EPS); if (tmo) rs = __builtin_nanf("");
#pragma unroll
            for (int j = 0; j < 2; ++j) { const v4u w = ((const GAS v4u*)(xb1 + (size_t)m * D))[lane + 64 * j]; const GAS f32x4* gp = (const GAS f32x4*)(a.g_final + (lane + 64 * j) * 8);
                f32x4 v0, v1; pg8::unpack8(w, v0, v1); GAS f32x4* op = (GAS f32x4*)(a.out + (size_t)m * D + (lane + 64 * j) * 8);
                op[0] = v0 * rs * gp[0]; op[1] = v1 * rs * gp[1]; }
        }
    }
}

extern "C" void kernel_launch(void* const* d_in, const int* in_sizes, int n_in, void* d_out, int out_size, void* d_ws, size_t ws_size, hipStream_t stream) {
    static int grid = 0;
    if (grid == 0) {
        if (n_in != 16 || in_sizes[0] != M * D || out_size != M * D || ws_size < WS_END) { fprintf(stderr, "kernel_launch: unexpected shapes (n_in %d, in0 %d, out %d, ws %zu < %zu)\n", n_in, n_in > 0 ? in_sizes[0] : -1, out_size, ws_size, (size_t)WS_END); grid = -1; return; }
        int dev = 0, cus = 0, per_cu = 0;
        if (hipGetDevice(&dev) != hipSuccess || hipDeviceGetAttribute(&cus, hipDeviceAttributeMultiprocessorCount, dev) != hipSuccess) { grid = -1; return; }
        if (hipFuncSetAttribute((const void*)fwd, hipFuncAttributeMaxDynamicSharedMemorySize, LDS_BYTES) != hipSuccess) { fprintf(stderr, "kernel_launch: hipFuncSetAttribute failed\n"); grid = -1; return; }
        if (hipOccupancyMaxActiveBlocksPerMultiprocessor(&per_cu, (const void*)fwd, NWAVES * 64, LDS_BYTES) != hipSuccess || per_cu < 1) fprintf(stderr, "kernel_launch: occupancy query reports %d\n", per_cu);
        (void)hipGetLastError();
        grid = cus;
    }
    if (grid < 0) return;
    if (hipMemsetAsync((char*)d_ws + WS_CTL, 0, 32768, stream) != hipSuccess) return;
    Args a{};
    a.x = (const float*)d_in[0]; a.p = (const float*)d_in[1]; a.pos = (const int*)d_in[2]; a.g_mix = (const float*)d_in[3]; a.w_in = (const float*)d_in[4]; a.pool_w = (const float*)d_in[5];
    a.pool_scale = (const float*)d_in[6]; a.w_out = (const float*)d_in[7]; a.g_ffn = (const float*)d_in[8]; a.w_gate = (const float*)d_in[9]; a.w_up = (const float*)d_in[10]; a.w_down = (const float*)d_in[11];
    a.g_ple = (const float*)d_in[12]; a.w_ple_gate = (const float*)d_in[13]; a.w_ple_proj = (const float*)d_in[14]; a.g_final = (const float*)d_in[15]; a.out = (float*)d_out; a.ws = (unsigned char*)d_ws;
    hipLaunchKernelGGL(fwd, dim3(grid), dim3(NWAVES * 64), LDS_BYTES, stream, a);
}
```

```cpp
#include <hip/hip_runtime.h>
#include <cstdio>
#include <cstdint>
namespace pg8 {
#define PG8_LAS __attribute__((address_space(3)))
typedef unsigned short bf16_t;
typedef short bf16x8 __attribute__((ext_vector_type(8)));
typedef float f32x4 __attribute__((ext_vector_type(4)));
typedef unsigned u32x4 __attribute__((ext_vector_type(4)));
constexpr int BM = 256, BK = 64, HALF = 128, HTB = HALF * BK * 2  , STAGE_BYTES = 8 * HTB, NXCD = 8, WGM = 8;

__host__ __device__ __forceinline__ int lds_byte(int r, int c) { const int st = (r >> 4) * 2 + (c >> 5), rr = r & 15, cc = c & 31, ob = rr * 64 + cc * 2; return st * 1024 + (ob ^ (((ob >> 9) & 1) << 5)); }
__host__ __device__ __forceinline__ void stage_rc(int b, int& R, int& C) { const int st = b / 1024, sb = b % 1024, swz = sb ^ (((sb >> 9) & 1) << 5); R = (st >> 1) * 16 + swz / 64; C = (st & 1) * 32 + (swz % 64) / 2; }
__host__ __device__ __forceinline__ int perm32(int rho) { const int n = rho >> 4, i = rho & 15; return 8 * (i >> 2) + 4 * n + (i & 3); }

struct Unit { int pm, pn; };
struct Gemm { const bf16_t* A; const bf16_t* Bt; int M, N, K; };

struct StaticOrder {
    int nM, nN, nwg, G, c;
    __host__ __device__ void init(int M, int N, int G_, int c_) { nM = M / BM; nN = N / BM; nwg = nM * nN; G = G_; c = c_; }
    __host__ __device__ bool next(int i, Unit& u) const {
        const long L = (long)i * G + c; if (L >= nwg) return false;
        int wgid = (int)L; { const int q = nwg / NXCD, r = nwg % NXCD, xcd = wgid % NXCD, off = wgid / NXCD; wgid = (xcd < r ? xcd * (q + 1) : r * (q + 1) + (xcd - r) * q) + off; }
        const int nig = WGM * nN, gid = wgid / nig, fm = gid * WGM, gsz = (nM - fm) < WGM ? (nM - fm) : WGM;
        u.pm = fm + ((wgid % nig) % gsz); u.pn = (wgid % nig) / gsz; return true;
    }
    __device__ __forceinline__ void a_ready(const Unit&) const {}
    __device__ __forceinline__ void done(const Unit&) const {}
};

typedef float f32x2_t __attribute__((ext_vector_type(2))); typedef __bf16 bf16x2_t __attribute__((ext_vector_type(2)));
__device__ __forceinline__ unsigned cvt_pk_bf16(float lo, float hi) { f32x2_t v = {lo, hi}; bf16x2_t b = __builtin_convertvector(v, bf16x2_t); return __builtin_bit_cast(unsigned, b); }
template <class Epi, class Sched, bool ALIGN_EPI = false, bool SP2 = false>
__device__ __forceinline__ void gemm_phase(PG8_LAS unsigned char* lds, const Gemm g, const Sched& S, const Epi& E, const int tid_in) {
    const int tid = tid_in, wid = __builtin_amdgcn_readfirstlane(tid >> 6), lane = tid & 63, wr = wid >> 2, wc = wid & 3, fr = lane & 15, fq = lane >> 4;
    const int K = g.K, nt = K / BK;
    unsigned voffA[2], voffB[2];
#pragma unroll
    for (int i = 0; i < 2; ++i) { int R, C; stage_rc(tid * 16 + i * 8192, R, C); const int Rb = Epi::PERM ? ((R & ~31) + perm32(R & 31)) : R;
        voffA[i] = (unsigned)(R * K + C) * 2u; voffB[i] = (unsigned)(Rb * K + C) * 2u; }
    const size_t kstep = (size_t)(BK * 2);
    const size_t hstep = (size_t)HALF * K * 2;
    const size_t tstep = 2 * hstep;
    const unsigned ldsw = (unsigned)wid * 1024u;
    const int aoff = lds_byte(wr * 64 + fr, fq * 8), boff = lds_byte(wc * 32 + fr, fq * 8);
#define PG8_SA(b, h) (((b) * 2 + (h)) * HTB)
#define PG8_SB(b, h) ((4 + (b) * 2 + (h)) * HTB)
#define PG8_STAGE(bufoff, gbase, voff) do { _Pragma("unroll") for (int _i = 0; _i < 2; ++_i) \
        __builtin_amdgcn_global_load_lds((const unsigned*)((const char*)(gbase) + (voff)[_i]), (PG8_LAS unsigned*)(lds + (bufoff) + ldsw + _i * 8192), 16, 0, 0); } while (0)
#define PG8_LDA(dst, b, h) do { _Pragma("unroll") for (int m = 0; m < 4; ++m) _Pragma("unroll") for (int k = 0; k < 2; ++k) dst[m][k] = *(const PG8_LAS bf16x8*)(lds + PG8_SA(b, h) + aoff + m * 2048 + k * 1024); } while (0)
#define PG8_LDB(dst, b, h) do { _Pragma("unroll") for (int n = 0; n < 2; ++n) _Pragma("unroll") for (int k = 0; k < 2; ++k) dst[n][k] = *(const PG8_LAS bf16x8*)(lds + PG8_SB(b, h) + boff + n * 2048 + k * 1024); } while (0)
#define PG8_MMA(ai, bj, At, Bt) do { __builtin_amdgcn_s_setprio(1); _Pragma("unroll") for (int m = 0; m < 4; ++m) _Pragma("unroll") for (int n = 0; n < 2; ++n) _Pragma("unroll") for (int k = 0; k < 2; ++k) \
        acc[ai][bj][m][n] = __builtin_amdgcn_mfma_f32_16x16x32_bf16(Bt[n][k], At[m][k], acc[ai][bj][m][n], 0, 0, 0); __builtin_amdgcn_s_setprio(0); } while (0)
#define PG8_WAIT_V(n) asm volatile("s_waitcnt vmcnt(" #n ")" ::: "memory")
#define PG8_WAIT_L(n) asm volatile("s_waitcnt lgkmcnt(" #n ")" ::: "memory")
#define PG8_BAR __builtin_amdgcn_s_barrier()
#define PG8_SCHED __builtin_amdgcn_sched_barrier(0)
    Unit cur, nxt; int ui = 0;
    if (!S.next(0, cur)) return;
    f32x4 acc[2][2][4][2];
    E.init(acc, cur, wr, wc, fr, fq);
    bf16x8 At[4][2], B0[2][2], B1[2][2];
    const char* cA = (const char*)g.A + (size_t)cur.pm * tstep; const char* cB = (const char*)g.Bt + (size_t)cur.pn * tstep;
    S.a_ready(cur);
    if constexpr (SP2) {
        PG8_STAGE(PG8_SB(0, 0), cB, voffB); PG8_STAGE(PG8_SB(0, 1), cB + hstep, voffB); PG8_STAGE(PG8_SA(0, 0), cA, voffA); PG8_STAGE(PG8_SA(0, 1), cA + hstep, voffA);
        if (wr == 1) PG8_BAR;
        PG8_WAIT_V(2); PG8_BAR;
        PG8_STAGE(PG8_SB(1, 0), cB + kstep, voffB); PG8_STAGE(PG8_SA(1, 0), cA + kstep, voffA); PG8_STAGE(PG8_SB(1, 1), cB + hstep + kstep, voffB);
        PG8_WAIT_V(6); PG8_BAR;
    } else {
        PG8_STAGE(PG8_SB(0, 0), cB, voffB); PG8_STAGE(PG8_SA(0, 0), cA, voffA); PG8_STAGE(PG8_SB(0, 1), cB + hstep, voffB); PG8_STAGE(PG8_SA(0, 1), cA + hstep, voffA);
        if (wr == 1) PG8_BAR;
        PG8_WAIT_V(4); PG8_BAR;
        PG8_STAGE(PG8_SB(1, 0), cB + kstep, voffB); PG8_STAGE(PG8_SA(1, 0), cA + kstep, voffA); PG8_STAGE(PG8_SB(1, 1), cB + hstep + kstep, voffB);
        PG8_WAIT_V(6); PG8_BAR;
    }
    for (;;) {
        const bool has_next = S.next(ui + 1, nxt);
        const char* nA = has_next ? (const char*)g.A + (size_t)nxt.pm * tstep : cA; const char* nB = has_next ? (const char*)g.Bt + (size_t)nxt.pn * tstep : cB;
#pragma unroll 1
        for (int t = 0; t < nt; t += 2) {
            const bool last = (t == nt - 2);
            const char* a1 = cA + (size_t)(t + 1) * kstep;
            const char* a2 = last ? nA : cA + (size_t)(t + 2) * kstep; const char* b2 = last ? nB : cB + (size_t)(t + 2) * kstep;
            const char* a3 = a2 + kstep; const char* b3 = b2 + kstep;
            if (last && has_next) S.a_ready(nxt);
            if constexpr (SP2) {
            PG8_LDB(B0, 0, 0); PG8_LDB(B1, 0, 1); PG8_SCHED; PG8_LDA(At, 0, 0); PG8_STAGE(PG8_SA(1, 1), a1 + hstep, voffA);
            PG8_WAIT_V(8); PG8_WAIT_L(0); PG8_BAR; PG8_MMA(0, 0, At, B0); PG8_MMA(0, 1, At, B1); PG8_BAR; PG8_SCHED;
            PG8_LDA(At, 0, 1); PG8_STAGE(PG8_SB(0, 0), b2, voffB); PG8_STAGE(PG8_SB(0, 1), b2 + hstep, voffB); PG8_STAGE(PG8_SA(0, 0), a2, voffA);
            PG8_WAIT_V(8); PG8_WAIT_L(0); PG8_BAR; PG8_MMA(1, 0, At, B0); PG8_MMA(1, 1, At, B1); PG8_BAR; PG8_SCHED;
            PG8_LDB(B0, 1, 0); PG8_LDB(B1, 1, 1); PG8_SCHED; PG8_LDA(At, 1, 0); PG8_STAGE(PG8_SA(0, 1), a2 + hstep, voffA);
            PG8_WAIT_V(8); PG8_WAIT_L(0); PG8_BAR; PG8_MMA(0, 0, At, B0); PG8_MMA(0, 1, At, B1); PG8_BAR; PG8_SCHED;
            PG8_LDA(At, 1, 1); PG8_STAGE(PG8_SB(1, 0), b3, voffB); PG8_STAGE(PG8_SB(1, 1), b3 + hstep, voffB); PG8_STAGE(PG8_SA(1, 0), a3, voffA);
            PG8_WAIT_V(8); PG8_WAIT_L(0); PG8_BAR; PG8_MMA(1, 0, At, B0); PG8_MMA(1, 1, At, B1); PG8_BAR; PG8_SCHED;
            } else {
            PG8_LDB(B0, 0, 0); PG8_SCHED; PG8_LDA(At, 0, 0); PG8_STAGE(PG8_SA(1, 1), a1 + hstep, voffA);
            PG8_WAIT_L(8); PG8_BAR; PG8_WAIT_L(0); PG8_MMA(0, 0, At, B0); PG8_BAR; PG8_SCHED;
            PG8_LDB(B1, 0, 1); PG8_STAGE(PG8_SB(0, 0), b2, voffB);
            PG8_BAR; PG8_WAIT_L(0); PG8_MMA(0, 1, At, B1); PG8_BAR;
            PG8_LDA(At, 0, 1); PG8_STAGE(PG8_SA(0, 0), a2, voffA);
            PG8_BAR; PG8_WAIT_L(0); PG8_MMA(1, 0, At, B0); PG8_BAR; PG8_SCHED;
            PG8_STAGE(PG8_SB(0, 1), b2 + hstep, voffB);
            PG8_WAIT_V(6); PG8_BAR; PG8_MMA(1, 1, At, B1); PG8_BAR;
            PG8_LDB(B0, 1, 0); PG8_SCHED; PG8_LDA(At, 1, 0); PG8_STAGE(PG8_SA(0, 1), a2 + hstep, voffA);
            PG8_WAIT_L(8); PG8_BAR; PG8_WAIT_L(0); PG8_MMA(0, 0, At, B0); PG8_BAR; PG8_SCHED;
            PG8_LDB(B1, 1, 1); PG8_STAGE(PG8_SB(1, 0), b3, voffB);
            PG8_BAR; PG8_WAIT_L(0); PG8_MMA(0, 1, At, B1); PG8_BAR;
            PG8_LDA(At, 1, 1); PG8_STAGE(PG8_SA(1, 0), a3, voffA);
            PG8_BAR; PG8_WAIT_L(0); PG8_MMA(1, 0, At, B0); PG8_BAR; PG8_SCHED;
            PG8_STAGE(PG8_SB(1, 1), b3 + hstep, voffB);
            PG8_WAIT_V(6); PG8_BAR; PG8_MMA(1, 1, At, B1); PG8_BAR;
            }
        }
        if constexpr (ALIGN_EPI) { if (wr == 0) PG8_BAR; }
        if constexpr (!Epi::AFTER_DRAIN) { E(acc, cur, wr, wc, fr, fq, ui); S.done(cur); }
        if (!has_next) break;
        E.init(acc, nxt, wr, wc, fr, fq);
        cur = nxt; cA = nA; cB = nB; ++ui;
        if constexpr (ALIGN_EPI) { if (wr == 1) PG8_BAR; }
    }
    PG8_WAIT_V(0);
    if constexpr (!ALIGN_EPI) { if (wr == 0) PG8_BAR; }
    PG8_BAR;
    if constexpr (Epi::AFTER_DRAIN) { E.fused(acc, cur, wr, wc, fr, fq, lds, wid, lane); S.done(cur); }
#undef PG8_SA
#undef PG8_SB
#undef PG8_STAGE
#undef PG8_LDA
#undef PG8_LDB
#undef PG8_MMA
#undef PG8_WAIT_V
#undef PG8_WAIT_L
#undef PG8_BAR
#undef PG8_SCHED
}
}

constexpr int BATCH = 8, SEQ = 4096, D = 1024, DEPTH = 4, M = BATCH * SEQ;
constexpr int NH = 4, DH = 128, RW = 512, CHUNK = 128, NCH = SEQ / CHUNK;
constexpr int INW = 2560, FF = 2816, PLE = 256;
constexpr float EPS = 1e-6f;
constexpr int NWAVES = 8;

constexpr size_t MiB = 1u << 20;
constexpr size_t WS_CTL = 0, CTL_ZERO_BYTES = 1 * MiB;
constexpr size_t WS_SSQA = 1 * MiB, WS_SSQB = 3 * MiB;
constexpr size_t WS_W = 8 * MiB, W_LAYER = 26 * MiB;
constexpr size_t WO_IN = 0, WO_OUT = 5 * MiB, WO_GU = 7 * MiB, WO_DOWN = 18 * MiB, WO_PG = 18 * MiB + 5632 * 1024, WO_PP = WO_PG + 2 * MiB;
static_assert(WO_PP + 512 * 1024 == W_LAYER, "weight map");
constexpr size_t WS_XB = 112 * MiB;
constexpr size_t WS_PB = 176 * MiB;
constexpr size_t WS_R = 192 * MiB;
constexpr size_t R_BATCH = 32 * MiB;
constexpr size_t R_Q = 0, R_K = 4 * MiB, R_V = 8 * MiB, R_G = 12 * MiB, R_UW = 16 * MiB, R_KV = 20 * MiB, R_MIX = 24 * MiB;
constexpr size_t R_H = 0, R_E = 24 * MiB, R_UT = 0;
constexpr size_t WS_XB1 = WS_R + 256 * MiB;
constexpr size_t WS_END = WS_XB1 + 64 * MiB;
static_assert((size_t)SEQ * FF * 2 <= R_MIX && R_MIX + (size_t)SEQ * D * 2 == R_BATCH, "per-batch scratch map");
constexpr int CW_BAR = 4096;

constexpr int RING_BYTES = 131072;
constexpr int LDSCTL_OFF = RING_BYTES, MISC_OFF = LDSCTL_OFF + 320;
constexpr int SIDE_OFF = LDSCTL_OFF + 1024;
constexpr int LDS_BYTES = 147456;

#define GAS __attribute__((address_space(1)))
#define LAS __attribute__((address_space(3)))
typedef unsigned short bf16;
typedef unsigned v4u __attribute__((ext_vector_type(4)));
typedef unsigned v2u __attribute__((ext_vector_type(2)));
typedef float f32x4 __attribute__((ext_vector_type(4)));
typedef float f32x16 __attribute__((ext_vector_type(16)));
typedef short bf16x8 __attribute__((ext_vector_type(8)));
typedef short s16x4 __attribute__((ext_vector_type(4)));
typedef GAS unsigned gu32;
#define RLX_AGENT __ATOMIC_RELAXED, __HIP_MEMORY_SCOPE_AGENT
#define LDS_WAIT() asm volatile("s_waitcnt lgkmcnt(0)" ::: "memory")
#define VM_WAIT() asm volatile("s_waitcnt vmcnt(0)" ::: "memory")
__device__ __forceinline__ unsigned f2bf(float f) { unsigned u = __builtin_bit_cast(unsigned, f); return (u + 0x7fffu + ((u >> 16) & 1u)) >> 16; }
__device__ __forceinline__ unsigned pk2(float lo, float hi) { return f2bf(lo) | (f2bf(hi) << 16); }
__device__ __forceinline__ float bf_lo(unsigned w) { return __builtin_bit_cast(float, w << 16); }
__device__ __forceinline__ float bf_hi(unsigned w) { return __builtin_bit_cast(float, w & 0xffff0000u); }

__device__ const float ROPE_HI[64] = {1.591186523e-01f, 1.378173828e-01f, 1.193237305e-01f, 1.033325195e-01f, 8.947753906e-02f, 7.748413086e-02f, 6.710815430e-02f, 5.810546875e-02f, 5.032348633e-02f, 4.357910156e-02f, 3.773498535e-02f, 3.266906738e-02f, 2.829742432e-02f, 2.450561523e-02f, 2.121734619e-02f, 1.837158203e-02f, 1.591491699e-02f, 1.377868652e-02f, 1.193237305e-02f, 1.033401489e-02f, 8.949279785e-03f, 7.749557495e-03f, 6.710052490e-03f, 5.811691284e-03f, 5.031585693e-03f, 4.358291626e-03f, 3.773689270e-03f, 3.268241882e-03f, 2.829551697e-03f, 2.449989319e-03f, 2.121925354e-03f, 1.837730408e-03f, 1.591205597e-03f, 1.378059387e-03f, 1.193046570e-03f, 1.033306122e-03f, 8.947849274e-04f, 7.748603821e-04f, 6.711483002e-04f, 5.810260773e-04f, 5.030632019e-04f, 4.358291626e-04f, 3.772974014e-04f, 3.267526627e-04f, 2.830028534e-04f, 2.449750900e-04f, 2.121925354e-04f, 1.837611198e-04f, 1.591444016e-04f, 1.378059387e-04f, 1.193284988e-04f, 1.033246517e-04f, 8.949637413e-05f, 7.748603821e-05f, 6.711483002e-05f, 5.811452866e-05f, 5.032122135e-05f, 4.357099533e-05f, 3.772974014e-05f, 3.267824650e-05f, 2.829730511e-05f, 2.450495958e-05f, 2.121925354e-05f, 1.837313175e-05f};
__device__ const float ROPE_LO[64] = {3.629074854e-05f, 5.119791695e-06f, 2.563974340e-05f, 1.977708780e-05f, 2.186254642e-05f, 1.915789653e-05f, 6.928708444e-06f, 1.379869173e-05f, 5.725776191e-06f, 4.200542662e-06f, 6.599365861e-06f, 1.379848982e-05f, 4.771514341e-06f, 3.076627763e-06f, 6.306573596e-06f, 7.344074220e-06f, 5.773169960e-07f, 3.563736982e-06f, 2.563974249e-06f, 1.214769213e-06f, 6.603757470e-07f, 7.713804280e-07f, 1.455810320e-06f, 2.354600070e-07f, 1.335517140e-06f, 3.858455244e-08f, 4.692017228e-07f, 4.470491177e-08f, 6.678862974e-07f, 8.798673434e-07f, 4.399224736e-07f, 1.622028520e-07f, 3.438339888e-07f, 1.656388378e-07f, 4.471322939e-07f, 2.168443558e-07f, 2.090887250e-07f, 1.725054801e-07f, 2.529881415e-09f, 1.665971467e-07f, 2.289191343e-07f, 3.858455333e-09f, 1.184457474e-07f, 7.599606278e-08f, 1.910491321e-08f, 1.118285908e-07f, 4.399224807e-08f, 2.814121380e-08f, 1.054154186e-08f, 1.656388271e-08f, 2.087137041e-08f, 2.764489970e-08f, 3.027478712e-09f, 1.725054766e-08f, 2.529881304e-10f, 4.738785808e-09f, 7.990752948e-09f, 1.230677427e-08f, 1.184457421e-08f, 4.619374216e-09f, 4.890723382e-09f, 3.732278930e-09f, 4.399224540e-09f, 5.794353886e-09f};
__device__ __forceinline__ float lg2gamma(int h) { return h == 0 ? -0.04580368961312479f : h == 1 ? -0.02272007650008353f : h == 2 ? -0.011315313227834146f : -0.005646563141142063f; }

__device__ __forceinline__ float add_xor16(float v) { return v + __builtin_bit_cast(float, __builtin_amdgcn_ds_swizzle(__builtin_bit_cast(int, v), 0x401F)); }
__device__ __forceinline__ float add_xor32(float v) { float a_ = v, b_ = v; asm volatile("s_nop 1\n\tv_permlane32_swap_b32 %0, %1" : "+v"(a_), "+v"(b_)); return a_ + b_; }
namespace pg8 {
struct BatchOrder {
    int nN, gsize, rank, nwg;
    __device__ __forceinline__ void init(int N, int gsize_, int rank_) { nN = N / BM; gsize = gsize_; rank = rank_; nwg = 16 * nN; }
    __device__ __forceinline__ bool next(int i, Unit& u) const {
        const int L = i * gsize + rank; if (L >= nwg) return false;
        const int grp = L / (8 * nN), r = L - grp * 8 * nN; u.pm = 8 * grp + (r & 7); u.pn = r >> 3; return true;
    }
    __device__ __forceinline__ void a_ready(const Unit&) const {}
    __device__ __forceinline__ void done(const Unit&) const {}
};
__device__ __forceinline__ void load_rstd(const PG8_LAS float* side, int ui, int wr, int fr, float (&rs)[2][4]) {
#pragma unroll
    for (int ai = 0; ai < 2; ++ai)
#pragma unroll
        for (int m = 0; m < 4; ++m) rs[ai][m] = side[ui * 256 + ai * HALF + wr * 64 + m * 16 + fr];
}
template <class Sched> __device__ __forceinline__ void fill_rstd(const Sched& S, const float* ssq, PG8_LAS float* side, const int* pos, PG8_LAS float* posf, int tid) {
    Unit u;
    for (int i = 0; S.next(i, u); ++i) {
        const int row = u.pm * BM + (tid >> 1), hf = tid & 1;
        const f32x4 a = *(const f32x4*)(ssq + (size_t)row * 16 + 8 * hf), b = *(const f32x4*)(ssq + (size_t)row * 16 + 8 * hf + 4);
        float s = ((a[0] + a[1]) + (a[2] + a[3])) + ((b[0] + b[1]) + (b[2] + b[3]));
        s += __builtin_bit_cast(float, __builtin_amdgcn_ds_swizzle(__builtin_bit_cast(int, s), 0x041F));
        if (hf == 0) { side[i * 256 + (tid >> 1)] = rsqrtf(s * (1.0f / 1024.0f) + 1e-6f); if (pos) posf[i * 256 + (tid >> 1)] = (float)pos[row]; }
    }
}
#ifndef WTM
#define WTM 0
#endif
template <int BIT> __device__ __forceinline__ void st16(void* p, const u32x4 v) {
    if constexpr ((WTM >> BIT) & 1) asm volatile("global_store_dwordx4 %0, %1, off sc1\n\ts_nop 0" :: "v"(p), "v"(v) : "memory");
    else *(u32x4*)p = v;
}
__device__ __forceinline__ u32x4 pack8(const f32x4 a, const f32x4 b) { u32x4 w; w.x = cvt_pk_bf16(a[0], a[1]); w.y = cvt_pk_bf16(a[2], a[3]); w.z = cvt_pk_bf16(b[0], b[1]); w.w = cvt_pk_bf16(b[2], b[3]); return w; }

struct EpiInProj {
    static constexpr bool PERM = true, AFTER_DRAIN = false;
    const PG8_LAS float* side; const PG8_LAS float* posf; const PG8_LAS float* rope; bf16_t *q, *k, *v, *g, *uw;
    __device__ __forceinline__ void init(f32x4 (&acc)[2][2][4][2], const Unit&, int, int, int, int) const {
#pragma unroll
        for (int a = 0; a < 2; ++a)
#pragma unroll
            for (int b = 0; b < 2; ++b)
#pragma unroll
                for (int m = 0; m < 4; ++m)
#pragma unroll
                    for (int n = 0; n < 2; ++n) acc[a][b][m][n] = (f32x4){0.f, 0.f, 0.f, 0.f};
    }
    __device__ __forceinline__ void operator()(const f32x4 (&acc)[2][2][4][2], const Unit& u, int wr, int wc, int fr, int fq, int ui) const {
        const int rowbase = u.pm * BM + wr * 64 + fr;
        float rs[2][4]; load_rstd(side, ui, wr, fr, rs);
        if (u.pn < 4) {
            const int sec = u.pn >> 1, head = 2 * (u.pn & 1) + (wc >> 1), dd0 = 32 * (wc & 1) + 8 * fq;
            bf16_t* dst = sec ? k : q;
            const f32x4 h0 = *(const PG8_LAS f32x4*)(rope + dd0), h1 = *(const PG8_LAS f32x4*)(rope + dd0 + 4), l0 = *(const PG8_LAS f32x4*)(rope + 64 + dd0), l1 = *(const PG8_LAS f32x4*)(rope + 64 + dd0 + 4);
            const float lg = lg2gamma(head);
#pragma unroll
            for (int ai = 0; ai < 2; ++ai)
#pragma unroll
                for (int m = 0; m < 4; ++m) {
                    const int row = rowbase + ai * HALF + m * 16, b = row >> 12, s = row & 4095;
                    const float p = posf[ui * 256 + ai * HALF + wr * 64 + m * 16 + fr];
                    const float sc = rs[ai][m] * (sec ? __builtin_amdgcn_exp2f((float)(127 - (s & 127)) * lg) : 1.0f);
                    f32x4 o1[2], o2[2];
#pragma unroll
                    for (int n = 0; n < 2; ++n) { const f32x4 fh = n ? h1 : h0, fl = n ? l1 : l0;
#pragma unroll
                        for (int j = 0; j < 4; ++j) { const float ph = p * fh[j]; const float rev = (ph - __builtin_floorf(ph)) + p * fl[j];
                            const float cs = __builtin_amdgcn_cosf(rev), sn = __builtin_amdgcn_sinf(rev);
                            const float x1 = acc[ai][0][m][n][j] * sc, x2 = acc[ai][1][m][n][j] * sc;
                            o1[n][j] = x1 * cs - x2 * sn; o2[n][j] = x2 * cs + x1 * sn; } }
                    bf16_t* rp = dst + ((size_t)((b * NH_ + head) * SEQ_ + s)) * 128 + dd0;
                    st16<0>(rp, pack8(o1[0], o1[1])); st16<0>((rp + 64), pack8(o2[0], o2[1]));
                    asm volatile("" ::: "memory");
                }
        } else {
            const int sec = (u.pn - 4) >> 1;
            const int c0 = 256 * (u.pn & 1) + 32 * wc + 8 * fq;
#pragma unroll
            for (int ai = 0; ai < 2; ++ai)
#pragma unroll
                for (int m = 0; m < 4; ++m) {
                    const int row = rowbase + ai * HALF + m * 16, b = row >> 12, s = row & 4095; const float sc = rs[ai][m];
#pragma unroll
                    for (int bj = 0; bj < 2; ++bj) { const u32x4 w = pack8(acc[ai][bj][m][0] * sc, acc[ai][bj][m][1] * sc); const int c = c0 + 128 * bj;
                        if (sec == 2) st16<0>((uw + (size_t)row * 512 + c), w);
                        else { bf16_t* dst = sec ? g : v; st16<0>((dst + ((size_t)((b * NH_ + (c >> 7)) * SEQ_ + s)) * 128 + (c & 127)), w); } }
                }
        }
    }
    static constexpr int NH_ = 4, SEQ_ = 4096;
};

__device__ __forceinline__ void unpack8(const u32x4 w, f32x4& a, f32x4& b) {
    a[0] = __builtin_bit_cast(float, w.x << 16); a[1] = __builtin_bit_cast(float, w.x & 0xffff0000u); a[2] = __builtin_bit_cast(float, w.y << 16); a[3] = __builtin_bit_cast(float, w.y & 0xffff0000u);
    b[0] = __builtin_bit_cast(float, w.z << 16); b[1] = __builtin_bit_cast(float, w.z & 0xffff0000u); b[2] = __builtin_bit_cast(float, w.w << 16); b[3] = __builtin_bit_cast(float, w.w & 0xffff0000u);
}
struct EpiResid {
    static constexpr bool PERM = true, AFTER_DRAIN = false;
    const bf16_t* xin; bf16_t* xout; float* ssq_out;
    __device__ __forceinline__ void init(f32x4 (&acc)[2][2][4][2], const Unit& u, int wr, int wc, int fr, int fq) const {
        const int rowbase = u.pm * BM + wr * 64 + fr, col0 = u.pn * BM + 32 * wc + 8 * fq;
        u32x4 w[2][4][2];
#pragma unroll
        for (int ai = 0; ai < 2; ++ai)
#pragma unroll
            for (int m = 0; m < 4; ++m)
#pragma unroll
                for (int bj = 0; bj < 2; ++bj) w[ai][m][bj] = *(const u32x4*)(xin + (size_t)(rowbase + ai * HALF + m * 16) * 1024 + col0 + bj * HALF);
#pragma unroll
        for (int ai = 0; ai < 2; ++ai)
#pragma unroll
            for (int m = 0; m < 4; ++m)
#pragma unroll
                for (int bj = 0; bj < 2; ++bj) unpack8(w[ai][m][bj], acc[ai][bj][m][0], acc[ai][bj][m][1]);
    }
    __device__ __forceinline__ void operator()(const f32x4 (&acc)[2][2][4][2], const Unit& u, int wr, int wc, int fr, int fq, int) const {
        const int rowbase = u.pm * BM + wr * 64 + fr, col0 = u.pn * BM + 32 * wc + 8 * fq;
#pragma unroll
        for (int ai = 0; ai < 2; ++ai)
#pragma unroll
            for (int m = 0; m < 4; ++m) {
                const int row = rowbase + ai * HALF + m * 16; const size_t off = (size_t)row * 1024 + col0; float ss = 0.f;
#pragma unroll
                for (int bj = 0; bj < 2; ++bj) {
                    const f32x4 v0 = acc[ai][bj][m][0], v1 = acc[ai][bj][m][1];
                    st16<1>((xout + off + bj * HALF), pack8(v0, v1));
                    ss += (v0[0] * v0[0] + v0[1] * v0[1]) + (v0[2] * v0[2] + v0[3] * v0[3]) + (v1[0] * v1[0] + v1[1] * v1[1]) + (v1[2] * v1[2] + v1[3] * v1[3]); }
                ss = add_xor32(add_xor16(ss));
                if (fq == 0) ssq_out[(size_t)row * 16 + u.pn * 4 + wc] = ss;
            }
    }
};

struct EpiSwiGLU {
    static constexpr bool PERM = true, AFTER_DRAIN = false;
    const PG8_LAS float* side; bf16_t* h;
    __device__ __forceinline__ void init(f32x4 (&acc)[2][2][4][2], const Unit&, int, int, int, int) const {
#pragma unroll
        for (int a = 0; a < 2; ++a)
#pragma unroll
            for (int b = 0; b < 2; ++b)
#pragma unroll
                for (int m = 0; m < 4; ++m)
#pragma unroll
                    for (int n = 0; n < 2; ++n) acc[a][b][m][n] = (f32x4){0.f, 0.f, 0.f, 0.f};
    }
    __device__ __forceinline__ void operator()(const f32x4 (&acc)[2][2][4][2], const Unit& u, int wr, int wc, int fr, int fq, int ui) const {
        const int rowbase = u.pm * BM + wr * 64 + fr, col0 = u.pn * HALF + 32 * wc + 8 * fq;
        float rs[2][4]; load_rstd(side, ui, wr, fr, rs);
#pragma unroll
        for (int ai = 0; ai < 2; ++ai)
#pragma unroll
            for (int m = 0; m < 4; ++m) { const float sc = rs[ai][m], c1 = -1.4426950408889634f * sc, sc2 = sc * sc; f32x4 o[2];
#pragma unroll
                for (int n = 0; n < 2; ++n)
#pragma unroll
                    for (int jp = 0; jp < 2; ++jp) { const f32x2_t av = {acc[ai][0][m][n][2 * jp], acc[ai][0][m][n][2 * jp + 1]}, bv = {acc[ai][1][m][n][2 * jp], acc[ai][1][m][n][2 * jp + 1]};
                        const f32x2_t t = av * c1; f32x2_t ex; ex.x = __builtin_amdgcn_exp2f(t.x); ex.y = __builtin_amdgcn_exp2f(t.y);
                        const f32x2_t d = ex + 1.0f; f32x2_t r; r.x = __builtin_amdgcn_rcpf(d.x); r.y = __builtin_amdgcn_rcpf(d.y);
                        const f32x2_t ov = (av * bv) * (r * sc2); o[n][2 * jp] = ov.x; o[n][2 * jp + 1] = ov.y; }
                st16<2>((h + (size_t)(rowbase + ai * HALF + m * 16) * 2816 + col0), pack8(o[0], o[1])); }
    }
};

struct EpiPlain {
    static constexpr bool PERM = true, AFTER_DRAIN = false;
    bf16_t* O; int ldc;
    __device__ __forceinline__ void init(f32x4 (&acc)[2][2][4][2], const Unit&, int, int, int, int) const {
#pragma unroll
        for (int a = 0; a < 2; ++a)
#pragma unroll
            for (int b = 0; b < 2; ++b)
#pragma unroll
                for (int m = 0; m < 4; ++m)
#pragma unroll
                    for (int n = 0; n < 2; ++n) acc[a][b][m][n] = (f32x4){0.f, 0.f, 0.f, 0.f};
    }
    __device__ __forceinline__ void operator()(const f32x4 (&acc)[2][2][4][2], const Unit& u, int wr, int wc, int fr, int fq, int) const {
        const int rowbase = u.pm * BM + wr * 64 + fr, col0 = u.pn * BM + 32 * wc + 8 * fq;
#pragma unroll
        for (int ai = 0; ai < 2; ++ai)
#pragma unroll
            for (int m = 0; m < 4; ++m)
#pragma unroll
                for (int bj = 0; bj < 2; ++bj) st16<3>((O + (size_t)(rowbase + ai * HALF + m * 16) * ldc + col0 + bj * HALF), pack8(acc[ai][bj][m][0], acc[ai][bj][m][1]));
    }
};

struct EpiPle {
    static constexpr bool PERM = true, AFTER_DRAIN = false;
    const PG8_LAS float* side; const bf16_t* e; const bf16_t* xin; bf16_t* xout; float* ssq_out;
    __device__ __forceinline__ void init(f32x4 (&acc)[2][2][4][2], const Unit&, int, int, int, int) const {
#pragma unroll
        for (int a = 0; a < 2; ++a)
#pragma unroll
            for (int b = 0; b < 2; ++b)
#pragma unroll
                for (int m = 0; m < 4; ++m)
#pragma unroll
                    for (int n = 0; n < 2; ++n) acc[a][b][m][n] = (f32x4){0.f, 0.f, 0.f, 0.f};
    }
    __device__ __forceinline__ void operator()(const f32x4 (&acc)[2][2][4][2], const Unit& u, int wr, int wc, int fr, int fq, int ui) const {
        const int rowbase = u.pm * BM + wr * 64 + fr, col0 = u.pn * BM + 32 * wc + 8 * fq;
        float rs[2][4]; load_rstd(side, ui, wr, fr, rs);
#pragma unroll
        for (int ai = 0; ai < 2; ++ai)
#pragma unroll
            for (int m = 0; m < 4; ++m) {
                const int row = rowbase + ai * HALF + m * 16; const size_t off = (size_t)row * 1024 + col0; float ss = 0.f; const float sc = -1.4426950408889634f * rs[ai][m];
#pragma unroll
                for (int bj = 0; bj < 2; ++bj) {
                    f32x4 e0, e1, x0, x1; unpack8(*(const u32x4*)(e + off + bj * HALF), e0, e1); unpack8(*(const u32x4*)(xin + off + bj * HALF), x0, x1);
                    f32x4 v0, v1;
#pragma unroll
                    for (int j = 0; j < 4; ++j) {
                        v0[j] = x0[j] + __builtin_amdgcn_rcpf(1.0f + __builtin_amdgcn_exp2f(sc * acc[ai][bj][m][0][j])) * e0[j];
                        v1[j] = x1[j] + __builtin_amdgcn_rcpf(1.0f + __builtin_amdgcn_exp2f(sc * acc[ai][bj][m][1][j])) * e1[j]; }
                    st16<4>((xout + off + bj * HALF), pack8(v0, v1));
                    ss += (v0[0] * v0[0] + v0[1] * v0[1]) + (v0[2] * v0[2] + v0[3] * v0[3]) + (v1[0] * v1[0] + v1[1] * v1[1]) + (v1[2] * v1[2] + v1[3] * v1[3]); }
                ss = add_xor32(add_xor16(ss));
                if (fq == 0) ssq_out[(size_t)row * 16 + u.pn * 4 + wc] = ss;
            }
    }
};
}
#define XB_TMO      128
#define XB_XCNT(j)  (256  + 64 * (j))
#define XB_XSUB(j)  (1280 + 64 * (j))
#define XB_XGEN(j)  (2304 + 64 * (j))
#define XB_TOP      3328
#define XB_TOPGEN   3392
#define XCD_BAR_WORDS 3456
#define XB_SPIN_CAP (1u << 18)

__device__ __forceinline__ unsigned xb_ld(unsigned* p)              { return __hip_atomic_load(p, __ATOMIC_RELAXED, __HIP_MEMORY_SCOPE_AGENT); }
__device__ __forceinline__ unsigned xb_add(unsigned* p, unsigned v) { return __hip_atomic_fetch_add(p, v, __ATOMIC_RELAXED, __HIP_MEMORY_SCOPE_AGENT); }
__device__ __forceinline__ unsigned xb_xcc_id() { return (unsigned)__builtin_amdgcn_s_getreg((3 << 11) | 20) & 0xFu; }
#define XB_SPIN(cond, bar) do { unsigned _sp = 0; while (cond) { __builtin_amdgcn_s_sleep(1); \
    if ((++_sp & 255u) == 0u) { if (xb_ld(&(bar)[XB_TMO])) break; if (_sp > XB_SPIN_CAP) { atomicAdd(&(bar)[XB_TMO], 1u); break; } } } } while (0)

struct XcdBarrier {
    unsigned* bar; unsigned x;
    volatile LAS unsigned* st;
};

__device__ __forceinline__ XcdBarrier xcd_barrier_post(unsigned* bar, volatile LAS unsigned* st) {
    XcdBarrier b; b.bar = bar; b.x = xb_xcc_id(); b.st = st;
    if (threadIdx.x == 0) st[2] = xb_add(&bar[XB_XCNT(b.x)], 1u);
    return b;
}
__device__ __forceinline__ void xcd_barrier_complete(unsigned* bar, unsigned x, unsigned& nloc, unsigned& nx) {
    const unsigned G = gridDim.x * gridDim.y * gridDim.z;
    unsigned sum, cnt, mine, sp = 0u;
    for (;;) {
        sum = 0u; cnt = 0u; mine = 0u;
#pragma unroll
        for (unsigned j = 0; j < 16; ++j) { const unsigned c = xb_ld(&bar[XB_XCNT(j)]); sum += c; cnt += (c > 0u) ? 1u : 0u; mine = (j == x) ? c : mine; }
        if (sum == G) break;
        __builtin_amdgcn_s_sleep(1);
        if ((++sp & 255u) == 0u) { if (xb_ld(&bar[XB_TMO])) break; if (sp > XB_SPIN_CAP) { atomicAdd(&bar[XB_TMO], 1u); break; } }
    }
    nloc = mine > 0u ? mine : 1u; nx = cnt > 0u ? cnt : 1u;
}

__device__ __forceinline__ void xcd_barrier(const XcdBarrier& b) {
    asm volatile("s_waitcnt vmcnt(0)" ::: "memory");
    __syncthreads();
    if (threadIdx.x == 0) {
        unsigned* bar = b.bar; unsigned bx_ = b.x; asm volatile("" : "+s"(bar), "+s"(bx_));
        __builtin_amdgcn_s_waitcnt(0);
        unsigned nloc = b.st[0], nx = b.st[1];
        if (nloc == 0u) { xcd_barrier_complete(bar, bx_, nloc, nx); b.st[0] = nloc; b.st[1] = nx; }
        const unsigned old = xb_add(&bar[XB_XSUB(bx_)], 1u);
        const unsigned gen = old / nloc;
        if (old + 1u == (gen + 1u) * nloc) {
            __builtin_amdgcn_fence(__ATOMIC_RELEASE, "agent");
            asm volatile("s_waitcnt vmcnt(0)" ::: "memory");
            const unsigned og = xb_add(&bar[XB_TOP], 1u);
            const unsigned tg = og / nx;
            if (og + 1u == (tg + 1u) * nx) xb_add(&bar[XB_TOPGEN], 1u);
            else XB_SPIN(xb_ld(&bar[XB_TOPGEN]) == tg, bar);
            __builtin_amdgcn_fence(__ATOMIC_ACQUIRE, "agent");
            xb_add(&bar[XB_XGEN(bx_)], 1u);
            asm volatile("s_waitcnt vmcnt(0)" ::: "memory");
        } else {
            XB_SPIN(xb_ld(&bar[XB_XGEN(bx_)]) == gen, bar);
            __builtin_amdgcn_fence(__ATOMIC_ACQUIRE, "agent");
            asm volatile("s_waitcnt vmcnt(0)" ::: "memory");
        }
    }
    __syncthreads();
}

#define XB_LSUB(j)  (3456 + 64 * (j))
#define XB_LGEN(j)  (3456 + 1024 + 64 * (j))
#define XB_TICKET   (3456 + 2048)
__device__ __forceinline__ void xcd_local_barrier(const XcdBarrier& b) {
    asm volatile("s_waitcnt vmcnt(0)" ::: "memory");
    __syncthreads();
    if (threadIdx.x == 0) {
        unsigned* bar = b.bar; unsigned bx_ = b.x; asm volatile("" : "+s"(bar), "+s"(bx_));
        const unsigned nloc = b.st[0];
        const unsigned old = xb_add(&bar[XB_LSUB(bx_)], 1u);
        const unsigned gen = old / nloc;
        if (old + 1u == (gen + 1u) * nloc) xb_add(&bar[XB_LGEN(bx_)], 1u);
        else XB_SPIN(xb_ld(&bar[XB_LGEN(bx_)]) == gen, bar);
        __builtin_amdgcn_fence(__ATOMIC_ACQUIRE, "agent");
        asm volatile("s_waitcnt vmcnt(0)" ::: "memory");
    }
    __syncthreads();
}

__device__ __forceinline__ float wave_sum(float v) {
    v += __builtin_bit_cast(float, __builtin_amdgcn_ds_swizzle(__builtin_bit_cast(int, v), 0x041F));
    v += __builtin_bit_cast(float, __builtin_amdgcn_ds_swizzle(__builtin_bit_cast(int, v), 0x081F));
    v += __builtin_bit_cast(float, __builtin_amdgcn_ds_swizzle(__builtin_bit_cast(int, v), 0x101F));
    v += __builtin_bit_cast(float, __builtin_amdgcn_ds_swizzle(__builtin_bit_cast(int, v), 0x201F));
    return add_xor32(add_xor16(v));
}
__device__ __forceinline__ unsigned off_b(unsigned row, unsigned ch) { return 256u * row + 16u * (ch ^ (((row & 3u) << 2) | ((row >> 2) & 3u))); }
__device__ __forceinline__ unsigned tr_addr_nat(unsigned lane, unsigned c, unsigned ks, unsigned t) {
    const unsigned h = lane >> 5, blk = (lane >> 4) & 1u, q = (lane & 15u) >> 2, p = lane & 3u;
    return off_b(16u * ks + 8u * h + 4u * t + q, 4u * c + 2u * blk + (p >> 1)) + 8u * (p & 1u);
}
__device__ __forceinline__ unsigned tr_addr_perm(unsigned lane, unsigned c, unsigned ks, unsigned t) {
    const unsigned h = lane >> 5, blk = (lane >> 4) & 1u, q = (lane & 15u) >> 2, p = lane & 3u;
    return off_b(16u * ks + 8u * t + 4u * h + q, 4u * c + 2u * blk + (p >> 1)) + 8u * (p & 1u);
}
__device__ __forceinline__ unsigned tr_addr16(unsigned lane, unsigned c, unsigned ks, unsigned t) {
    const unsigned g = lane >> 4, q = (lane & 15u) >> 2, p = lane & 3u;
    return off_b(32u * ks + 8u * g + 4u * t + q, 2u * c + (p >> 1)) + 8u * (p & 1u);
}
__device__ __forceinline__ void glds16(const void* gsrc, unsigned lds_dst) { unsigned keep;
    asm volatile("s_mov_b32 %0, m0\n\ts_mov_b32 m0, %2\n\ts_nop 0\n\tglobal_load_lds_dwordx4 %1, off\n\ts_mov_b32 m0, %0" : "=&s"(keep) : "v"(gsrc), "s"(lds_dst) : "memory"); }
typedef short v4i16_t __attribute__((ext_vector_type(4)));
__device__ __forceinline__ s16x4 tr_read(LAS unsigned char* p) { return __builtin_bit_cast(s16x4, __builtin_amdgcn_ds_read_tr16_b64_v4i16((LAS v4i16_t*)p)); }
__device__ __forceinline__ bf16x8 cat4(s16x4 a, s16x4 b) { return (bf16x8){a[0], a[1], a[2], a[3], b[0], b[1], b[2], b[3]}; }
__device__ __forceinline__ unsigned cvtpk(float lo, float hi) { return pg8::cvt_pk_bf16(lo, hi); }
__device__ __forceinline__ int crow(int r, int hi) { return (r & 3) + 8 * (r >> 2) + 4 * hi; }
__device__ __forceinline__ bf16x8 pack_acc(const f32x16& a, int s) {
    v4u w; w.x = cvtpk(a[8 * s + 0], a[8 * s + 1]); w.y = cvtpk(a[8 * s + 2], a[8 * s + 3]); w.z = cvtpk(a[8 * s + 4], a[8 * s + 5]); w.w = cvtpk(a[8 * s + 6], a[8 * s + 7]);
    return __builtin_bit_cast(bf16x8, w);
}

__device__ __forceinline__ void tr_item(const float* W, int ldw, int srccol0, int k0, const float* gain, float scal, bf16* WT, int K, int dstrow0, LAS float* scr, int lane) {
    float r[32], gv[32];
    const float* wp = W + (size_t)(k0 + (lane >> 5)) * ldw + srccol0 + (lane & 31);
#pragma unroll
    for (int i = 0; i < 32; ++i) r[i] = __builtin_nontemporal_load(wp + (size_t)(2 * i) * ldw);
    if (gain) {
#pragma unroll
        for (int i = 0; i < 32; ++i) gv[i] = gain[k0 + 2 * i + (lane >> 5)] * scal;
    } else {
#pragma unroll
        for (int i = 0; i < 32; ++i) gv[i] = scal;
    }
#pragma unroll
    for (int i = 0; i < 32; ++i) scr[(2 * i + (lane >> 5)) * 33 + (lane & 31)] = r[i] * gv[i];
    LDS_WAIT(); asm volatile("" ::: "memory");
    const int c = lane & 7;
#pragma unroll
    for (int j = 0; j < 4; ++j) { const int n = (lane >> 3) + 8 * j; const LAS float* s = scr + (8 * c) * 33 + n;
        v4u o; o.x = pk2(s[0 * 33], s[1 * 33]); o.y = pk2(s[2 * 33], s[3 * 33]); o.z = pk2(s[4 * 33], s[5 * 33]); o.w = pk2(s[6 * 33], s[7 * 33]);
        *(GAS v4u*)(WT + (size_t)(dstrow0 + n) * K + k0 + 8 * c) = o; }
    LDS_WAIT(); asm volatile("" ::: "memory");
}

struct Args { const float* x; const float* p; const int* pos; const float* g_mix; const float* w_in; const float* pool_w; const float* pool_scale; const float* w_out; const float* g_ffn;
              const float* w_gate; const float* w_up; const float* w_down; const float* g_ple; const float* w_ple_gate; const float* w_ple_proj; const float* g_final; float* out; unsigned char* ws; };

template <int W> __device__ __forceinline__ void pool_rows(const bf16* uw, bf16* mix, int b, int s0, int c0) {
    constexpr int NR = W - 1 + 16;
    v2u xr[NR];
#pragma unroll
    for (int i = 0; i < NR; ++i) { const int s = s0 - (W - 1) + i;
        xr[i] = (s >= 0) ? *(const GAS v2u*)(uw + (size_t)(b * SEQ + s) * 512 + c0) : (v2u){0u, 0u}; }
    float sum[4];
#pragma unroll
    for (int j = 0; j < 4; ++j) sum[j] = 0.f;
#pragma unroll
    for (int i = 0; i < W - 1; ++i)
#pragma unroll
        for (int j = 0; j < 2; ++j) { sum[2 * j] += bf_lo(xr[i][j]); sum[2 * j + 1] += bf_hi(xr[i][j]); }
#pragma unroll
    for (int i = 0; i < 16; ++i) {
        const int s = s0 + i; const float inv = 1.0f / (float)((s + 1 < W) ? (s + 1) : W);
        float o[4];
#pragma unroll
        for (int j = 0; j < 2; ++j) { const float a = bf_lo(xr[W - 1 + i][j]), c = bf_hi(xr[W - 1 + i][j]);
            sum[2 * j] += a; sum[2 * j + 1] += c; o[2 * j] = sum[2 * j] * inv - a; o[2 * j + 1] = sum[2 * j + 1] * inv - c;
            sum[2 * j] -= bf_lo(xr[i][j]); sum[2 * j + 1] -= bf_hi(xr[i][j]); }
        *(GAS v2u*)(mix + (size_t)(b * SEQ + s) * 1024 + 512 + c0) = (v2u){pk2(o[0], o[1]), pk2(o[2], o[3])};
    }
}

__global__ void __launch_bounds__(NWAVES * 64, 2) fwd(Args a_in) {
    extern __shared__ __attribute__((aligned(16))) unsigned char lds_raw[];
    LAS unsigned char* lds = (LAS unsigned char*)lds_raw;
    volatile LAS unsigned* MISC = (volatile LAS unsigned*)(lds + MISC_OFF);
    const int tid = threadIdx.x, lane = tid & 63, wave = __builtin_amdgcn_readfirstlane(tid >> 6);
    const int G = gridDim.x, bx = blockIdx.x;
    const int gw = bx * NWAVES + wave, NGW = G * NWAVES;
    typedef const __attribute__((address_space(4))) Args CArgs;
#define PHASE_ENVB(bi_) CArgs* ap_ = (CArgs*)__builtin_amdgcn_kernarg_segment_ptr(); asm volatile("" : "+s"(ap_)); CArgs& a = *ap_; \
    unsigned char* const ws = a.ws; float* const ssqA = (float*)(ws + WS_SSQA) + (size_t)(bi_) * SEQ * 16; float* const ssqB = (float*)(ws + WS_SSQB) + (size_t)(bi_) * SEQ * 16; \
    bf16* const xb = (bf16*)(ws + WS_XB) + (size_t)(bi_) * SEQ * D; bf16* const xb1 = (bf16*)(ws + WS_XB1) + (size_t)(bi_) * SEQ * D; bf16* const pb = (bf16*)(ws + WS_PB) + (size_t)(bi_) * SEQ * PLE; \
    unsigned char* const R = ws + WS_R + (size_t)(bi_) * R_BATCH; \
    bf16* const qb = (bf16*)(R + R_Q); bf16* const kb = (bf16*)(R + R_K); bf16* const vb = (bf16*)(R + R_V); bf16* const gb = (bf16*)(R + R_G); bf16* const uwb = (bf16*)(R + R_UW); \
    bf16* const kvb = (bf16*)(R + R_KV); bf16* const mix = (bf16*)(R + R_MIX); bf16* const hmid = (bf16*)(R + R_H); bf16* const eb = (bf16*)(R + R_E); float* const utmp = (float*)(ws + WS_R + R_UT); \
    (void)ssqA; (void)ssqB; (void)xb; (void)xb1; (void)pb; (void)qb; (void)kb; (void)vb; (void)gb; (void)uwb; (void)kvb; (void)mix; (void)hmid; (void)eb; (void)utmp
#define PHASE_ENV() PHASE_ENVB(batch)
    gu32* ctl = (gu32*)(a_in.ws + WS_CTL);
    for (int u = tid; u < (LDS_BYTES - LDSCTL_OFF) / 4; u += NWAVES * 64) ((LAS unsigned*)(lds + LDSCTL_OFF))[u] = 0u;
    __syncthreads();
    XcdBarrier bar = xcd_barrier_post((unsigned*)(ctl + CW_BAR), MISC + 8);

#ifndef PHMASK
#define PHMASK 0xFFFF
#endif
#define PH(n) ((PHMASK >> (n)) & 1)
#define FRESH_TID(name) int name = threadIdx.x; asm volatile("" : "+v"(name))
    if (PH(0)) { PHASE_ENVB(0);
    for (int task = gw; task < DEPTH * 4 * 2 * 128; task += NGW) {
        const int kb8 = task & 127, dh = (task >> 7) & 1, g = (task >> 8) & 3, L = task >> 10;
        const int d = dh * 64 + lane;
        const float* pw = a.pool_w + (size_t)((L * 4 + g) * 128) * 128 + d;
        const float* wi = a.w_in + (size_t)(L * 1024 + kb8 * 8) * INW + 2048 + g * 128;
        float acc[8];
#pragma unroll
        for (int i = 0; i < 8; ++i) acc[i] = 0.f;
#pragma unroll 4
        for (int c = 0; c < 128; ++c) { const float bv = pw[(size_t)c * 128];
#pragma unroll
            for (int i = 0; i < 8; ++i) acc[i] += wi[(size_t)i * INW + c] * bv; }
        const float sc = a.pool_scale[L * 512 + g * 128 + d];
#pragma unroll
        for (int i = 0; i < 8; ++i) utmp[(size_t)(L * 1024 + kb8 * 8 + i) * 512 + g * 128 + d] = acc[i] * sc;
    }
    }
    xcd_barrier(bar);
    if (threadIdx.x == 0) {
        unsigned* barw = (unsigned*)(ctl + CW_BAR);
        const unsigned nloc_ = MISC[8], nx_ = MISC[9], rk_ = MISC[10], myx_ = xb_xcc_id();
        unsigned mode_ = 0u, batch_ = 0u, rank_ = 0u, gsz_ = 1u;
        if (nx_ == 8u) { mode_ = 1u; for (unsigned j = 0; j < 16; ++j) if (j < myx_ && xb_ld(&barw[XB_XCNT(j)]) > 0u) ++batch_; rank_ = rk_; gsz_ = nloc_; }
        else { const unsigned t_ = xb_add(&barw[XB_TICKET], 1u); batch_ = t_ % 8u; rank_ = t_ / 8u; gsz_ = (unsigned)G / 8u + ((batch_ < (unsigned)G % 8u) ? 1u : 0u); }
        MISC[11] = mode_; MISC[12] = batch_; MISC[13] = rank_; MISC[14] = gsz_;
    }
    __syncthreads();
    const int lmode = __builtin_amdgcn_readfirstlane((int)MISC[11]), batch = __builtin_amdgcn_readfirstlane((int)MISC[12]), rank = __builtin_amdgcn_readfirstlane((int)MISC[13]), gsz = __builtin_amdgcn_readfirstlane((int)MISC[14]);
#define LBAR() do { if (lmode) xcd_local_barrier(bar); else xcd_barrier(bar); } while (0)

    if (PH(1)) { PHASE_ENVB(0);
        LAS float* scr = (LAS float*)(lds + wave * 16384);
        constexpr int I_IN = 16 * 80, I_OUT = 16 * 32, I_GU = 16 * 176, I_DN = 44 * 32, I_PG = 16 * 32, I_PP = 4 * 32, I_L = I_IN + I_OUT + I_GU + I_DN + I_PG + I_PP;
        for (int it = gw; it < DEPTH * I_L; it += NGW) {
            const int L = it / I_L; int r = it % I_L;
            unsigned char* wl = ws + WS_W + (size_t)L * W_LAYER;
            if (r < I_IN) { const int kbk = r / 80, nb = r % 80, n0 = 32 * nb, k0 = 64 * kbk; const float* gn = a.g_mix + L * 1024;
                if (n0 < 1024) { const int sec = n0 >> 9, w = n0 & 511, t = w >> 8, bj = (w >> 7) & 1, hh = (w >> 6) & 1, dd0 = w & 63;
                    tr_item(a.w_in + (size_t)L * 1024 * INW, INW, sec * 512 + (2 * t + hh) * 128 + bj * 64 + dd0, k0, gn, sec == 0 ? 0.08838834764831845f : 1.0f, (bf16*)(wl + WO_IN), 1024, n0, scr, lane); }
                else if (n0 < 2048) tr_item(a.w_in + (size_t)L * 1024 * INW, INW, n0, k0, gn, 1.0f, (bf16*)(wl + WO_IN), 1024, n0, scr, lane);
                else tr_item(utmp + (size_t)L * 1024 * 512, 512, n0 - 2048, k0, gn, 1.0f, (bf16*)(wl + WO_IN), 1024, n0, scr, lane);
                continue; } r -= I_IN;
            if (r < I_OUT) { const int kbk = r / 32, nb = r % 32; tr_item(a.w_out + (size_t)L * 1024 * 1024, 1024, 32 * nb, 64 * kbk, nullptr, 1.0f, (bf16*)(wl + WO_OUT), 1024, 32 * nb, scr, lane); continue; } r -= I_OUT;
            if (r < I_GU) { const int kbk = r / 176, nb = r % 176, n0 = 32 * nb, t = n0 >> 8, bj = (n0 >> 7) & 1, j0 = n0 & 127;
                tr_item((bj ? a.w_up : a.w_gate) + (size_t)L * 1024 * FF, FF, 128 * t + j0, 64 * kbk, a.g_ffn + L * 1024, 1.0f, (bf16*)(wl + WO_GU), 1024, n0, scr, lane); continue; } r -= I_GU;
            if (r < I_DN) { const int kbk = r / 32, nb = r % 32; tr_item(a.w_down + (size_t)L * FF * 1024, 1024, 32 * nb, 64 * kbk, nullptr, 1.0f, (bf16*)(wl + WO_DOWN), FF, 32 * nb, scr, lane); continue; } r -= I_DN;
            if (r < I_PG) { const int kbk = r / 32, nb = r % 32; tr_item(a.w_ple_gate + (size_t)L * 1024 * 1024, 1024, 32 * nb, 64 * kbk, a.g_ple + L * 1024, 1.0f, (bf16*)(wl + WO_PG), 1024, 32 * nb, scr, lane); continue; } r -= I_PG;
            { const int kbk = r / 32, nb = r % 32; tr_item(a.w_ple_proj + (size_t)L * PLE * 1024, 1024, 32 * nb, 64 * kbk, nullptr, 1.0f, (bf16*)(wl + WO_PP), PLE, 32 * nb, scr, lane); }
        }
        for (int m = 2 * gw; m < M; m += 2 * NGW) {
            const GAS f32x4* xr = (const GAS f32x4*)(a.x + (size_t)m * D) + lane; GAS v2u* o8 = (GAS v2u*)(xb1 + (size_t)m * D) + lane;
            f32x4 v[8];
#pragma unroll
            for (int j = 0; j < 8; ++j) v[j] = __builtin_nontemporal_load(xr + 64 * j);
            float ss0 = 0.f, ss1 = 0.f;
#pragma unroll
            for (int j = 0; j < 4; ++j) { ss0 += (v[j][0] * v[j][0] + v[j][1] * v[j][1]) + (v[j][2] * v[j][2] + v[j][3] * v[j][3]); o8[64 * j] = (v2u){pk2(v[j][0], v[j][1]), pk2(v[j][2], v[j][3])}; }
#pragma unroll
            for (int j = 4; j < 8; ++j) { ss1 += (v[j][0] * v[j][0] + v[j][1] * v[j][1]) + (v[j][2] * v[j][2] + v[j][3] * v[j][3]); o8[64 * j] = (v2u){pk2(v[j][0], v[j][1]), pk2(v[j][2], v[j][3])}; }
            ss0 = wave_sum(ss0); ss1 = wave_sum(ss1);
            if (lane < 32) ssqB[(size_t)m * 16 + lane] = (lane == 0) ? ss0 : (lane == 16) ? ss1 : 0.f;
        }
        for (size_t i = (size_t)bx * 512 + tid; i < (size_t)M * PLE / 8; i += (size_t)G * 512) {
            const f32x4 v0 = ((const GAS f32x4*)a.p)[2 * i], v1 = ((const GAS f32x4*)a.p)[2 * i + 1];
            ((GAS v4u*)pb)[i] = (v4u){pk2(v0[0], v0[1]), pk2(v0[2], v0[3]), pk2(v1[0], v1[1]), pk2(v1[2], v1[3])};
        }
    }
    xcd_barrier(bar);

    for (int L = 0; L < DEPTH; ++L) {

#ifndef REP_P1
#define REP_P1 1
#endif
#pragma unroll 1
        for (int rep_ = 0; rep_ < REP_P1; ++rep_) {
        if (PH(2)) {
            PHASE_ENV(); const unsigned char* wl = ws + WS_W + (size_t)L * W_LAYER; (void)wl; FRESH_TID(ptid); pg8::Gemm g{xb1, (const bf16*)(wl + WO_IN), SEQ, INW, D}; pg8::BatchOrder S; S.init(INW, gsz, rank);
            PG8_LAS float* side = (PG8_LAS float*)(lds + SIDE_OFF); const int npu = (S.nwg + gsz - 1) / gsz;     PG8_LAS float* posf = side + npu * 256; PG8_LAS float* rope = posf + npu * 256;
            pg8::fill_rstd(S, ssqB, side, a.pos + batch * SEQ, posf, ptid); if (ptid < 64) { rope[ptid] = ROPE_HI[ptid]; rope[64 + ptid] = ROPE_LO[ptid]; } __syncthreads();
            pg8::EpiInProj E{side, posf, rope, qb, kb, vb, gb, uwb};
            pg8::gemm_phase<pg8::EpiInProj, pg8::BatchOrder, true, true>(lds, g, S, E, ptid);
        }
        LBAR();


        }
#ifndef REP_RET
#define REP_RET 1
#endif
#pragma unroll 1
        for (int rep_ = 0; rep_ < REP_RET; ++rep_) {
        if (PH(3)) { PHASE_ENV();
            FRESH_TID(t_); const int tid = t_, lane = t_ & 63, wave = __builtin_amdgcn_readfirstlane(t_ >> 6); (void)tid; (void)lane; (void)wave;
            for (int u = rank; u < NH * NCH; u += gsz) {
                const bf16* kt = kb + (size_t)u * 16384; const bf16* vt = vb + (size_t)u * 16384;
                v4u ra[4], rb[4];
#pragma unroll
                for (int i = 0; i < 4; ++i) { const int c = tid + 512 * i; ra[i] = ((const GAS v4u*)kt)[c]; rb[i] = ((const GAS v4u*)vt)[c]; }
#pragma unroll
                for (int i = 0; i < 4; ++i) { const unsigned c = tid + 512 * i, o = off_b(c >> 4, c & 15); *(LAS v4u*)(lds + o) = ra[i]; *(LAS v4u*)(lds + 32768 + o) = rb[i]; }
                __syncthreads();
                const int dt = wave >> 1, et0 = (wave & 1) * 2;
                f32x16 acc0, acc1;
#pragma unroll
                for (int r = 0; r < 16; ++r) { acc0[r] = 0.f; acc1[r] = 0.f; }
#pragma unroll
                for (int ks = 0; ks < 8; ++ks) {
                    const bf16x8 A = cat4(tr_read(lds + tr_addr_nat(lane, dt, ks, 0)), tr_read(lds + tr_addr_nat(lane, dt, ks, 1)));
                    const bf16x8 B0 = cat4(tr_read(lds + 32768 + tr_addr_nat(lane, et0, ks, 0)), tr_read(lds + 32768 + tr_addr_nat(lane, et0, ks, 1)));
                    const bf16x8 B1 = cat4(tr_read(lds + 32768 + tr_addr_nat(lane, et0 + 1, ks, 0)), tr_read(lds + 32768 + tr_addr_nat(lane, et0 + 1, ks, 1)));
                    acc0 = __builtin_amdgcn_mfma_f32_32x32x16_bf16(A, B0, acc0, 0, 0, 0);
                    acc1 = __builtin_amdgcn_mfma_f32_32x32x16_bf16(A, B1, acc1, 0, 0, 0);
                }
                bf16* kvt = kvb + (size_t)u * 16384;
#pragma unroll
                for (int s = 0; s < 2; ++s) {
                    *(GAS bf16x8*)(kvt + ((dt * 4 + et0) * 2 + s) * 512 + lane * 8) = pack_acc(acc0, s);
                    *(GAS bf16x8*)(kvt + ((dt * 4 + et0 + 1) * 2 + s) * 512 + lane * 8) = pack_acc(acc1, s);
                }
                __syncthreads();
            }
            for (int it = rank; it < NCH; it += gsz) {
                const int b = it >> 5, n = it & 31, gi = wave & 3, half = wave >> 2;
#pragma unroll 1
                for (int ps = 0; ps < 2; ++ps) {
                    const int s0 = n * 128 + half * 64 + ps * 32 + (lane >> 5) * 16, c0 = gi * 128 + (lane & 31) * 4;
                    if (gi == 0) pool_rows<2>(uwb, mix, b, s0, c0); else if (gi == 1) pool_rows<4>(uwb, mix, b, s0, c0); else if (gi == 2) pool_rows<8>(uwb, mix, b, s0, c0); else pool_rows<16>(uwb, mix, b, s0, c0);
                }
            }
            if (L > 0) {
                const GAS f32x4* ps = (const GAS f32x4*)(a.p + ((size_t)L * M + (size_t)batch * SEQ) * PLE);
                for (size_t i = (size_t)rank * 512 + tid; i < (size_t)SEQ * PLE / 8; i += (size_t)gsz * 512) {
                    const f32x4 v0 = ps[2 * i], v1 = ps[2 * i + 1];
                    ((GAS v4u*)pb)[i] = (v4u){pk2(v0[0], v0[1]), pk2(v0[2], v0[3]), pk2(v1[0], v1[1]), pk2(v1[2], v1[3])};
                }
            }
        }
        LBAR();


        if (PH(4)) { PHASE_ENV(); FRESH_TID(t_); const int tid = t_, lane = t_ & 63, wave = __builtin_amdgcn_readfirstlane(t_ >> 6); (void)tid; (void)lane; (void)wave;
        for (int c = rank * 512 + tid; c < NH * 4096; c += gsz * 512) {
            const int bh = c >> 12; const float cd = __builtin_amdgcn_exp2f(128.0f * lg2gamma(bh & 3));
            GAS v2u* base = (GAS v2u*)(kvb + (size_t)bh * NCH * 16384) + (c & 4095);
            v2u t[NCH];
#pragma unroll
            for (int n = 0; n < NCH; ++n) t[n] = base[(size_t)n * 4096];
            float r0 = 0.f, r1 = 0.f, r2 = 0.f, r3 = 0.f;
#pragma unroll
            for (int n = 0; n < NCH; ++n) {
                const v2u in = t[n];
                base[(size_t)n * 4096] = (v2u){pk2(r0, r1), pk2(r2, r3)};
                r0 = cd * (r0 + bf_lo(in[0])); r1 = cd * (r1 + bf_hi(in[0])); r2 = cd * (r2 + bf_lo(in[1])); r3 = cd * (r3 + bf_hi(in[1]));
            }
        }
        }
        LBAR();

        if (PH(5)) { PHASE_ENV(); FRESH_TID(t_); const int tid = t_, lane = t_ & 63, wave = __builtin_amdgcn_readfirstlane(t_ >> 6);
        LAS float* red = (LAS float*)(lds + SIDE_OFF);
        for (int u = rank; u < NH * NCH; u += gsz) {
            const int bh = u >> 5, n = u & 31, h = bh & 3, b = bh >> 2;
            const int qt = wave & 3, eh = wave >> 2, ql = lane & 31, hh = lane >> 5;
            const size_t tile = ((size_t)bh * SEQ + n * 128) * 128;
            {
                v4u rg[16];
#pragma unroll
                for (int ti = 0; ti < 4; ++ti) { const bf16* src = (ti == 0 ? kb : ti == 1 ? vb : ti == 2 ? qb : gb) + tile;
#pragma unroll
                    for (int i = 0; i < 4; ++i) rg[ti * 4 + i] = ((const GAS v4u*)src)[tid + 512 * i]; }
#pragma unroll
                for (int ti = 0; ti < 4; ++ti)
#pragma unroll
                    for (int i = 0; i < 4; ++i) { const unsigned c = tid + 512 * i; *(LAS v4u*)(lds + ti * 32768 + off_b(c >> 4, c & 15)) = rg[ti * 4 + i]; }
            }
            const bf16* stt = kvb + (size_t)u * 16384;
            bf16x8 sf[2][4][2];
#pragma unroll
            for (int ei = 0; ei < 2; ++ei)
#pragma unroll
                for (int dt = 0; dt < 4; ++dt)
#pragma unroll
                    for (int s = 0; s < 2; ++s) sf[ei][dt][s] = *(const GAS bf16x8*)(stt + ((dt * 4 + 2 * eh + ei) * 2 + s) * 512 + lane * 8);
            __syncthreads();
            LAS unsigned char* kzl = lds; LAS unsigned char* vl = lds + 32768; LAS unsigned char* qlds = lds + 65536; LAS unsigned char* glds = lds + 98304;
            bf16x8 qf[4][2];
            { const unsigned qrow = 32u * qt + (unsigned)ql;
#pragma unroll
              for (int dt = 0; dt < 4; ++dt)
#pragma unroll
                for (int s = 0; s < 2; ++s) { const v2u lo = *(const LAS v2u*)(qlds + off_b(qrow, 4 * dt + 2 * s) + 8 * hh), hi = *(const LAS v2u*)(qlds + off_b(qrow, 4 * dt + 2 * s + 1) + 8 * hh);
                    qf[dt][s] = __builtin_bit_cast(bf16x8, (v4u){lo[0], lo[1], hi[0], hi[1]}); } }
            bf16x8 pf[4][2];
#pragma unroll
            for (int kt = 0; kt < 4; ++kt) {
                if (kt <= qt) {
                    f32x16 sa;
#pragma unroll
                    for (int r = 0; r < 16; ++r) sa[r] = 0.f;
                    const unsigned krow = 32 * kt + ql;
#pragma unroll
                    for (int dt = 0; dt < 4; ++dt)
#pragma unroll
                        for (int s = 0; s < 2; ++s) {
                            const v2u lo = *(const LAS v2u*)(kzl + off_b(krow, 4 * dt + 2 * s) + 8 * hh), hi = *(const LAS v2u*)(kzl + off_b(krow, 4 * dt + 2 * s + 1) + 8 * hh);
                            sa = __builtin_amdgcn_mfma_f32_32x32x16_bf16(__builtin_bit_cast(bf16x8, (v4u){lo[0], lo[1], hi[0], hi[1]}), qf[dt][s], sa, 0, 0, 0); }
                    if (kt == qt) {
#pragma unroll
                        for (int r = 0; r < 16; ++r) sa[r] = (crow(r, hh) > ql) ? 0.f : sa[r];
                    }
                    pf[kt][0] = pack_acc(sa, 0); pf[kt][1] = pack_acc(sa, 1);
                } else { pf[kt][0] = (bf16x8){0, 0, 0, 0, 0, 0, 0, 0}; pf[kt][1] = (bf16x8){0, 0, 0, 0, 0, 0, 0, 0}; }
            }
            f32x16 oacc[2];
#pragma unroll
            for (int ei = 0; ei < 2; ++ei) {
                const int et = 2 * eh + ei; f32x16 o;
#pragma unroll
                for (int r = 0; r < 16; ++r) o[r] = 0.f;
#pragma unroll
                for (int kt = 0; kt < 4; ++kt) {
                    if (kt <= qt) {
#pragma unroll
                        for (int s = 0; s < 2; ++s) {
                            const bf16x8 vf = cat4(tr_read(vl + tr_addr_perm(lane, et, 2 * kt + s, 0)), tr_read(vl + tr_addr_perm(lane, et, 2 * kt + s, 1)));
                            o = __builtin_amdgcn_mfma_f32_32x32x16_bf16(vf, pf[kt][s], o, 0, 0, 0); }
                    }
                }
#pragma unroll
                for (int dt = 0; dt < 4; ++dt)
#pragma unroll
                    for (int s = 0; s < 2; ++s) o = __builtin_amdgcn_mfma_f32_32x32x16_bf16(sf[ei][dt][s], qf[dt][s], o, 0, 0, 0);
                oacc[ei] = o;
            }
            const float rsc = __builtin_amdgcn_exp2f((float)(32 * qt + ql - 127) * lg2gamma(h));
            float ss = 0.f;
#pragma unroll
            for (int ei = 0; ei < 2; ++ei)
#pragma unroll
                for (int r = 0; r < 16; ++r) { const float y = oacc[ei][r] * rsc; oacc[ei][r] = y; ss += y * y; }
            ss = add_xor32(ss);
            if (hh == 0) red[eh * 128 + 32 * qt + ql] = ss;
            __syncthreads();
            const float rn = rsqrtf((red[32 * qt + ql] + red[128 + 32 * qt + ql]) * (1.0f / 128.0f) + EPS);
            { const unsigned yrow = 32u * qt + (unsigned)ql;
#pragma unroll
              for (int ei = 0; ei < 2; ++ei)
#pragma unroll
                for (int rg = 0; rg < 4; ++rg) {
                    const unsigned e0 = 32u * (2 * eh + ei) + 8u * rg + 4u * hh, ch = e0 >> 3, sub = (e0 & 7u) * 2u;
                    const v2u gv = *(const LAS v2u*)(glds + off_b(yrow, ch) + sub);
                    float o[4];
#pragma unroll
                    for (int j = 0; j < 4; ++j) { const float gt = (j & 1) ? bf_hi(gv[j >> 1]) : bf_lo(gv[j >> 1]);
                        o[j] = gt * __builtin_amdgcn_rcpf(1.0f + __builtin_amdgcn_exp2f(-1.4426950408889634f * gt)) * (oacc[ei][4 * rg + j] * rn); }
                    *(LAS v2u*)(qlds + off_b(yrow, ch) + sub) = (v2u){pk2(o[0], o[1]), pk2(o[2], o[3])};
                } }
            __syncthreads();
            { bf16* orow = mix + ((size_t)b * SEQ + n * 128) * 1024 + h * 128;
#pragma unroll
              for (int i = 0; i < 4; ++i) { const unsigned c = tid + 512 * i, row = c >> 4, ch = c & 15; *(GAS v4u*)(orow + (size_t)row * 1024 + ch * 8) = *(const LAS v4u*)(qlds + off_b(row, ch)); } }
            __syncthreads();
        }
        }
        LBAR();

        }
        if (PH(6)) {
            PHASE_ENV(); const unsigned char* wl = ws + WS_W + (size_t)L * W_LAYER; (void)wl; FRESH_TID(ptid); pg8::Gemm g{mix, (const bf16*)(wl + WO_OUT), SEQ, D, D}; pg8::BatchOrder S; S.init(D, gsz, rank);
            pg8::EpiResid E{xb1, xb, ssqA};
            pg8::gemm_phase<pg8::EpiResid, pg8::BatchOrder, true, true>(lds, g, S, E, ptid);
        }
        LBAR();


#ifndef REP_P6
#define REP_P6 1
#endif
#pragma unroll 1
        for (int rep_ = 0; rep_ < REP_P6; ++rep_) {
        if (PH(7)) {
            PHASE_ENV(); const unsigned char* wl = ws + WS_W + (size_t)L * W_LAYER; (void)wl; FRESH_TID(ptid); pg8::Gemm g{xb, (const bf16*)(wl + WO_GU), SEQ, 2 * FF, D}; pg8::BatchOrder S; S.init(2 * FF, gsz, rank);
            PG8_LAS float* side = (PG8_LAS float*)(lds + SIDE_OFF); pg8::fill_rstd(S, ssqA, side, (const int*)nullptr, (PG8_LAS float*)nullptr, ptid); __syncthreads();
            pg8::EpiSwiGLU E{side, hmid};
            pg8::gemm_phase<pg8::EpiSwiGLU, pg8::BatchOrder, true, true>(lds, g, S, E, ptid);
        }
        LBAR();

        }
        if (PH(8)) {
            PHASE_ENV(); const unsigned char* wl = ws + WS_W + (size_t)L * W_LAYER; (void)wl; FRESH_TID(ptid); pg8::Gemm g{hmid, (const bf16*)(wl + WO_DOWN), SEQ, D, FF}; pg8::BatchOrder S; S.init(D, gsz, rank);
            pg8::EpiResid E{xb, xb, ssqA};
            pg8::gemm_phase<pg8::EpiResid, pg8::BatchOrder, true, true>(lds, g, S, E, ptid);
        }
#ifndef REP_PE
#define REP_PE 1
#endif
#pragma unroll 1
        for (int rep_ = 0; rep_ < REP_PE; ++rep_)
        if (PH(9)) {
            PHASE_ENV(); const unsigned char* wl = ws + WS_W + (size_t)L * W_LAYER; (void)wl; FRESH_TID(ptid); pg8::Gemm g{pb, (const bf16*)(wl + WO_PP), SEQ, D, PLE}; pg8::BatchOrder S; S.init(D, gsz, rank);
            pg8::EpiPlain E{eb, D};
            pg8::gemm_phase<pg8::EpiPlain, pg8::BatchOrder, true, true>(lds, g, S, E, ptid);
        }
        LBAR();

        if (PH(10)) {
            PHASE_ENV(); const unsigned char* wl = ws + WS_W + (size_t)L * W_LAYER; (void)wl; FRESH_TID(ptid); pg8::Gemm g{xb, (const bf16*)(wl + WO_PG), SEQ, D, D}; pg8::BatchOrder S; S.init(D, gsz, rank);
            PG8_LAS float* side = (PG8_LAS float*)(lds + SIDE_OFF); pg8::fill_rstd(S, ssqA, side, (const int*)nullptr, (PG8_LAS float*)nullptr, ptid); __syncthreads();
            pg8::EpiPle E{side, eb, xb, xb1, ssqB};
            pg8::gemm_phase<pg8::EpiPle, pg8::BatchOrder, true, true>(lds, g, S, E, ptid);
        }
        LBAR();
    }

    if (PH(11)) { PHASE_ENV(); FRESH_TID(t_); const int lane = t_ & 63, gw = rank * NWAVES + __builtin_amdgcn_readfirstlane(t_ >> 6);
        const unsigned tmo = __hip_atomic_load((unsigned*)(ws + WS_CTL) + CW_BAR + XB_TMO, RLX_AGENT);
        for (int m = gw; m < SEQ; m += gsz * NWAVES) {
            float s = (lane < 16) ? ssqB[(size_t)m * 16 + lane] : 0.f; s = wave_sum(s);
            float rs = rsqrtf(s * (1.0f / 1024.0f) + EPS); if (tmo) rs = __builtin_nanf("");
#pragma unroll
            for (int j = 0; j < 2; ++j) { const v4u w = ((const GAS v4u*)(xb1 + (size_t)m * D))[lane + 64 * j]; const GAS f32x4* gp = (const GAS f32x4*)(a.g_final + (lane + 64 * j) * 8);
                f32x4 v0, v1; pg8::unpack8(w, v0, v1); GAS f32x4* op = (GAS f32x4*)(a.out + ((size_t)batch * SEQ + m) * D + (lane + 64 * j) * 8);
                op[0] = v0 * rs * gp[0]; op[1] = v1 * rs * gp[1]; }
        }
    }
}

extern "C" void kernel_launch(void* const* d_in, const int* in_sizes, int n_in, void* d_out, int out_size, void* d_ws, size_t ws_size, hipStream_t stream) {
    static int grid = 0;
    if (grid == 0) {
        if (n_in != 16 || in_sizes[0] != M * D || out_size != M * D || ws_size < WS_END) { fprintf(stderr, "kernel_launch: unexpected shapes (n_in %d, in0 %d, out %d, ws %zu < %zu)\n", n_in, n_in > 0 ? in_sizes[0] : -1, out_size, ws_size, (size_t)WS_END); grid = -1; return; }
        int dev = 0, cus = 0, per_cu = 0;
        if (hipGetDevice(&dev) != hipSuccess || hipDeviceGetAttribute(&cus, hipDeviceAttributeMultiprocessorCount, dev) != hipSuccess) { grid = -1; return; }
        if (hipFuncSetAttribute((const void*)fwd, hipFuncAttributeMaxDynamicSharedMemorySize, LDS_BYTES) != hipSuccess) { fprintf(stderr, "kernel_launch: hipFuncSetAttribute failed\n"); grid = -1; return; }
        if (hipOccupancyMaxActiveBlocksPerMultiprocessor(&per_cu, (const void*)fwd, NWAVES * 64, LDS_BYTES) != hipSuccess || per_cu < 1) fprintf(stderr, "kernel_launch: occupancy query reports %d\n", per_cu);
        (void)hipGetLastError();
        grid = cus;
    }
    if (grid < 0) return;
    if (hipMemsetAsync((char*)d_ws + WS_CTL, 0, CTL_ZERO_BYTES, stream) != hipSuccess) return;
    Args a{};
    a.x = (const float*)d_in[0]; a.p = (const float*)d_in[1]; a.pos = (const int*)d_in[2]; a.g_mix = (const float*)d_in[3]; a.w_in = (const float*)d_in[4]; a.pool_w = (const float*)d_in[5];
    a.pool_scale = (const float*)d_in[6]; a.w_out = (const float*)d_in[7]; a.g_ffn = (const float*)d_in[8]; a.w_gate = (const float*)d_in[9]; a.w_up = (const float*)d_in[10]; a.w_down = (const float*)d_in[11];
    a.g_ple = (const float*)d_in[12]; a.w_ple_gate = (const float*)d_in[13]; a.w_ple_proj = (const float*)d_in[14]; a.g_final = (const float*)d_in[15]; a.out = (float*)d_out; a.ws = (unsigned char*)d_ws;
    hipLaunchKernelGGL(fwd, dim3(grid), dim3(NWAVES * 64), LDS_BYTES, stream, a);
}
```

```cpp
#include <hip/hip_runtime.h>
#include <cstdio>
#include <cstdint>
namespace pg8 {
#define PG8_LAS __attribute__((address_space(3)))
typedef unsigned short bf16_t;
typedef short bf16x8 __attribute__((ext_vector_type(8)));
typedef float f32x4 __attribute__((ext_vector_type(4)));
typedef unsigned u32x4 __attribute__((ext_vector_type(4)));
constexpr int BM = 256, BK = 64, HALF = 128, HTB = HALF * BK * 2  , STAGE_BYTES = 8 * HTB, NXCD = 8, WGM = 8;

__host__ __device__ __forceinline__ int lds_byte(int r, int c) { const int st = (r >> 4) * 2 + (c >> 5), rr = r & 15, cc = c & 31, ob = rr * 64 + cc * 2; return st * 1024 + (ob ^ (((ob >> 9) & 1) << 5)); }
__host__ __device__ __forceinline__ void stage_rc(int b, int& R, int& C) { const int st = b / 1024, sb = b % 1024, swz = sb ^ (((sb >> 9) & 1) << 5); R = (st >> 1) * 16 + swz / 64; C = (st & 1) * 32 + (swz % 64) / 2; }
__host__ __device__ __forceinline__ int perm32(int rho) { const int n = rho >> 4, i = rho & 15; return 8 * (i >> 2) + 4 * n + (i & 3); }

struct Unit { int pm, pn; };
struct Gemm { const bf16_t* A; const bf16_t* Bt; int M, N, K; };

struct StaticOrder {
    int nM, nN, nwg, G, c;
    __host__ __device__ void init(int M, int N, int G_, int c_) { nM = M / BM; nN = N / BM; nwg = nM * nN; G = G_; c = c_; }
    __host__ __device__ bool next(int i, Unit& u) const {
        const long L = (long)i * G + c; if (L >= nwg) return false;
        int wgid = (int)L; { const int q = nwg / NXCD, r = nwg % NXCD, xcd = wgid % NXCD, off = wgid / NXCD; wgid = (xcd < r ? xcd * (q + 1) : r * (q + 1) + (xcd - r) * q) + off; }
        const int nig = WGM * nN, gid = wgid / nig, fm = gid * WGM, gsz = (nM - fm) < WGM ? (nM - fm) : WGM;
        u.pm = fm + ((wgid % nig) % gsz); u.pn = (wgid % nig) / gsz; return true;
    }
    __device__ __forceinline__ void a_ready(const Unit&) const {}
    __device__ __forceinline__ void done(const Unit&) const {}
};

typedef float f32x2_t __attribute__((ext_vector_type(2))); typedef __bf16 bf16x2_t __attribute__((ext_vector_type(2)));
__device__ __forceinline__ unsigned cvt_pk_bf16(float lo, float hi) { f32x2_t v = {lo, hi}; bf16x2_t b = __builtin_convertvector(v, bf16x2_t); return __builtin_bit_cast(unsigned, b); }
template <class Epi, class Sched, bool ALIGN_EPI = false, bool SP2 = false>
__device__ __forceinline__ void gemm_phase(PG8_LAS unsigned char* lds, const Gemm g, const Sched& S, const Epi& E, const int tid_in) {
    const int tid = tid_in, wid = __builtin_amdgcn_readfirstlane(tid >> 6), lane = tid & 63, wr = wid >> 2, wc = wid & 3, fr = lane & 15, fq = lane >> 4;
    const int K = g.K, nt = K / BK;
    unsigned voffA[2], voffB[2];
#pragma unroll
    for (int i = 0; i < 2; ++i) { int R, C; stage_rc(tid * 16 + i * 8192, R, C); const int Rb = Epi::PERM ? ((R & ~31) + perm32(R & 31)) : R;
        voffA[i] = (unsigned)(R * K + C) * 2u; voffB[i] = (unsigned)(Rb * K + C) * 2u; }
    const size_t kstep = (size_t)(BK * 2);
    const size_t hstep = (size_t)HALF * K * 2;
    const size_t tstep = 2 * hstep;
    const unsigned ldsw = (unsigned)wid * 1024u;
    const int aoff = lds_byte(wr * 64 + fr, fq * 8), boff = lds_byte(wc * 32 + fr, fq * 8);
#define PG8_SA(b, h) (((b) * 2 + (h)) * HTB)
#define PG8_SB(b, h) ((4 + (b) * 2 + (h)) * HTB)
#define PG8_STAGE(bufoff, gbase, voff) do { _Pragma("unroll") for (int _i = 0; _i < 2; ++_i) \
        __builtin_amdgcn_global_load_lds((const unsigned*)((const char*)(gbase) + (voff)[_i]), (PG8_LAS unsigned*)(lds + (bufoff) + ldsw + _i * 8192), 16, 0, 0); } while (0)
#define PG8_LDA(dst, b, h) do { _Pragma("unroll") for (int m = 0; m < 4; ++m) _Pragma("unroll") for (int k = 0; k < 2; ++k) dst[m][k] = *(const PG8_LAS bf16x8*)(lds + PG8_SA(b, h) + aoff + m * 2048 + k * 1024); } while (0)
#define PG8_LDB(dst, b, h) do { _Pragma("unroll") for (int n = 0; n < 2; ++n) _Pragma("unroll") for (int k = 0; k < 2; ++k) dst[n][k] = *(const PG8_LAS bf16x8*)(lds + PG8_SB(b, h) + boff + n * 2048 + k * 1024); } while (0)
#define PG8_MMA(ai, bj, At, Bt) do { __builtin_amdgcn_s_setprio(1); _Pragma("unroll") for (int m = 0; m < 4; ++m) _Pragma("unroll") for (int n = 0; n < 2; ++n) _Pragma("unroll") for (int k = 0; k < 2; ++k) \
        acc[ai][bj][m][n] = __builtin_amdgcn_mfma_f32_16x16x32_bf16(Bt[n][k], At[m][k], acc[ai][bj][m][n], 0, 0, 0); __builtin_amdgcn_s_setprio(0); } while (0)
#define PG8_WAIT_V(n) asm volatile("s_waitcnt vmcnt(" #n ")" ::: "memory")
#define PG8_WAIT_L(n) asm volatile("s_waitcnt lgkmcnt(" #n ")" ::: "memory")
#define PG8_BAR __builtin_amdgcn_s_barrier()
#define PG8_SCHED __builtin_amdgcn_sched_barrier(0)
    Unit cur, nxt; int ui = 0;
    if (!S.next(0, cur)) return;
    f32x4 acc[2][2][4][2];
    E.init(acc, cur, wr, wc, fr, fq);
    bf16x8 At[4][2], B0[2][2], B1[2][2];
    const char* cA = (const char*)g.A + (size_t)cur.pm * tstep; const char* cB = (const char*)g.Bt + (size_t)cur.pn * tstep;
    S.a_ready(cur);
    if constexpr (SP2) {
        PG8_STAGE(PG8_SB(0, 0), cB, voffB); PG8_STAGE(PG8_SB(0, 1), cB + hstep, voffB); PG8_STAGE(PG8_SA(0, 0), cA, voffA); PG8_STAGE(PG8_SA(0, 1), cA + hstep, voffA);
        if (wr == 1) PG8_BAR;
        PG8_WAIT_V(2); PG8_BAR;
        PG8_STAGE(PG8_SB(1, 0), cB + kstep, voffB); PG8_STAGE(PG8_SA(1, 0), cA + kstep, voffA); PG8_STAGE(PG8_SB(1, 1), cB + hstep + kstep, voffB);
        PG8_WAIT_V(6); PG8_BAR;
    } else {
        PG8_STAGE(PG8_SB(0, 0), cB, voffB); PG8_STAGE(PG8_SA(0, 0), cA, voffA); PG8_STAGE(PG8_SB(0, 1), cB + hstep, voffB); PG8_STAGE(PG8_SA(0, 1), cA + hstep, voffA);
        if (wr == 1) PG8_BAR;
        PG8_WAIT_V(4); PG8_BAR;
        PG8_STAGE(PG8_SB(1, 0), cB + kstep, voffB); PG8_STAGE(PG8_SA(1, 0), cA + kstep, voffA); PG8_STAGE(PG8_SB(1, 1), cB + hstep + kstep, voffB);
        PG8_WAIT_V(6); PG8_BAR;
    }
    for (;;) {
        const bool has_next = S.next(ui + 1, nxt);
        const char* nA = has_next ? (const char*)g.A + (size_t)nxt.pm * tstep : cA; const char* nB = has_next ? (const char*)g.Bt + (size_t)nxt.pn * tstep : cB;
#pragma unroll 1
        for (int t = 0; t < nt; t += 2) {
            const bool last = (t == nt - 2);
            const char* a1 = cA + (size_t)(t + 1) * kstep;
            const char* a2 = last ? nA : cA + (size_t)(t + 2) * kstep; const char* b2 = last ? nB : cB + (size_t)(t + 2) * kstep;
            const char* a3 = a2 + kstep; const char* b3 = b2 + kstep;
            if (last && has_next) S.a_ready(nxt);
            if constexpr (SP2) {
            PG8_LDB(B0, 0, 0); PG8_LDB(B1, 0, 1); PG8_SCHED; PG8_LDA(At, 0, 0); PG8_STAGE(PG8_SA(1, 1), a1 + hstep, voffA);
            PG8_WAIT_V(8); PG8_WAIT_L(0); PG8_BAR; PG8_MMA(0, 0, At, B0); PG8_MMA(0, 1, At, B1); PG8_BAR; PG8_SCHED;
            PG8_LDA(At, 0, 1); PG8_STAGE(PG8_SB(0, 0), b2, voffB); PG8_STAGE(PG8_SB(0, 1), b2 + hstep, voffB); PG8_STAGE(PG8_SA(0, 0), a2, voffA);
            PG8_WAIT_V(8); PG8_WAIT_L(0); PG8_BAR; PG8_MMA(1, 0, At, B0); PG8_MMA(1, 1, At, B1); PG8_BAR; PG8_SCHED;
            PG8_LDB(B0, 1, 0); PG8_LDB(B1, 1, 1); PG8_SCHED; PG8_LDA(At, 1, 0); PG8_STAGE(PG8_SA(0, 1), a2 + hstep, voffA);
            PG8_WAIT_V(8); PG8_WAIT_L(0); PG8_BAR; PG8_MMA(0, 0, At, B0); PG8_MMA(0, 1, At, B1); PG8_BAR; PG8_SCHED;
            PG8_LDA(At, 1, 1); PG8_STAGE(PG8_SB(1, 0), b3, voffB); PG8_STAGE(PG8_SB(1, 1), b3 + hstep, voffB); PG8_STAGE(PG8_SA(1, 0), a3, voffA);
            PG8_WAIT_V(8); PG8_WAIT_L(0); PG8_BAR; PG8_MMA(1, 0, At, B0); PG8_MMA(1, 1, At, B1); PG8_BAR; PG8_SCHED;
            } else {
            PG8_LDB(B0, 0, 0); PG8_SCHED; PG8_LDA(At, 0, 0); PG8_STAGE(PG8_SA(1, 1), a1 + hstep, voffA);
            PG8_WAIT_L(8); PG8_BAR; PG8_WAIT_L(0); PG8_MMA(0, 0, At, B0); PG8_BAR; PG8_SCHED;
            PG8_LDB(B1, 0, 1); PG8_STAGE(PG8_SB(0, 0), b2, voffB);
            PG8_BAR; PG8_WAIT_L(0); PG8_MMA(0, 1, At, B1); PG8_BAR;
            PG8_LDA(At, 0, 1); PG8_STAGE(PG8_SA(0, 0), a2, voffA);
            PG8_BAR; PG8_WAIT_L(0); PG8_MMA(1, 0, At, B0); PG8_BAR; PG8_SCHED;
            PG8_STAGE(PG8_SB(0, 1), b2 + hstep, voffB);
            PG8_WAIT_V(6); PG8_BAR; PG8_MMA(1, 1, At, B1); PG8_BAR;
            PG8_LDB(B0, 1, 0); PG8_SCHED; PG8_LDA(At, 1, 0); PG8_STAGE(PG8_SA(0, 1), a2 + hstep, voffA);
            PG8_WAIT_L(8); PG8_BAR; PG8_WAIT_L(0); PG8_MMA(0, 0, At, B0); PG8_BAR; PG8_SCHED;
            PG8_LDB(B1, 1, 1); PG8_STAGE(PG8_SB(1, 0), b3, voffB);
            PG8_BAR; PG8_WAIT_L(0); PG8_MMA(0, 1, At, B1); PG8_BAR;
            PG8_LDA(At, 1, 1); PG8_STAGE(PG8_SA(1, 0), a3, voffA);
            PG8_BAR; PG8_WAIT_L(0); PG8_MMA(1, 0, At, B0); PG8_BAR; PG8_SCHED;
            PG8_STAGE(PG8_SB(1, 1), b3 + hstep, voffB);
            PG8_WAIT_V(6); PG8_BAR; PG8_MMA(1, 1, At, B1); PG8_BAR;
            }
        }
        if constexpr (ALIGN_EPI) { if (wr == 0) PG8_BAR; }
        if constexpr (!Epi::AFTER_DRAIN) { E(acc, cur, wr, wc, fr, fq, ui); S.done(cur); }
        if (!has_next) break;
        E.init(acc, nxt, wr, wc, fr, fq);
        cur = nxt; cA = nA; cB = nB; ++ui;
        if constexpr (ALIGN_EPI) { if (wr == 1) PG8_BAR; }
    }
    PG8_WAIT_V(0);
    if constexpr (!ALIGN_EPI) { if (wr == 0) PG8_BAR; }
    PG8_BAR;
    if constexpr (Epi::AFTER_DRAIN) { E.fused(acc, cur, wr, wc, fr, fq, lds, wid, lane); S.done(cur); }
#undef PG8_SA
#undef PG8_SB
#undef PG8_STAGE
#undef PG8_LDA
#undef PG8_LDB
#undef PG8_MMA
#undef PG8_WAIT_V
#undef PG8_WAIT_L
#undef PG8_BAR
#undef PG8_SCHED
}
}

constexpr int BATCH = 8, SEQ = 4096, D = 1024, DEPTH = 4, M = BATCH * SEQ;
constexpr int NH = 4, DH = 128, RW = 512, CHUNK = 128, NCH = SEQ / CHUNK;
constexpr int INW = 2560, FF = 2816, PLE = 256;
constexpr float EPS = 1e-6f;
constexpr int NWAVES = 8;

constexpr size_t MiB = 1u << 20;
constexpr size_t WS_CTL = 0, CTL_ZERO_BYTES = 1 * MiB;
constexpr size_t WS_SSQA = 1 * MiB, WS_SSQB = 3 * MiB;
constexpr size_t WS_W = 8 * MiB, W_LAYER = 26 * MiB;
constexpr size_t WO_IN = 0, WO_OUT = 5 * MiB, WO_GU = 7 * MiB, WO_DOWN = 18 * MiB, WO_PG = 18 * MiB + 5632 * 1024, WO_PP = WO_PG + 2 * MiB;
static_assert(WO_PP + 512 * 1024 == W_LAYER, "weight map");
constexpr size_t WS_XB = 112 * MiB;
constexpr size_t WS_PB = 176 * MiB;
constexpr size_t WS_R = 192 * MiB;
constexpr size_t R_BATCH = 32 * MiB;
constexpr size_t R_Q = 0, R_K = 4 * MiB, R_V = 8 * MiB, R_G = 12 * MiB, R_UW = 16 * MiB, R_KV = 20 * MiB, R_MIX = 24 * MiB;
constexpr size_t R_H = 0, R_E = 24 * MiB, R_UT = 0;
constexpr size_t WS_XB1 = WS_R + 256 * MiB;
constexpr size_t WS_END = WS_XB1 + 64 * MiB;
static_assert((size_t)SEQ * FF * 2 <= R_MIX && R_MIX + (size_t)SEQ * D * 2 == R_BATCH, "per-batch scratch map");
constexpr int CW_BAR = 4096;

constexpr int RING_BYTES = 131072;
constexpr int LDSCTL_OFF = RING_BYTES, MISC_OFF = LDSCTL_OFF + 320;
constexpr int SIDE_OFF = LDSCTL_OFF + 1024;
constexpr int LDS_BYTES = 147456;

#define GAS __attribute__((address_space(1)))
#define LAS __attribute__((address_space(3)))
typedef unsigned short bf16;
typedef unsigned v4u __attribute__((ext_vector_type(4)));
typedef unsigned v2u __attribute__((ext_vector_type(2)));
typedef float f32x4 __attribute__((ext_vector_type(4)));
typedef float f32x16 __attribute__((ext_vector_type(16)));
typedef short bf16x8 __attribute__((ext_vector_type(8)));
typedef short s16x4 __attribute__((ext_vector_type(4)));
typedef GAS unsigned gu32;
#define RLX_AGENT __ATOMIC_RELAXED, __HIP_MEMORY_SCOPE_AGENT
#define LDS_WAIT() asm volatile("s_waitcnt lgkmcnt(0)" ::: "memory")
#define VM_WAIT() asm volatile("s_waitcnt vmcnt(0)" ::: "memory")
__device__ __forceinline__ unsigned f2bf(float f) { unsigned u = __builtin_bit_cast(unsigned, f); return (u + 0x7fffu + ((u >> 16) & 1u)) >> 16; }
__device__ __forceinline__ unsigned pk2(float lo, float hi) { return f2bf(lo) | (f2bf(hi) << 16); }
__device__ __forceinline__ float bf_lo(unsigned w) { return __builtin_bit_cast(float, w << 16); }
__device__ __forceinline__ float bf_hi(unsigned w) { return __builtin_bit_cast(float, w & 0xffff0000u); }

__device__ const float ROPE_HI[64] = {1.591186523e-01f, 1.378173828e-01f, 1.193237305e-01f, 1.033325195e-01f, 8.947753906e-02f, 7.748413086e-02f, 6.710815430e-02f, 5.810546875e-02f, 5.032348633e-02f, 4.357910156e-02f, 3.773498535e-02f, 3.266906738e-02f, 2.829742432e-02f, 2.450561523e-02f, 2.121734619e-02f, 1.837158203e-02f, 1.591491699e-02f, 1.377868652e-02f, 1.193237305e-02f, 1.033401489e-02f, 8.949279785e-03f, 7.749557495e-03f, 6.710052490e-03f, 5.811691284e-03f, 5.031585693e-03f, 4.358291626e-03f, 3.773689270e-03f, 3.268241882e-03f, 2.829551697e-03f, 2.449989319e-03f, 2.121925354e-03f, 1.837730408e-03f, 1.591205597e-03f, 1.378059387e-03f, 1.193046570e-03f, 1.033306122e-03f, 8.947849274e-04f, 7.748603821e-04f, 6.711483002e-04f, 5.810260773e-04f, 5.030632019e-04f, 4.358291626e-04f, 3.772974014e-04f, 3.267526627e-04f, 2.830028534e-04f, 2.449750900e-04f, 2.121925354e-04f, 1.837611198e-04f, 1.591444016e-04f, 1.378059387e-04f, 1.193284988e-04f, 1.033246517e-04f, 8.949637413e-05f, 7.748603821e-05f, 6.711483002e-05f, 5.811452866e-05f, 5.032122135e-05f, 4.357099533e-05f, 3.772974014e-05f, 3.267824650e-05f, 2.829730511e-05f, 2.450495958e-05f, 2.121925354e-05f, 1.837313175e-05f};
__device__ const float ROPE_LO[64] = {3.629074854e-05f, 5.119791695e-06f, 2.563974340e-05f, 1.977708780e-05f, 2.186254642e-05f, 1.915789653e-05f, 6.928708444e-06f, 1.379869173e-05f, 5.725776191e-06f, 4.200542662e-06f, 6.599365861e-06f, 1.379848982e-05f, 4.771514341e-06f, 3.076627763e-06f, 6.306573596e-06f, 7.344074220e-06f, 5.773169960e-07f, 3.563736982e-06f, 2.563974249e-06f, 1.214769213e-06f, 6.603757470e-07f, 7.713804280e-07f, 1.455810320e-06f, 2.354600070e-07f, 1.335517140e-06f, 3.858455244e-08f, 4.692017228e-07f, 4.470491177e-08f, 6.678862974e-07f, 8.798673434e-07f, 4.399224736e-07f, 1.622028520e-07f, 3.438339888e-07f, 1.656388378e-07f, 4.471322939e-07f, 2.168443558e-07f, 2.090887250e-07f, 1.725054801e-07f, 2.529881415e-09f, 1.665971467e-07f, 2.289191343e-07f, 3.858455333e-09f, 1.184457474e-07f, 7.599606278e-08f, 1.910491321e-08f, 1.118285908e-07f, 4.399224807e-08f, 2.814121380e-08f, 1.054154186e-08f, 1.656388271e-08f, 2.087137041e-08f, 2.764489970e-08f, 3.027478712e-09f, 1.725054766e-08f, 2.529881304e-10f, 4.738785808e-09f, 7.990752948e-09f, 1.230677427e-08f, 1.184457421e-08f, 4.619374216e-09f, 4.890723382e-09f, 3.732278930e-09f, 4.399224540e-09f, 5.794353886e-09f};
__device__ __forceinline__ float lg2gamma(int h) { return h == 0 ? -0.04580368961312479f : h == 1 ? -0.02272007650008353f : h == 2 ? -0.011315313227834146f : -0.005646563141142063f; }

__device__ __forceinline__ float add_xor16(float v) { return v + __builtin_bit_cast(float, __builtin_amdgcn_ds_swizzle(__builtin_bit_cast(int, v), 0x401F)); }
__device__ __forceinline__ float add_xor32(float v) { float a_ = v, b_ = v; asm volatile("s_nop 1\n\tv_permlane32_swap_b32 %0, %1" : "+v"(a_), "+v"(b_)); return a_ + b_; }
namespace pg8 {
#ifndef BO_GRP
#define BO_GRP 8
#endif
struct BatchOrder {
    int nN, gsize, rank, nwg;
    __device__ __forceinline__ void init(int N, int gsize_, int rank_) { nN = N / BM; gsize = gsize_; rank = rank_; nwg = 16 * nN; }
    __device__ __forceinline__ bool next(int i, Unit& u) const {
        const int L = i * gsize + rank; if (L >= nwg) return false;
#if defined(BO_ORDER) && BO_ORDER == 1
        const int nb = nN >> 2;
        if (L < nb * 64) { const int q = L >> 6, r = L & 63, g = r >> 5, w = r & 31; u.pm = 8 * g + (w & 7); u.pn = 4 * q + (w >> 3); }
        else { const int Lt = L - nb * 64, rem = nN - 4 * nb, g = Lt / (8 * rem), w = Lt - g * 8 * rem; u.pm = 8 * g + (w & 7); u.pn = 4 * nb + (w >> 3); }
        return true;
#else
        const int grp = L / (BO_GRP * nN), r = L - grp * BO_GRP * nN; u.pm = BO_GRP * grp + (r % BO_GRP); u.pn = r / BO_GRP; return true;
#endif
    }
    __device__ __forceinline__ void a_ready(const Unit&) const {}
    __device__ __forceinline__ void done(const Unit&) const {}
};
__device__ __forceinline__ void load_rstd(const PG8_LAS float* side, int ui, int wr, int fr, float (&rs)[2][4]) {
#pragma unroll
    for (int ai = 0; ai < 2; ++ai)
#pragma unroll
        for (int m = 0; m < 4; ++m) rs[ai][m] = side[ui * 256 + ai * HALF + wr * 64 + m * 16 + fr];
}
template <class Sched> __device__ __forceinline__ void fill_rstd(const Sched& S, const float* ssq, PG8_LAS float* side, const int* pos, PG8_LAS float* posf, int tid) {
    Unit u;
    for (int i = 0; S.next(i, u); ++i) {
        const int row = u.pm * BM + (tid >> 1), hf = tid & 1;
        const f32x4 a = *(const f32x4*)(ssq + (size_t)row * 16 + 8 * hf), b = *(const f32x4*)(ssq + (size_t)row * 16 + 8 * hf + 4);
        float s = ((a[0] + a[1]) + (a[2] + a[3])) + ((b[0] + b[1]) + (b[2] + b[3]));
        s += __builtin_bit_cast(float, __builtin_amdgcn_ds_swizzle(__builtin_bit_cast(int, s), 0x041F));
        if (hf == 0) { side[i * 256 + (tid >> 1)] = rsqrtf(s * (1.0f / 1024.0f) + 1e-6f); if (pos) posf[i * 256 + (tid >> 1)] = (float)pos[row]; }
    }
}
#ifndef WTM
#define WTM 0
#endif
template <int BIT> __device__ __forceinline__ void st16(void* p, const u32x4 v) {
    if constexpr ((WTM >> BIT) & 1) asm volatile("global_store_dwordx4 %0, %1, off sc1\n\ts_nop 0" :: "v"(p), "v"(v) : "memory");
    else *(u32x4*)p = v;
}
__device__ __forceinline__ u32x4 pack8(const f32x4 a, const f32x4 b) { u32x4 w; w.x = cvt_pk_bf16(a[0], a[1]); w.y = cvt_pk_bf16(a[2], a[3]); w.z = cvt_pk_bf16(b[0], b[1]); w.w = cvt_pk_bf16(b[2], b[3]); return w; }

struct EpiInProj {
    static constexpr bool PERM = true, AFTER_DRAIN = false;
    const PG8_LAS float* side; const PG8_LAS float* posf; const PG8_LAS float* rope; bf16_t *q, *k, *v, *g, *uw;
    __device__ __forceinline__ void init(f32x4 (&acc)[2][2][4][2], const Unit&, int, int, int, int) const {
#pragma unroll
        for (int a = 0; a < 2; ++a)
#pragma unroll
            for (int b = 0; b < 2; ++b)
#pragma unroll
                for (int m = 0; m < 4; ++m)
#pragma unroll
                    for (int n = 0; n < 2; ++n) acc[a][b][m][n] = (f32x4){0.f, 0.f, 0.f, 0.f};
    }
    __device__ __forceinline__ void operator()(const f32x4 (&acc)[2][2][4][2], const Unit& u, int wr, int wc, int fr, int fq, int ui) const {
        const int rowbase = u.pm * BM + wr * 64 + fr;
        float rs[2][4]; load_rstd(side, ui, wr, fr, rs);
        if (u.pn < 4) {
            const int sec = u.pn >> 1, head = 2 * (u.pn & 1) + (wc >> 1), dd0 = 32 * (wc & 1) + 8 * fq;
            bf16_t* dst = sec ? k : q;
            const f32x4 h0 = *(const PG8_LAS f32x4*)(rope + dd0), h1 = *(const PG8_LAS f32x4*)(rope + dd0 + 4), l0 = *(const PG8_LAS f32x4*)(rope + 64 + dd0), l1 = *(const PG8_LAS f32x4*)(rope + 64 + dd0 + 4);
            const float lg = lg2gamma(head);
#pragma unroll
            for (int ai = 0; ai < 2; ++ai)
#pragma unroll
                for (int m = 0; m < 4; ++m) {
                    const int row = rowbase + ai * HALF + m * 16, b = row >> 12, s = row & 4095;
                    const float p = posf[ui * 256 + ai * HALF + wr * 64 + m * 16 + fr];
                    const float sc = rs[ai][m] * (sec ? __builtin_amdgcn_exp2f((float)(127 - (s & 127)) * lg) : 1.0f);
                    f32x4 o1[2], o2[2];
#pragma unroll
                    for (int n = 0; n < 2; ++n) { const f32x4 fh = n ? h1 : h0, fl = n ? l1 : l0;
#pragma unroll
                        for (int j = 0; j < 4; ++j) { const float ph = p * fh[j]; const float rev = (ph - __builtin_floorf(ph)) + p * fl[j];
                            const float cs = __builtin_amdgcn_cosf(rev), sn = __builtin_amdgcn_sinf(rev);
                            const float x1 = acc[ai][0][m][n][j] * sc, x2 = acc[ai][1][m][n][j] * sc;
                            o1[n][j] = x1 * cs - x2 * sn; o2[n][j] = x2 * cs + x1 * sn; } }
                    bf16_t* rp = dst + ((size_t)((b * NH_ + head) * SEQ_ + s)) * 128 + dd0;
                    st16<0>(rp, pack8(o1[0], o1[1])); st16<0>((rp + 64), pack8(o2[0], o2[1]));
                    asm volatile("" ::: "memory");
                }
        } else {
            const int sec = (u.pn - 4) >> 1;
            const int c0 = 256 * (u.pn & 1) + 32 * wc + 8 * fq;
#pragma unroll
            for (int ai = 0; ai < 2; ++ai)
#pragma unroll
                for (int m = 0; m < 4; ++m) {
                    const int row = rowbase + ai * HALF + m * 16, b = row >> 12, s = row & 4095; const float sc = rs[ai][m];
#pragma unroll
                    for (int bj = 0; bj < 2; ++bj) { const u32x4 w = pack8(acc[ai][bj][m][0] * sc, acc[ai][bj][m][1] * sc); const int c = c0 + 128 * bj;
                        if (sec == 2) st16<0>((uw + (size_t)row * 512 + c), w);
                        else { bf16_t* dst = sec ? g : v; st16<0>((dst + ((size_t)((b * NH_ + (c >> 7)) * SEQ_ + s)) * 128 + (c & 127)), w); } }
                }
        }
    }
    static constexpr int NH_ = 4, SEQ_ = 4096;
};

__device__ __forceinline__ void unpack8(const u32x4 w, f32x4& a, f32x4& b) {
    a[0] = __builtin_bit_cast(float, w.x << 16); a[1] = __builtin_bit_cast(float, w.x & 0xffff0000u); a[2] = __builtin_bit_cast(float, w.y << 16); a[3] = __builtin_bit_cast(float, w.y & 0xffff0000u);
    b[0] = __builtin_bit_cast(float, w.z << 16); b[1] = __builtin_bit_cast(float, w.z & 0xffff0000u); b[2] = __builtin_bit_cast(float, w.w << 16); b[3] = __builtin_bit_cast(float, w.w & 0xffff0000u);
}
struct EpiResid {
    static constexpr bool PERM = true, AFTER_DRAIN = false;
    const bf16_t* xin; bf16_t* xout; float* ssq_out;
    __device__ __forceinline__ void init(f32x4 (&acc)[2][2][4][2], const Unit& u, int wr, int wc, int fr, int fq) const {
        const int rowbase = u.pm * BM + wr * 64 + fr, col0 = u.pn * BM + 32 * wc + 8 * fq;
        u32x4 w[2][4][2];
#pragma unroll
        for (int ai = 0; ai < 2; ++ai)
#pragma unroll
            for (int m = 0; m < 4; ++m)
#pragma unroll
                for (int bj = 0; bj < 2; ++bj) w[ai][m][bj] = *(const u32x4*)(xin + (size_t)(rowbase + ai * HALF + m * 16) * 1024 + col0 + bj * HALF);
#pragma unroll
        for (int ai = 0; ai < 2; ++ai)
#pragma unroll
            for (int m = 0; m < 4; ++m)
#pragma unroll
                for (int bj = 0; bj < 2; ++bj) unpack8(w[ai][m][bj], acc[ai][bj][m][0], acc[ai][bj][m][1]);
    }
    __device__ __forceinline__ void operator()(const f32x4 (&acc)[2][2][4][2], const Unit& u, int wr, int wc, int fr, int fq, int) const {
        const int rowbase = u.pm * BM + wr * 64 + fr, col0 = u.pn * BM + 32 * wc + 8 * fq;
#pragma unroll
        for (int ai = 0; ai < 2; ++ai)
#pragma unroll
            for (int m = 0; m < 4; ++m) {
                const int row = rowbase + ai * HALF + m * 16; const size_t off = (size_t)row * 1024 + col0; float ss = 0.f;
#pragma unroll
                for (int bj = 0; bj < 2; ++bj) {
                    const f32x4 v0 = acc[ai][bj][m][0], v1 = acc[ai][bj][m][1];
                    st16<1>((xout + off + bj * HALF), pack8(v0, v1));
                    ss += (v0[0] * v0[0] + v0[1] * v0[1]) + (v0[2] * v0[2] + v0[3] * v0[3]) + (v1[0] * v1[0] + v1[1] * v1[1]) + (v1[2] * v1[2] + v1[3] * v1[3]); }
                ss = add_xor32(add_xor16(ss));
                if (fq == 0) ssq_out[(size_t)row * 16 + u.pn * 4 + wc] = ss;
            }
    }
};

struct EpiSwiGLU {
    static constexpr bool PERM = true, AFTER_DRAIN = false;
    const PG8_LAS float* side; bf16_t* h;
    __device__ __forceinline__ void init(f32x4 (&acc)[2][2][4][2], const Unit&, int, int, int, int) const {
#pragma unroll
        for (int a = 0; a < 2; ++a)
#pragma unroll
            for (int b = 0; b < 2; ++b)
#pragma unroll
                for (int m = 0; m < 4; ++m)
#pragma unroll
                    for (int n = 0; n < 2; ++n) acc[a][b][m][n] = (f32x4){0.f, 0.f, 0.f, 0.f};
    }
    __device__ __forceinline__ void operator()(const f32x4 (&acc)[2][2][4][2], const Unit& u, int wr, int wc, int fr, int fq, int ui) const {
        const int rowbase = u.pm * BM + wr * 64 + fr, col0 = u.pn * HALF + 32 * wc + 8 * fq;
        float rs[2][4]; load_rstd(side, ui, wr, fr, rs);
#pragma unroll
        for (int ai = 0; ai < 2; ++ai)
#pragma unroll
            for (int m = 0; m < 4; ++m) { const float sc = rs[ai][m], c1 = -1.4426950408889634f * sc, sc2 = sc * sc; f32x4 o[2];
#pragma unroll
                for (int n = 0; n < 2; ++n)
#pragma unroll
                    for (int jp = 0; jp < 2; ++jp) { const f32x2_t av = {acc[ai][0][m][n][2 * jp], acc[ai][0][m][n][2 * jp + 1]}, bv = {acc[ai][1][m][n][2 * jp], acc[ai][1][m][n][2 * jp + 1]};
                        const f32x2_t t = av * c1; f32x2_t ex; ex.x = __builtin_amdgcn_exp2f(t.x); ex.y = __builtin_amdgcn_exp2f(t.y);
                        const f32x2_t d = ex + 1.0f; f32x2_t r; r.x = __builtin_amdgcn_rcpf(d.x); r.y = __builtin_amdgcn_rcpf(d.y);
                        const f32x2_t ov = (av * bv) * (r * sc2); o[n][2 * jp] = ov.x; o[n][2 * jp + 1] = ov.y; }
                st16<2>((h + (size_t)(rowbase + ai * HALF + m * 16) * 2816 + col0), pack8(o[0], o[1])); }
    }
};

struct EpiPlain {
    static constexpr bool PERM = true, AFTER_DRAIN = false;
    bf16_t* O; int ldc;
    __device__ __forceinline__ void init(f32x4 (&acc)[2][2][4][2], const Unit&, int, int, int, int) const {
#pragma unroll
        for (int a = 0; a < 2; ++a)
#pragma unroll
            for (int b = 0; b < 2; ++b)
#pragma unroll
                for (int m = 0; m < 4; ++m)
#pragma unroll
                    for (int n = 0; n < 2; ++n) acc[a][b][m][n] = (f32x4){0.f, 0.f, 0.f, 0.f};
    }
    __device__ __forceinline__ void operator()(const f32x4 (&acc)[2][2][4][2], const Unit& u, int wr, int wc, int fr, int fq, int) const {
        const int rowbase = u.pm * BM + wr * 64 + fr, col0 = u.pn * BM + 32 * wc + 8 * fq;
#pragma unroll
        for (int ai = 0; ai < 2; ++ai)
#pragma unroll
            for (int m = 0; m < 4; ++m)
#pragma unroll
                for (int bj = 0; bj < 2; ++bj) st16<3>((O + (size_t)(rowbase + ai * HALF + m * 16) * ldc + col0 + bj * HALF), pack8(acc[ai][bj][m][0], acc[ai][bj][m][1]));
    }
};

struct EpiPle {
    static constexpr bool PERM = true, AFTER_DRAIN = false;
    const PG8_LAS float* side; const bf16_t* e; const bf16_t* xin; bf16_t* xout; float* ssq_out;
    __device__ __forceinline__ void init(f32x4 (&acc)[2][2][4][2], const Unit&, int, int, int, int) const {
#pragma unroll
        for (int a = 0; a < 2; ++a)
#pragma unroll
            for (int b = 0; b < 2; ++b)
#pragma unroll
                for (int m = 0; m < 4; ++m)
#pragma unroll
                    for (int n = 0; n < 2; ++n) acc[a][b][m][n] = (f32x4){0.f, 0.f, 0.f, 0.f};
    }
    __device__ __forceinline__ void operator()(const f32x4 (&acc)[2][2][4][2], const Unit& u, int wr, int wc, int fr, int fq, int ui) const {
        const int rowbase = u.pm * BM + wr * 64 + fr, col0 = u.pn * BM + 32 * wc + 8 * fq;
        float rs[2][4]; load_rstd(side, ui, wr, fr, rs);
#pragma unroll
        for (int ai = 0; ai < 2; ++ai)
#pragma unroll
            for (int m = 0; m < 4; ++m) {
                const int row = rowbase + ai * HALF + m * 16; const size_t off = (size_t)row * 1024 + col0; float ss = 0.f; const float sc = -1.4426950408889634f * rs[ai][m];
#pragma unroll
                for (int bj = 0; bj < 2; ++bj) {
                    f32x4 e0, e1, x0, x1; unpack8(*(const u32x4*)(e + off + bj * HALF), e0, e1); unpack8(*(const u32x4*)(xin + off + bj * HALF), x0, x1);
                    f32x4 v0, v1;
#pragma unroll
                    for (int j = 0; j < 4; ++j) {
                        v0[j] = x0[j] + __builtin_amdgcn_rcpf(1.0f + __builtin_amdgcn_exp2f(sc * acc[ai][bj][m][0][j])) * e0[j];
                        v1[j] = x1[j] + __builtin_amdgcn_rcpf(1.0f + __builtin_amdgcn_exp2f(sc * acc[ai][bj][m][1][j])) * e1[j]; }
                    st16<4>((xout + off + bj * HALF), pack8(v0, v1));
                    ss += (v0[0] * v0[0] + v0[1] * v0[1]) + (v0[2] * v0[2] + v0[3] * v0[3]) + (v1[0] * v1[0] + v1[1] * v1[1]) + (v1[2] * v1[2] + v1[3] * v1[3]); }
                ss = add_xor32(add_xor16(ss));
                if (fq == 0) ssq_out[(size_t)row * 16 + u.pn * 4 + wc] = ss;
            }
    }
};
}
#define XB_TMO      128
#define XB_XCNT(j)  (256  + 64 * (j))
#define XB_XSUB(j)  (1280 + 64 * (j))
#define XB_XGEN(j)  (2304 + 64 * (j))
#define XB_TOP      3328
#define XB_TOPGEN   3392
#define XCD_BAR_WORDS 3456
#define XB_SPIN_CAP (1u << 18)

__device__ __forceinline__ unsigned xb_ld(unsigned* p)              { return __hip_atomic_load(p, __ATOMIC_RELAXED, __HIP_MEMORY_SCOPE_AGENT); }
__device__ __forceinline__ unsigned xb_add(unsigned* p, unsigned v) { return __hip_atomic_fetch_add(p, v, __ATOMIC_RELAXED, __HIP_MEMORY_SCOPE_AGENT); }
__device__ __forceinline__ unsigned xb_xcc_id() { return (unsigned)__builtin_amdgcn_s_getreg((3 << 11) | 20) & 0xFu; }
#define XB_SPIN(cond, bar) do { unsigned _sp = 0; while (cond) { __builtin_amdgcn_s_sleep(1); \
    if ((++_sp & 255u) == 0u) { if (xb_ld(&(bar)[XB_TMO])) break; if (_sp > XB_SPIN_CAP) { atomicAdd(&(bar)[XB_TMO], 1u); break; } } } } while (0)

struct XcdBarrier {
    unsigned* bar; unsigned x;
    volatile LAS unsigned* st;
};

__device__ __forceinline__ XcdBarrier xcd_barrier_post(unsigned* bar, volatile LAS unsigned* st) {
    XcdBarrier b; b.bar = bar; b.x = xb_xcc_id(); b.st = st;
    if (threadIdx.x == 0) st[2] = xb_add(&bar[XB_XCNT(b.x)], 1u);
    return b;
}
__device__ __forceinline__ void xcd_barrier_complete(unsigned* bar, unsigned x, unsigned& nloc, unsigned& nx) {
    const unsigned G = gridDim.x * gridDim.y * gridDim.z;
    unsigned sum, cnt, mine, sp = 0u;
    for (;;) {
        sum = 0u; cnt = 0u; mine = 0u;
#pragma unroll
        for (unsigned j = 0; j < 16; ++j) { const unsigned c = xb_ld(&bar[XB_XCNT(j)]); sum += c; cnt += (c > 0u) ? 1u : 0u; mine = (j == x) ? c : mine; }
        if (sum == G) break;
        __builtin_amdgcn_s_sleep(1);
        if ((++sp & 255u) == 0u) { if (xb_ld(&bar[XB_TMO])) break; if (sp > XB_SPIN_CAP) { atomicAdd(&bar[XB_TMO], 1u); break; } }
    }
    nloc = mine > 0u ? mine : 1u; nx = cnt > 0u ? cnt : 1u;
}

__device__ __forceinline__ void xcd_barrier(const XcdBarrier& b) {
    asm volatile("s_waitcnt vmcnt(0)" ::: "memory");
    __syncthreads();
    if (threadIdx.x == 0) {
        unsigned* bar = b.bar; unsigned bx_ = b.x; asm volatile("" : "+s"(bar), "+s"(bx_));
        __builtin_amdgcn_s_waitcnt(0);
        unsigned nloc = b.st[0], nx = b.st[1];
        if (nloc == 0u) { xcd_barrier_complete(bar, bx_, nloc, nx); b.st[0] = nloc; b.st[1] = nx; }
        const unsigned old = xb_add(&bar[XB_XSUB(bx_)], 1u);
        const unsigned gen = old / nloc;
        if (old + 1u == (gen + 1u) * nloc) {
            __builtin_amdgcn_fence(__ATOMIC_RELEASE, "agent");
            asm volatile("s_waitcnt vmcnt(0)" ::: "memory");
            const unsigned og = xb_add(&bar[XB_TOP], 1u);
            const unsigned tg = og / nx;
            if (og + 1u == (tg + 1u) * nx) xb_add(&bar[XB_TOPGEN], 1u);
            else XB_SPIN(xb_ld(&bar[XB_TOPGEN]) == tg, bar);
            __builtin_amdgcn_fence(__ATOMIC_ACQUIRE, "agent");
            xb_add(&bar[XB_XGEN(bx_)], 1u);
            asm volatile("s_waitcnt vmcnt(0)" ::: "memory");
        } else {
            XB_SPIN(xb_ld(&bar[XB_XGEN(bx_)]) == gen, bar);
            __builtin_amdgcn_fence(__ATOMIC_ACQUIRE, "agent");
            asm volatile("s_waitcnt vmcnt(0)" ::: "memory");
        }
    }
    __syncthreads();
}

#define XB_LSUB(j)  (3456 + 64 * (j))
#define XB_LGEN(j)  (3456 + 1024 + 64 * (j))
#define XB_TICKET   (3456 + 2048)
__device__ __forceinline__ void xcd_local_barrier(const XcdBarrier& b) {
    asm volatile("s_waitcnt vmcnt(0)" ::: "memory");
    __syncthreads();
    if (threadIdx.x == 0) {
        unsigned* bar = b.bar; unsigned bx_ = b.x; asm volatile("" : "+s"(bar), "+s"(bx_));
        const unsigned nloc = b.st[0];
        const unsigned old = xb_add(&bar[XB_LSUB(bx_)], 1u);
        const unsigned gen = old / nloc;
        if (old + 1u == (gen + 1u) * nloc) xb_add(&bar[XB_LGEN(bx_)], 1u);
        else XB_SPIN(xb_ld(&bar[XB_LGEN(bx_)]) == gen, bar);
        __builtin_amdgcn_fence(__ATOMIC_ACQUIRE, "agent");
        asm volatile("s_waitcnt vmcnt(0)" ::: "memory");
    }
    __syncthreads();
}

__device__ __forceinline__ float wave_sum(float v) {
    v += __builtin_bit_cast(float, __builtin_amdgcn_ds_swizzle(__builtin_bit_cast(int, v), 0x041F));
    v += __builtin_bit_cast(float, __builtin_amdgcn_ds_swizzle(__builtin_bit_cast(int, v), 0x081F));
    v += __builtin_bit_cast(float, __builtin_amdgcn_ds_swizzle(__builtin_bit_cast(int, v), 0x101F));
    v += __builtin_bit_cast(float, __builtin_amdgcn_ds_swizzle(__builtin_bit_cast(int, v), 0x201F));
    return add_xor32(add_xor16(v));
}
__device__ __forceinline__ unsigned off_b(unsigned row, unsigned ch) { return 256u * row + 16u * (ch ^ (((row & 3u) << 2) | ((row >> 2) & 3u))); }
__device__ __forceinline__ unsigned tr_addr_nat(unsigned lane, unsigned c, unsigned ks, unsigned t) {
    const unsigned h = lane >> 5, blk = (lane >> 4) & 1u, q = (lane & 15u) >> 2, p = lane & 3u;
    return off_b(16u * ks + 8u * h + 4u * t + q, 4u * c + 2u * blk + (p >> 1)) + 8u * (p & 1u);
}
__device__ __forceinline__ unsigned tr_addr_perm(unsigned lane, unsigned c, unsigned ks, unsigned t) {
    const unsigned h = lane >> 5, blk = (lane >> 4) & 1u, q = (lane & 15u) >> 2, p = lane & 3u;
    return off_b(16u * ks + 8u * t + 4u * h + q, 4u * c + 2u * blk + (p >> 1)) + 8u * (p & 1u);
}
__device__ __forceinline__ unsigned tr_addr16(unsigned lane, unsigned c, unsigned ks, unsigned t) {
    const unsigned g = lane >> 4, q = (lane & 15u) >> 2, p = lane & 3u;
    return off_b(32u * ks + 8u * g + 4u * t + q, 2u * c + (p >> 1)) + 8u * (p & 1u);
}
__device__ __forceinline__ void glds16(const void* gsrc, unsigned lds_dst) { unsigned keep;
    asm volatile("s_mov_b32 %0, m0\n\ts_mov_b32 m0, %2\n\ts_nop 0\n\tglobal_load_lds_dwordx4 %1, off\n\ts_mov_b32 m0, %0" : "=&s"(keep) : "v"(gsrc), "s"(lds_dst) : "memory"); }
typedef short v4i16_t __attribute__((ext_vector_type(4)));
__device__ __forceinline__ s16x4 tr_read(LAS unsigned char* p) { return __builtin_bit_cast(s16x4, __builtin_amdgcn_ds_read_tr16_b64_v4i16((LAS v4i16_t*)p)); }
__device__ __forceinline__ bf16x8 cat4(s16x4 a, s16x4 b) { return (bf16x8){a[0], a[1], a[2], a[3], b[0], b[1], b[2], b[3]}; }
__device__ __forceinline__ unsigned cvtpk(float lo, float hi) { return pg8::cvt_pk_bf16(lo, hi); }
__device__ __forceinline__ int crow(int r, int hi) { return (r & 3) + 8 * (r >> 2) + 4 * hi; }
__device__ __forceinline__ bf16x8 pack_acc(const f32x16& a, int s) {
    v4u w; w.x = cvtpk(a[8 * s + 0], a[8 * s + 1]); w.y = cvtpk(a[8 * s + 2], a[8 * s + 3]); w.z = cvtpk(a[8 * s + 4], a[8 * s + 5]); w.w = cvtpk(a[8 * s + 6], a[8 * s + 7]);
    return __builtin_bit_cast(bf16x8, w);
}

__device__ __forceinline__ void tr_item(const float* W, int ldw, int srccol0, int k0, const float* gain, float scal, bf16* WT, int K, int dstrow0, LAS float* scr, int lane) {
    float r[32], gv[32];
    const float* wp = W + (size_t)(k0 + (lane >> 5)) * ldw + srccol0 + (lane & 31);
#pragma unroll
    for (int i = 0; i < 32; ++i) r[i] = __builtin_nontemporal_load(wp + (size_t)(2 * i) * ldw);
    if (gain) {
#pragma unroll
        for (int i = 0; i < 32; ++i) gv[i] = gain[k0 + 2 * i + (lane >> 5)] * scal;
    } else {
#pragma unroll
        for (int i = 0; i < 32; ++i) gv[i] = scal;
    }
#pragma unroll
    for (int i = 0; i < 32; ++i) scr[(2 * i + (lane >> 5)) * 33 + (lane & 31)] = r[i] * gv[i];
    LDS_WAIT(); asm volatile("" ::: "memory");
    const int c = lane & 7;
#pragma unroll
    for (int j = 0; j < 4; ++j) { const int n = (lane >> 3) + 8 * j; const LAS float* s = scr + (8 * c) * 33 + n;
        v4u o; o.x = pk2(s[0 * 33], s[1 * 33]); o.y = pk2(s[2 * 33], s[3 * 33]); o.z = pk2(s[4 * 33], s[5 * 33]); o.w = pk2(s[6 * 33], s[7 * 33]);
        *(GAS v4u*)(WT + (size_t)(dstrow0 + n) * K + k0 + 8 * c) = o; }
    LDS_WAIT(); asm volatile("" ::: "memory");
}

struct Args { const float* x; const float* p; const int* pos; const float* g_mix; const float* w_in; const float* pool_w; const float* pool_scale; const float* w_out; const float* g_ffn;
              const float* w_gate; const float* w_up; const float* w_down; const float* g_ple; const float* w_ple_gate; const float* w_ple_proj; const float* g_final; float* out; unsigned char* ws; };

template <int W> __device__ __forceinline__ void pool_rows(const bf16* uw, bf16* mix, int b, int s0, int c0) {
    constexpr int NR = W - 1 + 16;
    v2u xr[NR];
#pragma unroll
    for (int i = 0; i < NR; ++i) { const int s = s0 - (W - 1) + i;
        xr[i] = (s >= 0) ? *(const GAS v2u*)(uw + (size_t)(b * SEQ + s) * 512 + c0) : (v2u){0u, 0u}; }
    float sum[4];
#pragma unroll
    for (int j = 0; j < 4; ++j) sum[j] = 0.f;
#pragma unroll
    for (int i = 0; i < W - 1; ++i)
#pragma unroll
        for (int j = 0; j < 2; ++j) { sum[2 * j] += bf_lo(xr[i][j]); sum[2 * j + 1] += bf_hi(xr[i][j]); }
#pragma unroll
    for (int i = 0; i < 16; ++i) {
        const int s = s0 + i; const float inv = 1.0f / (float)((s + 1 < W) ? (s + 1) : W);
        float o[4];
#pragma unroll
        for (int j = 0; j < 2; ++j) { const float a = bf_lo(xr[W - 1 + i][j]), c = bf_hi(xr[W - 1 + i][j]);
            sum[2 * j] += a; sum[2 * j + 1] += c; o[2 * j] = sum[2 * j] * inv - a; o[2 * j + 1] = sum[2 * j + 1] * inv - c;
            sum[2 * j] -= bf_lo(xr[i][j]); sum[2 * j + 1] -= bf_hi(xr[i][j]); }
        *(GAS v2u*)(mix + (size_t)(b * SEQ + s) * 1024 + 512 + c0) = (v2u){pk2(o[0], o[1]), pk2(o[2], o[3])};
    }
}

__global__ void __launch_bounds__(NWAVES * 64, 2) fwd(Args a_in) {
    extern __shared__ __attribute__((aligned(16))) unsigned char lds_raw[];
    LAS unsigned char* lds = (LAS unsigned char*)lds_raw;
    volatile LAS unsigned* MISC = (volatile LAS unsigned*)(lds + MISC_OFF);
    const int tid = threadIdx.x, lane = tid & 63, wave = __builtin_amdgcn_readfirstlane(tid >> 6);
    const int G = gridDim.x, bx = blockIdx.x;
    const int gw = bx * NWAVES + wave, NGW = G * NWAVES;
    typedef const __attribute__((address_space(4))) Args CArgs;
#define PHASE_ENVB(bi_) CArgs* ap_ = (CArgs*)__builtin_amdgcn_kernarg_segment_ptr(); asm volatile("" : "+s"(ap_)); CArgs& a = *ap_; \
    unsigned char* const ws = a.ws; float* const ssqA = (float*)(ws + WS_SSQA) + (size_t)(bi_) * SEQ * 16; float* const ssqB = (float*)(ws + WS_SSQB) + (size_t)(bi_) * SEQ * 16; \
    bf16* const xb = (bf16*)(ws + WS_XB) + (size_t)(bi_) * SEQ * D; bf16* const xb1 = (bf16*)(ws + WS_XB1) + (size_t)(bi_) * SEQ * D; bf16* const pb = (bf16*)(ws + WS_PB) + (size_t)(bi_) * SEQ * PLE; \
    unsigned char* const R = ws + WS_R + (size_t)(bi_) * R_BATCH; \
    bf16* const qb = (bf16*)(R + R_Q); bf16* const kb = (bf16*)(R + R_K); bf16* const vb = (bf16*)(R + R_V); bf16* const gb = (bf16*)(R + R_G); bf16* const uwb = (bf16*)(R + R_UW); \
    bf16* const kvb = (bf16*)(R + R_KV); bf16* const mix = (bf16*)(R + R_MIX); bf16* const hmid = (bf16*)(R + R_H); bf16* const eb = (bf16*)(R + R_E); float* const utmp = (float*)(ws + WS_R + R_UT); \
    (void)ssqA; (void)ssqB; (void)xb; (void)xb1; (void)pb; (void)qb; (void)kb; (void)vb; (void)gb; (void)uwb; (void)kvb; (void)mix; (void)hmid; (void)eb; (void)utmp
#define PHASE_ENV() PHASE_ENVB(batch)
    gu32* ctl = (gu32*)(a_in.ws + WS_CTL);
    for (int u = tid; u < (LDS_BYTES - LDSCTL_OFF) / 4; u += NWAVES * 64) ((LAS unsigned*)(lds + LDSCTL_OFF))[u] = 0u;
    __syncthreads();
    XcdBarrier bar = xcd_barrier_post((unsigned*)(ctl + CW_BAR), MISC + 8);

#ifndef PHMASK
#define PHMASK 0xFFFF
#endif
#define PH(n) ((PHMASK >> (n)) & 1)
#define FRESH_TID(name) int name = threadIdx.x; asm volatile("" : "+v"(name))
    if (PH(0)) { PHASE_ENVB(0);
    for (int task = gw; task < DEPTH * 4 * 2 * 128; task += NGW) {
        const int kb8 = task & 127, dh = (task >> 7) & 1, g = (task >> 8) & 3, L = task >> 10;
        const int d = dh * 64 + lane;
        const float* pw = a.pool_w + (size_t)((L * 4 + g) * 128) * 128 + d;
        const float* wi = a.w_in + (size_t)(L * 1024 + kb8 * 8) * INW + 2048 + g * 128;
        float acc[8];
#pragma unroll
        for (int i = 0; i < 8; ++i) acc[i] = 0.f;
#pragma unroll 4
        for (int c = 0; c < 128; ++c) { const float bv = pw[(size_t)c * 128];
#pragma unroll
            for (int i = 0; i < 8; ++i) acc[i] += wi[(size_t)i * INW + c] * bv; }
        const float sc = a.pool_scale[L * 512 + g * 128 + d];
#pragma unroll
        for (int i = 0; i < 8; ++i) utmp[(size_t)(L * 1024 + kb8 * 8 + i) * 512 + g * 128 + d] = acc[i] * sc;
    }
    }
    xcd_barrier(bar);
#ifndef FORCE_FALLBACK
#define FORCE_FALLBACK 0
#endif
    if (threadIdx.x == 0) {
        unsigned* barw = (unsigned*)(ctl + CW_BAR);
        const unsigned nloc_ = MISC[8], nx_ = MISC[9], rk_ = MISC[10], myx_ = xb_xcc_id();
        unsigned mode_ = 0u, batch_ = 0u, rank_ = 0u, gsz_ = 1u;
        if (nx_ == 8u && !FORCE_FALLBACK) { mode_ = 1u; for (unsigned j = 0; j < 16; ++j) if (j < myx_ && xb_ld(&barw[XB_XCNT(j)]) > 0u) ++batch_; rank_ = rk_; gsz_ = nloc_; }
        else { const unsigned t_ = xb_add(&barw[XB_TICKET], 1u); batch_ = t_ % 8u; rank_ = t_ / 8u; gsz_ = (unsigned)G / 8u + ((batch_ < (unsigned)G % 8u) ? 1u : 0u); }
        MISC[11] = mode_; MISC[12] = batch_; MISC[13] = rank_; MISC[14] = gsz_;
    }
    __syncthreads();
    const int lmode = __builtin_amdgcn_readfirstlane((int)MISC[11]), batch = __builtin_amdgcn_readfirstlane((int)MISC[12]), rank = __builtin_amdgcn_readfirstlane((int)MISC[13]), gsz = __builtin_amdgcn_readfirstlane((int)MISC[14]);
#define LBAR() do { if (lmode) xcd_local_barrier(bar); else xcd_barrier(bar); } while (0)

    if (PH(1)) { PHASE_ENVB(0);
        LAS float* scr = (LAS float*)(lds + wave * 16384);
        constexpr int I_IN = 16 * 80, I_OUT = 16 * 32, I_GU = 16 * 176, I_DN = 44 * 32, I_PG = 16 * 32, I_PP = 4 * 32, I_L = I_IN + I_OUT + I_GU + I_DN + I_PG + I_PP;
        for (int it = gw; it < DEPTH * I_L; it += NGW) {
            const int L = it / I_L; int r = it % I_L;
            unsigned char* wl = ws + WS_W + (size_t)L * W_LAYER;
            if (r < I_IN) { const int kbk = r / 80, nb = r % 80, n0 = 32 * nb, k0 = 64 * kbk; const float* gn = a.g_mix + L * 1024;
                if (n0 < 1024) { const int sec = n0 >> 9, w = n0 & 511, t = w >> 8, bj = (w >> 7) & 1, hh = (w >> 6) & 1, dd0 = w & 63;
                    tr_item(a.w_in + (size_t)L * 1024 * INW, INW, sec * 512 + (2 * t + hh) * 128 + bj * 64 + dd0, k0, gn, sec == 0 ? 0.08838834764831845f : 1.0f, (bf16*)(wl + WO_IN), 1024, n0, scr, lane); }
                else if (n0 < 2048) tr_item(a.w_in + (size_t)L * 1024 * INW, INW, n0, k0, gn, 1.0f, (bf16*)(wl + WO_IN), 1024, n0, scr, lane);
                else tr_item(utmp + (size_t)L * 1024 * 512, 512, n0 - 2048, k0, gn, 1.0f, (bf16*)(wl + WO_IN), 1024, n0, scr, lane);
                continue; } r -= I_IN;
            if (r < I_OUT) { const int kbk = r / 32, nb = r % 32; tr_item(a.w_out + (size_t)L * 1024 * 1024, 1024, 32 * nb, 64 * kbk, nullptr, 1.0f, (bf16*)(wl + WO_OUT), 1024, 32 * nb, scr, lane); continue; } r -= I_OUT;
            if (r < I_GU) { const int kbk = r / 176, nb = r % 176, n0 = 32 * nb, t = n0 >> 8, bj = (n0 >> 7) & 1, j0 = n0 & 127;
                tr_item((bj ? a.w_up : a.w_gate) + (size_t)L * 1024 * FF, FF, 128 * t + j0, 64 * kbk, a.g_ffn + L * 1024, 1.0f, (bf16*)(wl + WO_GU), 1024, n0, scr, lane); continue; } r -= I_GU;
            if (r < I_DN) { const int kbk = r / 32, nb = r % 32; tr_item(a.w_down + (size_t)L * FF * 1024, 1024, 32 * nb, 64 * kbk, nullptr, 1.0f, (bf16*)(wl + WO_DOWN), FF, 32 * nb, scr, lane); continue; } r -= I_DN;
            if (r < I_PG) { const int kbk = r / 32, nb = r % 32; tr_item(a.w_ple_gate + (size_t)L * 1024 * 1024, 1024, 32 * nb, 64 * kbk, a.g_ple + L * 1024, 1.0f, (bf16*)(wl + WO_PG), 1024, 32 * nb, scr, lane); continue; } r -= I_PG;
            { const int kbk = r / 32, nb = r % 32; tr_item(a.w_ple_proj + (size_t)L * PLE * 1024, 1024, 32 * nb, 64 * kbk, nullptr, 1.0f, (bf16*)(wl + WO_PP), PLE, 32 * nb, scr, lane); }
        }
        for (int m = 2 * gw; m < M; m += 2 * NGW) {
            const GAS f32x4* xr = (const GAS f32x4*)(a.x + (size_t)m * D) + lane; GAS v2u* o8 = (GAS v2u*)(xb1 + (size_t)m * D) + lane;
            f32x4 v[8];
#pragma unroll
            for (int j = 0; j < 8; ++j) v[j] = __builtin_nontemporal_load(xr + 64 * j);
            float ss0 = 0.f, ss1 = 0.f;
#pragma unroll
            for (int j = 0; j < 4; ++j) { ss0 += (v[j][0] * v[j][0] + v[j][1] * v[j][1]) + (v[j][2] * v[j][2] + v[j][3] * v[j][3]); o8[64 * j] = (v2u){pk2(v[j][0], v[j][1]), pk2(v[j][2], v[j][3])}; }
#pragma unroll
            for (int j = 4; j < 8; ++j) { ss1 += (v[j][0] * v[j][0] + v[j][1] * v[j][1]) + (v[j][2] * v[j][2] + v[j][3] * v[j][3]); o8[64 * j] = (v2u){pk2(v[j][0], v[j][1]), pk2(v[j][2], v[j][3])}; }
            ss0 = wave_sum(ss0); ss1 = wave_sum(ss1);
            if (lane < 32) ssqB[(size_t)m * 16 + lane] = (lane == 0) ? ss0 : (lane == 16) ? ss1 : 0.f;
        }
        for (size_t i = (size_t)bx * 512 + tid; i < (size_t)M * PLE / 8; i += (size_t)G * 512) {
            const f32x4 v0 = ((const GAS f32x4*)a.p)[2 * i], v1 = ((const GAS f32x4*)a.p)[2 * i + 1];
            ((GAS v4u*)pb)[i] = (v4u){pk2(v0[0], v0[1]), pk2(v0[2], v0[3]), pk2(v1[0], v1[1]), pk2(v1[2], v1[3])};
        }
    }
    xcd_barrier(bar);

    for (int L = 0; L < DEPTH; ++L) {

#ifndef REP_P1
#define REP_P1 1
#endif
#pragma unroll 1
        for (int rep_ = 0; rep_ < REP_P1; ++rep_) {
        if (PH(2)) {
            PHASE_ENV(); const unsigned char* wl = ws + WS_W + (size_t)L * W_LAYER; (void)wl; FRESH_TID(ptid); pg8::Gemm g{xb1, (const bf16*)(wl + WO_IN), SEQ, INW, D}; pg8::BatchOrder S; S.init(INW, gsz, rank);
            PG8_LAS float* side = (PG8_LAS float*)(lds + SIDE_OFF); const int npu = (S.nwg + gsz - 1) / gsz;     PG8_LAS float* posf = side + npu * 256; PG8_LAS float* rope = posf + npu * 256;
            pg8::fill_rstd(S, ssqB, side, a.pos + batch * SEQ, posf, ptid); if (ptid < 64) { rope[ptid] = ROPE_HI[ptid]; rope[64 + ptid] = ROPE_LO[ptid]; } __syncthreads();
            pg8::EpiInProj E{side, posf, rope, qb, kb, vb, gb, uwb};
            pg8::gemm_phase<pg8::EpiInProj, pg8::BatchOrder, true, true>(lds, g, S, E, ptid);
        }
        LBAR();


        }
#ifndef REP_RET
#define REP_RET 1
#endif
#pragma unroll 1
        for (int rep_ = 0; rep_ < REP_RET; ++rep_) {
        if (PH(3)) { PHASE_ENV();
            FRESH_TID(t_); const int tid = t_, lane = t_ & 63, wave = __builtin_amdgcn_readfirstlane(t_ >> 6); (void)tid; (void)lane; (void)wave;
            for (int u = rank; u < NH * NCH; u += gsz) {
                const bf16* kt = kb + (size_t)u * 16384; const bf16* vt = vb + (size_t)u * 16384;
                v4u ra[4], rb[4];
#pragma unroll
                for (int i = 0; i < 4; ++i) { const int c = tid + 512 * i; ra[i] = ((const GAS v4u*)kt)[c]; rb[i] = ((const GAS v4u*)vt)[c]; }
#pragma unroll
                for (int i = 0; i < 4; ++i) { const unsigned c = tid + 512 * i, o = off_b(c >> 4, c & 15); *(LAS v4u*)(lds + o) = ra[i]; *(LAS v4u*)(lds + 32768 + o) = rb[i]; }
                __syncthreads();
                const int dt = wave >> 1, et0 = (wave & 1) * 2;
                f32x16 acc0, acc1;
#pragma unroll
                for (int r = 0; r < 16; ++r) { acc0[r] = 0.f; acc1[r] = 0.f; }
#pragma unroll
                for (int ks = 0; ks < 8; ++ks) {
                    const bf16x8 A = cat4(tr_read(lds + tr_addr_nat(lane, dt, ks, 0)), tr_read(lds + tr_addr_nat(lane, dt, ks, 1)));
                    const bf16x8 B0 = cat4(tr_read(lds + 32768 + tr_addr_nat(lane, et0, ks, 0)), tr_read(lds + 32768 + tr_addr_nat(lane, et0, ks, 1)));
                    const bf16x8 B1 = cat4(tr_read(lds + 32768 + tr_addr_nat(lane, et0 + 1, ks, 0)), tr_read(lds + 32768 + tr_addr_nat(lane, et0 + 1, ks, 1)));
                    acc0 = __builtin_amdgcn_mfma_f32_32x32x16_bf16(A, B0, acc0, 0, 0, 0);
                    acc1 = __builtin_amdgcn_mfma_f32_32x32x16_bf16(A, B1, acc1, 0, 0, 0);
                }
                bf16* kvt = kvb + (size_t)u * 16384;
#pragma unroll
                for (int s = 0; s < 2; ++s) {
                    *(GAS bf16x8*)(kvt + ((dt * 4 + et0) * 2 + s) * 512 + lane * 8) = pack_acc(acc0, s);
                    *(GAS bf16x8*)(kvt + ((dt * 4 + et0 + 1) * 2 + s) * 512 + lane * 8) = pack_acc(acc1, s);
                }
                __syncthreads();
            }
            for (int it = rank; it < NCH; it += gsz) {
                const int b = it >> 5, n = it & 31, gi = wave & 3, half = wave >> 2;
#pragma unroll 1
                for (int ps = 0; ps < 2; ++ps) {
                    const int s0 = n * 128 + half * 64 + ps * 32 + (lane >> 5) * 16, c0 = gi * 128 + (lane & 31) * 4;
                    if (gi == 0) pool_rows<2>(uwb, mix, b, s0, c0); else if (gi == 1) pool_rows<4>(uwb, mix, b, s0, c0); else if (gi == 2) pool_rows<8>(uwb, mix, b, s0, c0); else pool_rows<16>(uwb, mix, b, s0, c0);
                }
            }
            if (L > 0) {
                const GAS f32x4* ps = (const GAS f32x4*)(a.p + ((size_t)L * M + (size_t)batch * SEQ) * PLE);
                for (size_t i = (size_t)rank * 512 + tid; i < (size_t)SEQ * PLE / 8; i += (size_t)gsz * 512) {
                    const f32x4 v0 = ps[2 * i], v1 = ps[2 * i + 1];
                    ((GAS v4u*)pb)[i] = (v4u){pk2(v0[0], v0[1]), pk2(v0[2], v0[3]), pk2(v1[0], v1[1]), pk2(v1[2], v1[3])};
                }
            }
        }
        LBAR();


        if (PH(4)) { PHASE_ENV(); FRESH_TID(t_); const int tid = t_, lane = t_ & 63, wave = __builtin_amdgcn_readfirstlane(t_ >> 6); (void)tid; (void)lane; (void)wave;
        for (int c = rank * 512 + tid; c < NH * 4096; c += gsz * 512) {
            const int bh = c >> 12; const float cd = __builtin_amdgcn_exp2f(128.0f * lg2gamma(bh & 3));
            GAS v2u* base = (GAS v2u*)(kvb + (size_t)bh * NCH * 16384) + (c & 4095);
            v2u t[NCH];
#pragma unroll
            for (int n = 0; n < NCH; ++n) t[n] = base[(size_t)n * 4096];
            float r0 = 0.f, r1 = 0.f, r2 = 0.f, r3 = 0.f;
#pragma unroll
            for (int n = 0; n < NCH; ++n) {
                const v2u in = t[n];
                base[(size_t)n * 4096] = (v2u){pk2(r0, r1), pk2(r2, r3)};
                r0 = cd * (r0 + bf_lo(in[0])); r1 = cd * (r1 + bf_hi(in[0])); r2 = cd * (r2 + bf_lo(in[1])); r3 = cd * (r3 + bf_hi(in[1]));
            }
        }
        }
        LBAR();

        if (PH(5)) { PHASE_ENV(); FRESH_TID(t_); const int tid = t_, lane = t_ & 63, wave = __builtin_amdgcn_readfirstlane(t_ >> 6);
        LAS float* red = (LAS float*)(lds + SIDE_OFF);
        for (int u = rank; u < NH * NCH; u += gsz) {
            const int bh = u >> 5, n = u & 31, h = bh & 3, b = bh >> 2;
            const int qt = wave & 3, eh = wave >> 2, ql = lane & 31, hh = lane >> 5;
            const size_t tile = ((size_t)bh * SEQ + n * 128) * 128;
            {
                v4u rg[16];
#pragma unroll
                for (int ti = 0; ti < 4; ++ti) { const bf16* src = (ti == 0 ? kb : ti == 1 ? vb : ti == 2 ? qb : gb) + tile;
#pragma unroll
                    for (int i = 0; i < 4; ++i) rg[ti * 4 + i] = ((const GAS v4u*)src)[tid + 512 * i]; }
#pragma unroll
                for (int ti = 0; ti < 4; ++ti)
#pragma unroll
                    for (int i = 0; i < 4; ++i) { const unsigned c = tid + 512 * i; *(LAS v4u*)(lds + ti * 32768 + off_b(c >> 4, c & 15)) = rg[ti * 4 + i]; }
            }
            const bf16* stt = kvb + (size_t)u * 16384;
            bf16x8 sf[2][4][2];
#pragma unroll
            for (int ei = 0; ei < 2; ++ei)
#pragma unroll
                for (int dt = 0; dt < 4; ++dt)
#pragma unroll
                    for (int s = 0; s < 2; ++s) sf[ei][dt][s] = *(const GAS bf16x8*)(stt + ((dt * 4 + 2 * eh + ei) * 2 + s) * 512 + lane * 8);
            __syncthreads();
            LAS unsigned char* kzl = lds; LAS unsigned char* vl = lds + 32768; LAS unsigned char* qlds = lds + 65536; LAS unsigned char* glds = lds + 98304;
            bf16x8 qf[4][2];
            { const unsigned qrow = 32u * qt + (unsigned)ql;
#pragma unroll
              for (int dt = 0; dt < 4; ++dt)
#pragma unroll
                for (int s = 0; s < 2; ++s) { const v2u lo = *(const LAS v2u*)(qlds + off_b(qrow, 4 * dt + 2 * s) + 8 * hh), hi = *(const LAS v2u*)(qlds + off_b(qrow, 4 * dt + 2 * s + 1) + 8 * hh);
                    qf[dt][s] = __builtin_bit_cast(bf16x8, (v4u){lo[0], lo[1], hi[0], hi[1]}); } }
            bf16x8 pf[4][2];
#pragma unroll
            for (int kt = 0; kt < 4; ++kt) {
                if (kt <= qt) {
                    f32x16 sa;
#pragma unroll
                    for (int r = 0; r < 16; ++r) sa[r] = 0.f;
                    const unsigned krow = 32 * kt + ql;
#pragma unroll
                    for (int dt = 0; dt < 4; ++dt)
#pragma unroll
                        for (int s = 0; s < 2; ++s) {
                            const v2u lo = *(const LAS v2u*)(kzl + off_b(krow, 4 * dt + 2 * s) + 8 * hh), hi = *(const LAS v2u*)(kzl + off_b(krow, 4 * dt + 2 * s + 1) + 8 * hh);
                            sa = __builtin_amdgcn_mfma_f32_32x32x16_bf16(__builtin_bit_cast(bf16x8, (v4u){lo[0], lo[1], hi[0], hi[1]}), qf[dt][s], sa, 0, 0, 0); }
                    if (kt == qt) {
#pragma unroll
                        for (int r = 0; r < 16; ++r) sa[r] = (crow(r, hh) > ql) ? 0.f : sa[r];
                    }
                    pf[kt][0] = pack_acc(sa, 0); pf[kt][1] = pack_acc(sa, 1);
                } else { pf[kt][0] = (bf16x8){0, 0, 0, 0, 0, 0, 0, 0}; pf[kt][1] = (bf16x8){0, 0, 0, 0, 0, 0, 0, 0}; }
            }
            f32x16 oacc[2];
#pragma unroll
            for (int ei = 0; ei < 2; ++ei) {
                const int et = 2 * eh + ei; f32x16 o;
#pragma unroll
                for (int r = 0; r < 16; ++r) o[r] = 0.f;
#pragma unroll
                for (int kt = 0; kt < 4; ++kt) {
                    if (kt <= qt) {
#pragma unroll
                        for (int s = 0; s < 2; ++s) {
                            const bf16x8 vf = cat4(tr_read(vl + tr_addr_perm(lane, et, 2 * kt + s, 0)), tr_read(vl + tr_addr_perm(lane, et, 2 * kt + s, 1)));
                            o = __builtin_amdgcn_mfma_f32_32x32x16_bf16(vf, pf[kt][s], o, 0, 0, 0); }
                    }
                }
#pragma unroll
                for (int dt = 0; dt < 4; ++dt)
#pragma unroll
                    for (int s = 0; s < 2; ++s) o = __builtin_amdgcn_mfma_f32_32x32x16_bf16(sf[ei][dt][s], qf[dt][s], o, 0, 0, 0);
                oacc[ei] = o;
            }
            const float rsc = __builtin_amdgcn_exp2f((float)(32 * qt + ql - 127) * lg2gamma(h));
            float ss = 0.f;
#pragma unroll
            for (int ei = 0; ei < 2; ++ei)
#pragma unroll
                for (int r = 0; r < 16; ++r) { const float y = oacc[ei][r] * rsc; oacc[ei][r] = y; ss += y * y; }
            ss = add_xor32(ss);
            if (hh == 0) red[eh * 128 + 32 * qt + ql] = ss;
            __syncthreads();
            const float rn = rsqrtf((red[32 * qt + ql] + red[128 + 32 * qt + ql]) * (1.0f / 128.0f) + EPS);
            { const unsigned yrow = 32u * qt + (unsigned)ql;
#pragma unroll
              for (int ei = 0; ei < 2; ++ei)
#pragma unroll
                for (int rg = 0; rg < 4; ++rg) {
                    const unsigned e0 = 32u * (2 * eh + ei) + 8u * rg + 4u * hh, ch = e0 >> 3, sub = (e0 & 7u) * 2u;
                    const v2u gv = *(const LAS v2u*)(glds + off_b(yrow, ch) + sub);
                    float o[4];
#pragma unroll
                    for (int j = 0; j < 4; ++j) { const float gt = (j & 1) ? bf_hi(gv[j >> 1]) : bf_lo(gv[j >> 1]);
                        o[j] = gt * __builtin_amdgcn_rcpf(1.0f + __builtin_amdgcn_exp2f(-1.4426950408889634f * gt)) * (oacc[ei][4 * rg + j] * rn); }
                    *(LAS v2u*)(qlds + off_b(yrow, ch) + sub) = (v2u){pk2(o[0], o[1]), pk2(o[2], o[3])};
                } }
            __syncthreads();
            { bf16* orow = mix + ((size_t)b * SEQ + n * 128) * 1024 + h * 128;
#pragma unroll
              for (int i = 0; i < 4; ++i) { const unsigned c = tid + 512 * i, row = c >> 4, ch = c & 15; *(GAS v4u*)(orow + (size_t)row * 1024 + ch * 8) = *(const LAS v4u*)(qlds + off_b(row, ch)); } }
            __syncthreads();
        }
        }
        LBAR();

        }
        if (PH(6)) {
            PHASE_ENV(); const unsigned char* wl = ws + WS_W + (size_t)L * W_LAYER; (void)wl; FRESH_TID(ptid); pg8::Gemm g{mix, (const bf16*)(wl + WO_OUT), SEQ, D, D}; pg8::BatchOrder S; S.init(D, gsz, rank);
            pg8::EpiResid E{xb1, xb, ssqA};
            pg8::gemm_phase<pg8::EpiResid, pg8::BatchOrder, true, true>(lds, g, S, E, ptid);
        }
        LBAR();


#ifndef REP_P6
#define REP_P6 1
#endif
#pragma unroll 1
        for (int rep_ = 0; rep_ < REP_P6; ++rep_) {
        if (PH(7)) {
            PHASE_ENV(); const unsigned char* wl = ws + WS_W + (size_t)L * W_LAYER; (void)wl; FRESH_TID(ptid); pg8::Gemm g{xb, (const bf16*)(wl + WO_GU), SEQ, 2 * FF, D}; pg8::BatchOrder S; S.init(2 * FF, gsz, rank);
            PG8_LAS float* side = (PG8_LAS float*)(lds + SIDE_OFF); pg8::fill_rstd(S, ssqA, side, (const int*)nullptr, (PG8_LAS float*)nullptr, ptid); __syncthreads();
            pg8::EpiSwiGLU E{side, hmid};
            pg8::gemm_phase<pg8::EpiSwiGLU, pg8::BatchOrder, true, true>(lds, g, S, E, ptid);
        }
        LBAR();

        }
        if (PH(8)) {
            PHASE_ENV(); const unsigned char* wl = ws + WS_W + (size_t)L * W_LAYER; (void)wl; FRESH_TID(ptid); pg8::Gemm g{hmid, (const bf16*)(wl + WO_DOWN), SEQ, D, FF}; pg8::BatchOrder S; S.init(D, gsz, rank);
            pg8::EpiResid E{xb, xb, ssqA};
            pg8::gemm_phase<pg8::EpiResid, pg8::BatchOrder, true, true>(lds, g, S, E, ptid);
        }
#ifndef REP_PE
#define REP_PE 1
#endif
#pragma unroll 1
        for (int rep_ = 0; rep_ < REP_PE; ++rep_)
        if (PH(9)) {
            PHASE_ENV(); const unsigned char* wl = ws + WS_W + (size_t)L * W_LAYER; (void)wl; FRESH_TID(ptid); pg8::Gemm g{pb, (const bf16*)(wl + WO_PP), SEQ, D, PLE}; pg8::BatchOrder S; S.init(D, gsz, rank);
            pg8::EpiPlain E{eb, D};
            pg8::gemm_phase<pg8::EpiPlain, pg8::BatchOrder, true, true>(lds, g, S, E, ptid);
        }
        LBAR();

        if (PH(10)) {
            PHASE_ENV(); const unsigned char* wl = ws + WS_W + (size_t)L * W_LAYER; (void)wl; FRESH_TID(ptid); pg8::Gemm g{xb, (const bf16*)(wl + WO_PG), SEQ, D, D}; pg8::BatchOrder S; S.init(D, gsz, rank);
            PG8_LAS float* side = (PG8_LAS float*)(lds + SIDE_OFF); pg8::fill_rstd(S, ssqA, side, (const int*)nullptr, (PG8_LAS float*)nullptr, ptid); __syncthreads();
            pg8::EpiPle E{side, eb, xb, xb1, ssqB};
            pg8::gemm_phase<pg8::EpiPle, pg8::BatchOrder, true, true>(lds, g, S, E, ptid);
        }
        LBAR();
    }

    if (PH(11)) { PHASE_ENV(); FRESH_TID(t_); const int lane = t_ & 63, gw = rank * NWAVES + __builtin_amdgcn_readfirstlane(t_ >> 6);
        const unsigned tmo = __hip_atomic_load((unsigned*)(ws + WS_CTL) + CW_BAR + XB_TMO, RLX_AGENT);
        for (int m = gw; m < SEQ; m += gsz * NWAVES) {
            float s = (lane < 16) ? ssqB[(size_t)m * 16 + lane] : 0.f; s = wave_sum(s);
            float rs = rsqrtf(s * (1.0f / 1024.0f) + EPS); if (tmo) rs = __builtin_nanf("");
#pragma unroll
            for (int j = 0; j < 2; ++j) { const v4u w = ((const GAS v4u*)(xb1 + (size_t)m * D))[lane + 64 * j]; const GAS f32x4* gp = (const GAS f32x4*)(a.g_final + (lane + 64 * j) * 8);
                f32x4 v0, v1; pg8::unpack8(w, v0, v1); GAS f32x4* op = (GAS f32x4*)(a.out + ((size_t)batch * SEQ + m) * D + (lane + 64 * j) * 8);
                op[0] = v0 * rs * gp[0]; op[1] = v1 * rs * gp[1]; }
        }
    }
}

extern "C" void kernel_launch(void* const* d_in, const int* in_sizes, int n_in, void* d_out, int out_size, void* d_ws, size_t ws_size, hipStream_t stream) {
    static int grid = 0;
    if (grid == 0) {
        if (n_in != 16 || in_sizes[0] != M * D || out_size != M * D || ws_size < WS_END) { fprintf(stderr, "kernel_launch: unexpected shapes (n_in %d, in0 %d, out %d, ws %zu < %zu)\n", n_in, n_in > 0 ? in_sizes[0] : -1, out_size, ws_size, (size_t)WS_END); grid = -1; return; }
        int dev = 0, cus = 0, per_cu = 0;
        if (hipGetDevice(&dev) != hipSuccess || hipDeviceGetAttribute(&cus, hipDeviceAttributeMultiprocessorCount, dev) != hipSuccess) { grid = -1; return; }
        if (hipFuncSetAttribute((const void*)fwd, hipFuncAttributeMaxDynamicSharedMemorySize, LDS_BYTES) != hipSuccess) { fprintf(stderr, "kernel_launch: hipFuncSetAttribute failed\n"); grid = -1; return; }
        if (hipOccupancyMaxActiveBlocksPerMultiprocessor(&per_cu, (const void*)fwd, NWAVES * 64, LDS_BYTES) != hipSuccess || per_cu < 1) fprintf(stderr, "kernel_launch: occupancy query reports %d\n", per_cu);
        (void)hipGetLastError();
        grid = cus;
    }
    if (grid < 0) return;
    if (hipMemsetAsync((char*)d_ws + WS_CTL, 0, CTL_ZERO_BYTES, stream) != hipSuccess) return;
    Args a{};
    a.x = (const float*)d_in[0]; a.p = (const float*)d_in[1]; a.pos = (const int*)d_in[2]; a.g_mix = (const float*)d_in[3]; a.w_in = (const float*)d_in[4]; a.pool_w = (const float*)d_in[5];
    a.pool_scale = (const float*)d_in[6]; a.w_out = (const float*)d_in[7]; a.g_ffn = (const float*)d_in[8]; a.w_gate = (const float*)d_in[9]; a.w_up = (const float*)d_in[10]; a.w_down = (const float*)d_in[11];
    a.g_ple = (const float*)d_in[12]; a.w_ple_gate = (const float*)d_in[13]; a.w_ple_proj = (const float*)d_in[14]; a.g_final = (const float*)d_in[15]; a.out = (float*)d_out; a.ws = (unsigned char*)d_ws;
    hipLaunchKernelGGL(fwd, dim3(grid), dim3(NWAVES * 64), LDS_BYTES, stream, a);
}
```

```cpp
#include <hip/hip_runtime.h>
#include <cstdio>
#include <cstdint>
namespace pg8 {
#define PG8_LAS __attribute__((address_space(3)))
typedef unsigned short bf16_t;
typedef short bf16x8 __attribute__((ext_vector_type(8)));
typedef float f32x4 __attribute__((ext_vector_type(4)));
typedef unsigned u32x4 __attribute__((ext_vector_type(4)));
constexpr int BM = 256, BK = 64, HALF = 128, HTB = HALF * BK * 2  , STAGE_BYTES = 8 * HTB, NXCD = 8, WGM = 8;

__host__ __device__ __forceinline__ int lds_byte(int r, int c) { const int st = (r >> 4) * 2 + (c >> 5), rr = r & 15, cc = c & 31, ob = rr * 64 + cc * 2; return st * 1024 + (ob ^ (((ob >> 9) & 1) << 5)); }
__host__ __device__ __forceinline__ void stage_rc(int b, int& R, int& C) { const int st = b / 1024, sb = b % 1024, swz = sb ^ (((sb >> 9) & 1) << 5); R = (st >> 1) * 16 + swz / 64; C = (st & 1) * 32 + (swz % 64) / 2; }
__host__ __device__ __forceinline__ int perm32(int rho) { const int n = rho >> 4, i = rho & 15; return 8 * (i >> 2) + 4 * n + (i & 3); }

struct Unit { int pm, pn; };
struct Gemm { const bf16_t* A; const bf16_t* Bt; int M, N, K; };

struct StaticOrder {
    int nM, nN, nwg, G, c;
    __host__ __device__ void init(int M, int N, int G_, int c_) { nM = M / BM; nN = N / BM; nwg = nM * nN; G = G_; c = c_; }
    __host__ __device__ bool next(int i, Unit& u) const {
        const long L = (long)i * G + c; if (L >= nwg) return false;
        int wgid = (int)L; { const int q = nwg / NXCD, r = nwg % NXCD, xcd = wgid % NXCD, off = wgid / NXCD; wgid = (xcd < r ? xcd * (q + 1) : r * (q + 1) + (xcd - r) * q) + off; }
        const int nig = WGM * nN, gid = wgid / nig, fm = gid * WGM, gsz = (nM - fm) < WGM ? (nM - fm) : WGM;
        u.pm = fm + ((wgid % nig) % gsz); u.pn = (wgid % nig) / gsz; return true;
    }
    __device__ __forceinline__ void a_ready(const Unit&) const {}
    __device__ __forceinline__ void done(const Unit&) const {}
};

typedef float f32x2_t __attribute__((ext_vector_type(2))); typedef __bf16 bf16x2_t __attribute__((ext_vector_type(2)));
__device__ __forceinline__ unsigned cvt_pk_bf16(float lo, float hi) { f32x2_t v = {lo, hi}; bf16x2_t b = __builtin_convertvector(v, bf16x2_t); return __builtin_bit_cast(unsigned, b); }
template <class Epi, class Sched, bool ALIGN_EPI = false, bool SP2 = false>
__device__ __forceinline__ void gemm_phase(PG8_LAS unsigned char* lds, const Gemm g, const Sched& S, const Epi& E, const int tid_in) {
    const int tid = tid_in, wid = __builtin_amdgcn_readfirstlane(tid >> 6), lane = tid & 63, wr = wid >> 2, wc = wid & 3, fr = lane & 15, fq = lane >> 4;
    const int K = g.K, nt = K / BK;
    unsigned voffA[2], voffB[2];
#pragma unroll
    for (int i = 0; i < 2; ++i) { int R, C; stage_rc(tid * 16 + i * 8192, R, C); const int Rb = Epi::PERM ? ((R & ~31) + perm32(R & 31)) : R;
        voffA[i] = (unsigned)(R * K + C) * 2u; voffB[i] = (unsigned)(Rb * K + C) * 2u; }
    const size_t kstep = (size_t)(BK * 2);
    const size_t hstep = (size_t)HALF * K * 2;
    const size_t tstep = 2 * hstep;
    const unsigned ldsw = (unsigned)wid * 1024u;
    const int aoff = lds_byte(wr * 64 + fr, fq * 8), boff = lds_byte(wc * 32 + fr, fq * 8);
#define PG8_SA(b, h) (((b) * 2 + (h)) * HTB)
#define PG8_SB(b, h) ((4 + (b) * 2 + (h)) * HTB)
#define PG8_STAGE(bufoff, gbase, voff) do { _Pragma("unroll") for (int _i = 0; _i < 2; ++_i) \
        __builtin_amdgcn_global_load_lds((const unsigned*)((const char*)(gbase) + (voff)[_i]), (PG8_LAS unsigned*)(lds + (bufoff) + ldsw + _i * 8192), 16, 0, 0); } while (0)
#define PG8_LDA(dst, b, h) do { _Pragma("unroll") for (int m = 0; m < 4; ++m) _Pragma("unroll") for (int k = 0; k < 2; ++k) dst[m][k] = *(const PG8_LAS bf16x8*)(lds + PG8_SA(b, h) + aoff + m * 2048 + k * 1024); } while (0)
#define PG8_LDB(dst, b, h) do { _Pragma("unroll") for (int n = 0; n < 2; ++n) _Pragma("unroll") for (int k = 0; k < 2; ++k) dst[n][k] = *(const PG8_LAS bf16x8*)(lds + PG8_SB(b, h) + boff + n * 2048 + k * 1024); } while (0)
#define PG8_MMA(ai, bj, At, Bt) do { __builtin_amdgcn_s_setprio(1); _Pragma("unroll") for (int m = 0; m < 4; ++m) _Pragma("unroll") for (int n = 0; n < 2; ++n) _Pragma("unroll") for (int k = 0; k < 2; ++k) \
        acc[ai][bj][m][n] = __builtin_amdgcn_mfma_f32_16x16x32_bf16(Bt[n][k], At[m][k], acc[ai][bj][m][n], 0, 0, 0); __builtin_amdgcn_s_setprio(0); } while (0)
#define PG8_WAIT_V(n) asm volatile("s_waitcnt vmcnt(" #n ")" ::: "memory")
#define PG8_WAIT_L(n) asm volatile("s_waitcnt lgkmcnt(" #n ")" ::: "memory")
#define PG8_BAR __builtin_amdgcn_s_barrier()
#define PG8_SCHED __builtin_amdgcn_sched_barrier(0)
    Unit cur, nxt; int ui = 0;
    if (!S.next(0, cur)) return;
    f32x4 acc[2][2][4][2];
    E.init(acc, cur, wr, wc, fr, fq);
    bf16x8 At[4][2], B0[2][2], B1[2][2];
    const char* cA = (const char*)g.A + (size_t)cur.pm * tstep; const char* cB = (const char*)g.Bt + (size_t)cur.pn * tstep;
    S.a_ready(cur);
    if constexpr (SP2) {
        PG8_STAGE(PG8_SB(0, 0), cB, voffB); PG8_STAGE(PG8_SB(0, 1), cB + hstep, voffB); PG8_STAGE(PG8_SA(0, 0), cA, voffA); PG8_STAGE(PG8_SA(0, 1), cA + hstep, voffA);
        if (wr == 1) PG8_BAR;
        PG8_WAIT_V(2); PG8_BAR;
        PG8_STAGE(PG8_SB(1, 0), cB + kstep, voffB); PG8_STAGE(PG8_SA(1, 0), cA + kstep, voffA); PG8_STAGE(PG8_SB(1, 1), cB + hstep + kstep, voffB);
        PG8_WAIT_V(6); PG8_BAR;
    } else {
        PG8_STAGE(PG8_SB(0, 0), cB, voffB); PG8_STAGE(PG8_SA(0, 0), cA, voffA); PG8_STAGE(PG8_SB(0, 1), cB + hstep, voffB); PG8_STAGE(PG8_SA(0, 1), cA + hstep, voffA);
        if (wr == 1) PG8_BAR;
        PG8_WAIT_V(4); PG8_BAR;
        PG8_STAGE(PG8_SB(1, 0), cB + kstep, voffB); PG8_STAGE(PG8_SA(1, 0), cA + kstep, voffA); PG8_STAGE(PG8_SB(1, 1), cB + hstep + kstep, voffB);
        PG8_WAIT_V(6); PG8_BAR;
    }
    for (;;) {
        const bool has_next = S.next(ui + 1, nxt);
        const char* nA = has_next ? (const char*)g.A + (size_t)nxt.pm * tstep : cA; const char* nB = has_next ? (const char*)g.Bt + (size_t)nxt.pn * tstep : cB;
#pragma unroll 1
        for (int t = 0; t < nt; t += 2) {
            const bool last = (t == nt - 2);
            const char* a1 = cA + (size_t)(t + 1) * kstep;
            const char* a2 = last ? nA : cA + (size_t)(t + 2) * kstep; const char* b2 = last ? nB : cB + (size_t)(t + 2) * kstep;
            const char* a3 = a2 + kstep; const char* b3 = b2 + kstep;
            if (last && has_next) S.a_ready(nxt);
            if constexpr (SP2) {
            PG8_LDB(B0, 0, 0); PG8_LDB(B1, 0, 1); PG8_SCHED; PG8_LDA(At, 0, 0); PG8_STAGE(PG8_SA(1, 1), a1 + hstep, voffA);
            PG8_WAIT_V(8); PG8_WAIT_L(0); PG8_BAR; PG8_MMA(0, 0, At, B0); PG8_MMA(0, 1, At, B1); PG8_BAR; PG8_SCHED;
            PG8_LDA(At, 0, 1); PG8_STAGE(PG8_SB(0, 0), b2, voffB); PG8_STAGE(PG8_SB(0, 1), b2 + hstep, voffB); PG8_STAGE(PG8_SA(0, 0), a2, voffA);
            PG8_WAIT_V(8); PG8_WAIT_L(0); PG8_BAR; PG8_MMA(1, 0, At, B0); PG8_MMA(1, 1, At, B1); PG8_BAR; PG8_SCHED;
            PG8_LDB(B0, 1, 0); PG8_LDB(B1, 1, 1); PG8_SCHED; PG8_LDA(At, 1, 0); PG8_STAGE(PG8_SA(0, 1), a2 + hstep, voffA);
            PG8_WAIT_V(8); PG8_WAIT_L(0); PG8_BAR; PG8_MMA(0, 0, At, B0); PG8_MMA(0, 1, At, B1); PG8_BAR; PG8_SCHED;
            PG8_LDA(At, 1, 1); PG8_STAGE(PG8_SB(1, 0), b3, voffB); PG8_STAGE(PG8_SB(1, 1), b3 + hstep, voffB); PG8_STAGE(PG8_SA(1, 0), a3, voffA);
            PG8_WAIT_V(8); PG8_WAIT_L(0); PG8_BAR; PG8_MMA(1, 0, At, B0); PG8_MMA(1, 1, At, B1); PG8_BAR; PG8_SCHED;
            } else {
            PG8_LDB(B0, 0, 0); PG8_SCHED; PG8_LDA(At, 0, 0); PG8_STAGE(PG8_SA(1, 1), a1 + hstep, voffA);
            PG8_WAIT_L(8); PG8_BAR; PG8_WAIT_L(0); PG8_MMA(0, 0, At, B0); PG8_BAR; PG8_SCHED;
            PG8_LDB(B1, 0, 1); PG8_STAGE(PG8_SB(0, 0), b2, voffB);
            PG8_BAR; PG8_WAIT_L(0); PG8_MMA(0, 1, At, B1); PG8_BAR;
            PG8_LDA(At, 0, 1); PG8_STAGE(PG8_SA(0, 0), a2, voffA);
            PG8_BAR; PG8_WAIT_L(0); PG8_MMA(1, 0, At, B0); PG8_BAR; PG8_SCHED;
            PG8_STAGE(PG8_SB(0, 1), b2 + hstep, voffB);
            PG8_WAIT_V(6); PG8_BAR; PG8_MMA(1, 1, At, B1); PG8_BAR;
            PG8_LDB(B0, 1, 0); PG8_SCHED; PG8_LDA(At, 1, 0); PG8_STAGE(PG8_SA(0, 1), a2 + hstep, voffA);
            PG8_WAIT_L(8); PG8_BAR; PG8_WAIT_L(0); PG8_MMA(0, 0, At, B0); PG8_BAR; PG8_SCHED;
            PG8_LDB(B1, 1, 1); PG8_STAGE(PG8_SB(1, 0), b3, voffB);
            PG8_BAR; PG8_WAIT_L(0); PG8_MMA(0, 1, At, B1); PG8_BAR;
            PG8_LDA(At, 1, 1); PG8_STAGE(PG8_SA(1, 0), a3, voffA);
            PG8_BAR; PG8_WAIT_L(0); PG8_MMA(1, 0, At, B0); PG8_BAR; PG8_SCHED;
            PG8_STAGE(PG8_SB(1, 1), b3 + hstep, voffB);
            PG8_WAIT_V(6); PG8_BAR; PG8_MMA(1, 1, At, B1); PG8_BAR;
            }
        }
        if constexpr (ALIGN_EPI) { if (wr == 0) PG8_BAR; }
        if constexpr (!Epi::AFTER_DRAIN) { E(acc, cur, wr, wc, fr, fq, ui); S.done(cur); }
        if (!has_next) break;
        E.init(acc, nxt, wr, wc, fr, fq);
        cur = nxt; cA = nA; cB = nB; ++ui;
        if constexpr (ALIGN_EPI) { if (wr == 1) PG8_BAR; }
    }
    PG8_WAIT_V(0);
    if constexpr (!ALIGN_EPI) { if (wr == 0) PG8_BAR; }
    PG8_BAR;
    if constexpr (Epi::AFTER_DRAIN) { E.fused(acc, cur, wr, wc, fr, fq, lds, wid, lane); S.done(cur); }
#undef PG8_SA
#undef PG8_SB
#undef PG8_STAGE
#undef PG8_LDA
#undef PG8_LDB
#undef PG8_MMA
#undef PG8_WAIT_V
#undef PG8_WAIT_L
#undef PG8_BAR
#undef PG8_SCHED
}
}

constexpr int BATCH = 8, SEQ = 4096, D = 1024, DEPTH = 4, M = BATCH * SEQ;
constexpr int NH = 4, DH = 128, RW = 512, CHUNK = 128, NCH = SEQ / CHUNK;
constexpr int INW = 2560, FF = 2816, PLE = 256;
constexpr float EPS = 1e-6f;
constexpr int NWAVES = 8;

constexpr size_t MiB = 1u << 20;
constexpr size_t WS_CTL = 0, CTL_ZERO_BYTES = 1 * MiB;
constexpr size_t WS_SSQA = 1 * MiB, WS_SSQB = 3 * MiB;
constexpr size_t WS_W = 8 * MiB, W_LAYER = 26 * MiB;
constexpr size_t WO_IN = 0, WO_OUT = 5 * MiB, WO_GU = 7 * MiB, WO_DOWN = 18 * MiB, WO_PG = 18 * MiB + 5632 * 1024, WO_PP = WO_PG + 2 * MiB;
static_assert(WO_PP + 512 * 1024 == W_LAYER, "weight map");
constexpr size_t WS_XB = 112 * MiB;
constexpr size_t WS_PB = 176 * MiB;
constexpr size_t WS_R = 192 * MiB;
constexpr size_t R_BATCH = 32 * MiB;
constexpr size_t R_Q = 0, R_K = 4 * MiB, R_V = 8 * MiB, R_G = 12 * MiB, R_UW = 16 * MiB, R_KV = 20 * MiB, R_MIX = 24 * MiB;
constexpr size_t R_H = 0, R_E = 24 * MiB, R_UT = 0;
constexpr size_t WS_XB1 = WS_R + 256 * MiB;
constexpr size_t WS_END = WS_XB1 + 64 * MiB;
static_assert((size_t)SEQ * FF * 2 <= R_MIX && R_MIX + (size_t)SEQ * D * 2 == R_BATCH, "per-batch scratch map");
constexpr int CW_BAR = 4096;

constexpr int RING_BYTES = 131072;
constexpr int LDSCTL_OFF = RING_BYTES, MISC_OFF = LDSCTL_OFF + 320;
constexpr int SIDE_OFF = LDSCTL_OFF + 1024;
constexpr int LDS_BYTES = 147456;

#define GAS __attribute__((address_space(1)))
#define LAS __attribute__((address_space(3)))
typedef unsigned short bf16;
typedef unsigned v4u __attribute__((ext_vector_type(4)));
typedef unsigned v2u __attribute__((ext_vector_type(2)));
typedef float f32x4 __attribute__((ext_vector_type(4)));
typedef float f32x16 __attribute__((ext_vector_type(16)));
typedef short bf16x8 __attribute__((ext_vector_type(8)));
typedef short s16x4 __attribute__((ext_vector_type(4)));
typedef GAS unsigned gu32;
#define RLX_AGENT __ATOMIC_RELAXED, __HIP_MEMORY_SCOPE_AGENT
#define LDS_WAIT() asm volatile("s_waitcnt lgkmcnt(0)" ::: "memory")
#define VM_WAIT() asm volatile("s_waitcnt vmcnt(0)" ::: "memory")
__device__ __forceinline__ unsigned f2bf(float f) { unsigned u = __builtin_bit_cast(unsigned, f); return (u + 0x7fffu + ((u >> 16) & 1u)) >> 16; }
__device__ __forceinline__ unsigned pk2(float lo, float hi) { return f2bf(lo) | (f2bf(hi) << 16); }
__device__ __forceinline__ float bf_lo(unsigned w) { return __builtin_bit_cast(float, w << 16); }
__device__ __forceinline__ float bf_hi(unsigned w) { return __builtin_bit_cast(float, w & 0xffff0000u); }

__device__ const float ROPE_HI[64] = {1.591186523e-01f, 1.378173828e-01f, 1.193237305e-01f, 1.033325195e-01f, 8.947753906e-02f, 7.748413086e-02f, 6.710815430e-02f, 5.810546875e-02f, 5.032348633e-02f, 4.357910156e-02f, 3.773498535e-02f, 3.266906738e-02f, 2.829742432e-02f, 2.450561523e-02f, 2.121734619e-02f, 1.837158203e-02f, 1.591491699e-02f, 1.377868652e-02f, 1.193237305e-02f, 1.033401489e-02f, 8.949279785e-03f, 7.749557495e-03f, 6.710052490e-03f, 5.811691284e-03f, 5.031585693e-03f, 4.358291626e-03f, 3.773689270e-03f, 3.268241882e-03f, 2.829551697e-03f, 2.449989319e-03f, 2.121925354e-03f, 1.837730408e-03f, 1.591205597e-03f, 1.378059387e-03f, 1.193046570e-03f, 1.033306122e-03f, 8.947849274e-04f, 7.748603821e-04f, 6.711483002e-04f, 5.810260773e-04f, 5.030632019e-04f, 4.358291626e-04f, 3.772974014e-04f, 3.267526627e-04f, 2.830028534e-04f, 2.449750900e-04f, 2.121925354e-04f, 1.837611198e-04f, 1.591444016e-04f, 1.378059387e-04f, 1.193284988e-04f, 1.033246517e-04f, 8.949637413e-05f, 7.748603821e-05f, 6.711483002e-05f, 5.811452866e-05f, 5.032122135e-05f, 4.357099533e-05f, 3.772974014e-05f, 3.267824650e-05f, 2.829730511e-05f, 2.450495958e-05f, 2.121925354e-05f, 1.837313175e-05f};
__device__ const float ROPE_LO[64] = {3.629074854e-05f, 5.119791695e-06f, 2.563974340e-05f, 1.977708780e-05f, 2.186254642e-05f, 1.915789653e-05f, 6.928708444e-06f, 1.379869173e-05f, 5.725776191e-06f, 4.200542662e-06f, 6.599365861e-06f, 1.379848982e-05f, 4.771514341e-06f, 3.076627763e-06f, 6.306573596e-06f, 7.344074220e-06f, 5.773169960e-07f, 3.563736982e-06f, 2.563974249e-06f, 1.214769213e-06f, 6.603757470e-07f, 7.713804280e-07f, 1.455810320e-06f, 2.354600070e-07f, 1.335517140e-06f, 3.858455244e-08f, 4.692017228e-07f, 4.470491177e-08f, 6.678862974e-07f, 8.798673434e-07f, 4.399224736e-07f, 1.622028520e-07f, 3.438339888e-07f, 1.656388378e-07f, 4.471322939e-07f, 2.168443558e-07f, 2.090887250e-07f, 1.725054801e-07f, 2.529881415e-09f, 1.665971467e-07f, 2.289191343e-07f, 3.858455333e-09f, 1.184457474e-07f, 7.599606278e-08f, 1.910491321e-08f, 1.118285908e-07f, 4.399224807e-08f, 2.814121380e-08f, 1.054154186e-08f, 1.656388271e-08f, 2.087137041e-08f, 2.764489970e-08f, 3.027478712e-09f, 1.725054766e-08f, 2.529881304e-10f, 4.738785808e-09f, 7.990752948e-09f, 1.230677427e-08f, 1.184457421e-08f, 4.619374216e-09f, 4.890723382e-09f, 3.732278930e-09f, 4.399224540e-09f, 5.794353886e-09f};
__device__ __forceinline__ float lg2gamma(int h) { return h == 0 ? -0.04580368961312479f : h == 1 ? -0.02272007650008353f : h == 2 ? -0.011315313227834146f : -0.005646563141142063f; }

__device__ __forceinline__ float add_xor16(float v) { return v + __builtin_bit_cast(float, __builtin_amdgcn_ds_swizzle(__builtin_bit_cast(int, v), 0x401F)); }
__device__ __forceinline__ float add_xor32(float v) { float a_ = v, b_ = v; asm volatile("s_nop 1\n\tv_permlane32_swap_b32 %0, %1" : "+v"(a_), "+v"(b_)); return a_ + b_; }
namespace pg8 {
#ifndef BO_GRP
#define BO_GRP 8
#endif
struct BatchOrder {
    int nN, gsize, rank, nwg;
    __device__ __forceinline__ void init(int N, int gsize_, int rank_) { nN = N / BM; gsize = gsize_; rank = rank_; nwg = 16 * nN; }
    __device__ __forceinline__ bool next(int i, Unit& u) const {
        const int L = i * gsize + rank; if (L >= nwg) return false;
#if defined(BO_ORDER) && BO_ORDER == 1
        const int nb = nN >> 2;
        if (L < nb * 64) { const int q = L >> 6, r = L & 63, g = r >> 5, w = r & 31; u.pm = 8 * g + (w & 7); u.pn = 4 * q + (w >> 3); }
        else { const int Lt = L - nb * 64, rem = nN - 4 * nb, g = Lt / (8 * rem), w = Lt - g * 8 * rem; u.pm = 8 * g + (w & 7); u.pn = 4 * nb + (w >> 3); }
        return true;
#else
        const int grp = L / (BO_GRP * nN), r = L - grp * BO_GRP * nN; u.pm = BO_GRP * grp + (r % BO_GRP); u.pn = r / BO_GRP; return true;
#endif
    }
    __device__ __forceinline__ void a_ready(const Unit&) const {}
    __device__ __forceinline__ void done(const Unit&) const {}
};
__device__ __forceinline__ void load_rstd(const PG8_LAS float* side, int ui, int wr, int fr, float (&rs)[2][4]) {
#pragma unroll
    for (int ai = 0; ai < 2; ++ai)
#pragma unroll
        for (int m = 0; m < 4; ++m) rs[ai][m] = side[ui * 256 + ai * HALF + wr * 64 + m * 16 + fr];
}
template <class Sched> __device__ __forceinline__ void fill_rstd(const Sched& S, const float* ssq, PG8_LAS float* side, const int* pos, PG8_LAS float* posf, int tid) {
    Unit u;
    for (int i = 0; S.next(i, u); ++i) {
        const int row = u.pm * BM + (tid >> 1), hf = tid & 1;
        const f32x4 a = *(const f32x4*)(ssq + (size_t)row * 16 + 8 * hf), b = *(const f32x4*)(ssq + (size_t)row * 16 + 8 * hf + 4);
        float s = ((a[0] + a[1]) + (a[2] + a[3])) + ((b[0] + b[1]) + (b[2] + b[3]));
        s += __builtin_bit_cast(float, __builtin_amdgcn_ds_swizzle(__builtin_bit_cast(int, s), 0x041F));
        if (hf == 0) { side[i * 256 + (tid >> 1)] = rsqrtf(s * (1.0f / 1024.0f) + 1e-6f); if (pos) posf[i * 256 + (tid >> 1)] = (float)pos[row]; }
    }
}
#ifndef WTM
#define WTM 0
#endif
template <int BIT> __device__ __forceinline__ void st16(void* p, const u32x4 v) {
    if constexpr ((WTM >> BIT) & 1) asm volatile("global_store_dwordx4 %0, %1, off sc1\n\ts_nop 0" :: "v"(p), "v"(v) : "memory");
    else *(u32x4*)p = v;
}
__device__ __forceinline__ u32x4 pack8(const f32x4 a, const f32x4 b) { u32x4 w; w.x = cvt_pk_bf16(a[0], a[1]); w.y = cvt_pk_bf16(a[2], a[3]); w.z = cvt_pk_bf16(b[0], b[1]); w.w = cvt_pk_bf16(b[2], b[3]); return w; }

struct EpiInProj {
    static constexpr bool PERM = true, AFTER_DRAIN = false;
    const PG8_LAS float* side; const PG8_LAS float* posf; const PG8_LAS float* rope; bf16_t *q, *k, *v, *g, *uw;
    __device__ __forceinline__ void init(f32x4 (&acc)[2][2][4][2], const Unit&, int, int, int, int) const {
#pragma unroll
        for (int a = 0; a < 2; ++a)
#pragma unroll
            for (int b = 0; b < 2; ++b)
#pragma unroll
                for (int m = 0; m < 4; ++m)
#pragma unroll
                    for (int n = 0; n < 2; ++n) acc[a][b][m][n] = (f32x4){0.f, 0.f, 0.f, 0.f};
    }
    __device__ __forceinline__ void operator()(const f32x4 (&acc)[2][2][4][2], const Unit& u, int wr, int wc, int fr, int fq, int ui) const {
        const int rowbase = u.pm * BM + wr * 64 + fr;
        float rs[2][4]; load_rstd(side, ui, wr, fr, rs);
        if (u.pn < 4) {
            const int sec = u.pn >> 1, head = 2 * (u.pn & 1) + (wc >> 1), dd0 = 32 * (wc & 1) + 8 * fq;
            bf16_t* dst = sec ? k : q;
            const f32x4 h0 = *(const PG8_LAS f32x4*)(rope + dd0), h1 = *(const PG8_LAS f32x4*)(rope + dd0 + 4), l0 = *(const PG8_LAS f32x4*)(rope + 64 + dd0), l1 = *(const PG8_LAS f32x4*)(rope + 64 + dd0 + 4);
            const float lg = lg2gamma(head);
#pragma unroll
            for (int ai = 0; ai < 2; ++ai)
#pragma unroll
                for (int m = 0; m < 4; ++m) {
                    const int row = rowbase + ai * HALF + m * 16, b = row >> 12, s = row & 4095;
                    const float p = posf[ui * 256 + ai * HALF + wr * 64 + m * 16 + fr];
                    const float sc = rs[ai][m] * (sec ? __builtin_amdgcn_exp2f((float)(127 - (s & 127)) * lg) : 1.0f);
                    f32x4 o1[2], o2[2];
#pragma unroll
                    for (int n = 0; n < 2; ++n) { const f32x4 fh = n ? h1 : h0, fl = n ? l1 : l0;
#pragma unroll
                        for (int j = 0; j < 4; ++j) { const float ph = p * fh[j]; const float rev = (ph - __builtin_floorf(ph)) + p * fl[j];
                            const float cs = __builtin_amdgcn_cosf(rev), sn = __builtin_amdgcn_sinf(rev);
                            const float x1 = acc[ai][0][m][n][j] * sc, x2 = acc[ai][1][m][n][j] * sc;
                            o1[n][j] = x1 * cs - x2 * sn; o2[n][j] = x2 * cs + x1 * sn; } }
                    bf16_t* rp = dst + ((size_t)((b * NH_ + head) * SEQ_ + s)) * 128 + dd0;
                    st16<0>(rp, pack8(o1[0], o1[1])); st16<0>((rp + 64), pack8(o2[0], o2[1]));
                    asm volatile("" ::: "memory");
                }
        } else {
            const int sec = (u.pn - 4) >> 1;
            const int c0 = 256 * (u.pn & 1) + 32 * wc + 8 * fq;
#pragma unroll
            for (int ai = 0; ai < 2; ++ai)
#pragma unroll
                for (int m = 0; m < 4; ++m) {
                    const int row = rowbase + ai * HALF + m * 16, b = row >> 12, s = row & 4095; const float sc = rs[ai][m];
#pragma unroll
                    for (int bj = 0; bj < 2; ++bj) { const u32x4 w = pack8(acc[ai][bj][m][0] * sc, acc[ai][bj][m][1] * sc); const int c = c0 + 128 * bj;
                        if (sec == 2) st16<0>((uw + (size_t)row * 512 + c), w);
                        else { bf16_t* dst = sec ? g : v; st16<0>((dst + ((size_t)((b * NH_ + (c >> 7)) * SEQ_ + s)) * 128 + (c & 127)), w); } }
                }
        }
    }
    static constexpr int NH_ = 4, SEQ_ = 4096;
};

__device__ __forceinline__ void unpack8(const u32x4 w, f32x4& a, f32x4& b) {
    a[0] = __builtin_bit_cast(float, w.x << 16); a[1] = __builtin_bit_cast(float, w.x & 0xffff0000u); a[2] = __builtin_bit_cast(float, w.y << 16); a[3] = __builtin_bit_cast(float, w.y & 0xffff0000u);
    b[0] = __builtin_bit_cast(float, w.z << 16); b[1] = __builtin_bit_cast(float, w.z & 0xffff0000u); b[2] = __builtin_bit_cast(float, w.w << 16); b[3] = __builtin_bit_cast(float, w.w & 0xffff0000u);
}
struct EpiResid {
    static constexpr bool PERM = true, AFTER_DRAIN = false;
    const bf16_t* xin; bf16_t* xout; float* ssq_out;
    __device__ __forceinline__ void init(f32x4 (&acc)[2][2][4][2], const Unit& u, int wr, int wc, int fr, int fq) const {
        const int rowbase = u.pm * BM + wr * 64 + fr, col0 = u.pn * BM + 32 * wc + 8 * fq;
        u32x4 w[2][4][2];
#pragma unroll
        for (int ai = 0; ai < 2; ++ai)
#pragma unroll
            for (int m = 0; m < 4; ++m)
#pragma unroll
                for (int bj = 0; bj < 2; ++bj) w[ai][m][bj] = *(const u32x4*)(xin + (size_t)(rowbase + ai * HALF + m * 16) * 1024 + col0 + bj * HALF);
#pragma unroll
        for (int ai = 0; ai < 2; ++ai)
#pragma unroll
            for (int m = 0; m < 4; ++m)
#pragma unroll
                for (int bj = 0; bj < 2; ++bj) unpack8(w[ai][m][bj], acc[ai][bj][m][0], acc[ai][bj][m][1]);
    }
    __device__ __forceinline__ void operator()(const f32x4 (&acc)[2][2][4][2], const Unit& u, int wr, int wc, int fr, int fq, int) const {
        const int rowbase = u.pm * BM + wr * 64 + fr, col0 = u.pn * BM + 32 * wc + 8 * fq;
#pragma unroll
        for (int ai = 0; ai < 2; ++ai)
#pragma unroll
            for (int m = 0; m < 4; ++m) {
                const int row = rowbase + ai * HALF + m * 16; const size_t off = (size_t)row * 1024 + col0; float ss = 0.f;
#pragma unroll
                for (int bj = 0; bj < 2; ++bj) {
                    const f32x4 v0 = acc[ai][bj][m][0], v1 = acc[ai][bj][m][1];
                    st16<1>((xout + off + bj * HALF), pack8(v0, v1));
                    ss += (v0[0] * v0[0] + v0[1] * v0[1]) + (v0[2] * v0[2] + v0[3] * v0[3]) + (v1[0] * v1[0] + v1[1] * v1[1]) + (v1[2] * v1[2] + v1[3] * v1[3]); }
                ss = add_xor32(add_xor16(ss));
                if (fq == 0) ssq_out[(size_t)row * 16 + u.pn * 4 + wc] = ss;
            }
    }
};

struct EpiSwiGLU {
    static constexpr bool PERM = true, AFTER_DRAIN = false;
    const PG8_LAS float* side; bf16_t* h;
    __device__ __forceinline__ void init(f32x4 (&acc)[2][2][4][2], const Unit&, int, int, int, int) const {
#pragma unroll
        for (int a = 0; a < 2; ++a)
#pragma unroll
            for (int b = 0; b < 2; ++b)
#pragma unroll
                for (int m = 0; m < 4; ++m)
#pragma unroll
                    for (int n = 0; n < 2; ++n) acc[a][b][m][n] = (f32x4){0.f, 0.f, 0.f, 0.f};
    }
    __device__ __forceinline__ void operator()(const f32x4 (&acc)[2][2][4][2], const Unit& u, int wr, int wc, int fr, int fq, int ui) const {
        const int rowbase = u.pm * BM + wr * 64 + fr, col0 = u.pn * HALF + 32 * wc + 8 * fq;
        float rs[2][4]; load_rstd(side, ui, wr, fr, rs);
#pragma unroll
        for (int ai = 0; ai < 2; ++ai)
#pragma unroll
            for (int m = 0; m < 4; ++m) { const float sc = rs[ai][m], c1 = -1.4426950408889634f * sc, sc2 = sc * sc; f32x4 o[2];
#pragma unroll
                for (int n = 0; n < 2; ++n)
#pragma unroll
                    for (int jp = 0; jp < 2; ++jp) { const f32x2_t av = {acc[ai][0][m][n][2 * jp], acc[ai][0][m][n][2 * jp + 1]}, bv = {acc[ai][1][m][n][2 * jp], acc[ai][1][m][n][2 * jp + 1]};
                        const f32x2_t t = av * c1; f32x2_t ex; ex.x = __builtin_amdgcn_exp2f(t.x); ex.y = __builtin_amdgcn_exp2f(t.y);
                        const f32x2_t d = ex + 1.0f; f32x2_t r; r.x = __builtin_amdgcn_rcpf(d.x); r.y = __builtin_amdgcn_rcpf(d.y);
                        const f32x2_t ov = (av * bv) * (r * sc2); o[n][2 * jp] = ov.x; o[n][2 * jp + 1] = ov.y; }
                st16<2>((h + (size_t)(rowbase + ai * HALF + m * 16) * 2816 + col0), pack8(o[0], o[1])); }
    }
};

struct EpiPlain {
    static constexpr bool PERM = true, AFTER_DRAIN = false;
    bf16_t* O; int ldc;
    __device__ __forceinline__ void init(f32x4 (&acc)[2][2][4][2], const Unit&, int, int, int, int) const {
#pragma unroll
        for (int a = 0; a < 2; ++a)
#pragma unroll
            for (int b = 0; b < 2; ++b)
#pragma unroll
                for (int m = 0; m < 4; ++m)
#pragma unroll
                    for (int n = 0; n < 2; ++n) acc[a][b][m][n] = (f32x4){0.f, 0.f, 0.f, 0.f};
    }
    __device__ __forceinline__ void operator()(const f32x4 (&acc)[2][2][4][2], const Unit& u, int wr, int wc, int fr, int fq, int) const {
        const int rowbase = u.pm * BM + wr * 64 + fr, col0 = u.pn * BM + 32 * wc + 8 * fq;
#pragma unroll
        for (int ai = 0; ai < 2; ++ai)
#pragma unroll
            for (int m = 0; m < 4; ++m)
#pragma unroll
                for (int bj = 0; bj < 2; ++bj) st16<3>((O + (size_t)(rowbase + ai * HALF + m * 16) * ldc + col0 + bj * HALF), pack8(acc[ai][bj][m][0], acc[ai][bj][m][1]));
    }
};

struct EpiPle {
    static constexpr bool PERM = true, AFTER_DRAIN = false;
    const PG8_LAS float* side; const bf16_t* e; const bf16_t* xin; bf16_t* xout; float* ssq_out;
    __device__ __forceinline__ void init(f32x4 (&acc)[2][2][4][2], const Unit&, int, int, int, int) const {
#pragma unroll
        for (int a = 0; a < 2; ++a)
#pragma unroll
            for (int b = 0; b < 2; ++b)
#pragma unroll
                for (int m = 0; m < 4; ++m)
#pragma unroll
                    for (int n = 0; n < 2; ++n) acc[a][b][m][n] = (f32x4){0.f, 0.f, 0.f, 0.f};
    }
    __device__ __forceinline__ void operator()(const f32x4 (&acc)[2][2][4][2], const Unit& u, int wr, int wc, int fr, int fq, int ui) const {
        const int rowbase = u.pm * BM + wr * 64 + fr, col0 = u.pn * BM + 32 * wc + 8 * fq;
        float rs[2][4]; load_rstd(side, ui, wr, fr, rs);
#pragma unroll
        for (int ai = 0; ai < 2; ++ai)
#pragma unroll
            for (int m = 0; m < 4; ++m) {
                const int row = rowbase + ai * HALF + m * 16; const size_t off = (size_t)row * 1024 + col0; float ss = 0.f; const float sc = -1.4426950408889634f * rs[ai][m];
#pragma unroll
                for (int bj = 0; bj < 2; ++bj) {
                    f32x4 e0, e1, x0, x1; unpack8(*(const u32x4*)(e + off + bj * HALF), e0, e1); unpack8(*(const u32x4*)(xin + off + bj * HALF), x0, x1);
                    f32x4 v0, v1;
#pragma unroll
                    for (int j = 0; j < 4; ++j) {
                        v0[j] = x0[j] + __builtin_amdgcn_rcpf(1.0f + __builtin_amdgcn_exp2f(sc * acc[ai][bj][m][0][j])) * e0[j];
                        v1[j] = x1[j] + __builtin_amdgcn_rcpf(1.0f + __builtin_amdgcn_exp2f(sc * acc[ai][bj][m][1][j])) * e1[j]; }
                    st16<4>((xout + off + bj * HALF), pack8(v0, v1));
                    ss += (v0[0] * v0[0] + v0[1] * v0[1]) + (v0[2] * v0[2] + v0[3] * v0[3]) + (v1[0] * v1[0] + v1[1] * v1[1]) + (v1[2] * v1[2] + v1[3] * v1[3]); }
                ss = add_xor32(add_xor16(ss));
                if (fq == 0) ssq_out[(size_t)row * 16 + u.pn * 4 + wc] = ss;
            }
    }
};
}
#define XB_TMO      128
#define XB_XCNT(j)  (256  + 64 * (j))
#define XB_XSUB(j)  (1280 + 64 * (j))
#define XB_XGEN(j)  (2304 + 64 * (j))
#define XB_TOP      3328
#define XB_TOPGEN   3392
#define XCD_BAR_WORDS 3456
#define XB_SPIN_CAP (1u << 18)

__device__ __forceinline__ unsigned xb_ld(unsigned* p)              { return __hip_atomic_load(p, __ATOMIC_RELAXED, __HIP_MEMORY_SCOPE_AGENT); }
__device__ __forceinline__ unsigned xb_add(unsigned* p, unsigned v) { return __hip_atomic_fetch_add(p, v, __ATOMIC_RELAXED, __HIP_MEMORY_SCOPE_AGENT); }
__device__ __forceinline__ unsigned xb_xcc_id() { return (unsigned)__builtin_amdgcn_s_getreg((3 << 11) | 20) & 0xFu; }
#define XB_SPIN(cond, bar) do { unsigned _sp = 0; while (cond) { __builtin_amdgcn_s_sleep(1); \
    if ((++_sp & 255u) == 0u) { if (xb_ld(&(bar)[XB_TMO])) break; if (_sp > XB_SPIN_CAP) { atomicAdd(&(bar)[XB_TMO], 1u); break; } } } } while (0)

struct XcdBarrier {
    unsigned* bar; unsigned x;
    volatile LAS unsigned* st;
};

__device__ __forceinline__ XcdBarrier xcd_barrier_post(unsigned* bar, volatile LAS unsigned* st) {
    XcdBarrier b; b.bar = bar; b.x = xb_xcc_id(); b.st = st;
    if (threadIdx.x == 0) st[2] = xb_add(&bar[XB_XCNT(b.x)], 1u);
    return b;
}
__device__ __forceinline__ void xcd_barrier_complete(unsigned* bar, unsigned x, unsigned& nloc, unsigned& nx) {
    const unsigned G = gridDim.x * gridDim.y * gridDim.z;
    unsigned sum, cnt, mine, sp = 0u;
    for (;;) {
        sum = 0u; cnt = 0u; mine = 0u;
#pragma unroll
        for (unsigned j = 0; j < 16; ++j) { const unsigned c = xb_ld(&bar[XB_XCNT(j)]); sum += c; cnt += (c > 0u) ? 1u : 0u; mine = (j == x) ? c : mine; }
        if (sum == G) break;
        __builtin_amdgcn_s_sleep(1);
        if ((++sp & 255u) == 0u) { if (xb_ld(&bar[XB_TMO])) break; if (sp > XB_SPIN_CAP) { atomicAdd(&bar[XB_TMO], 1u); break; } }
    }
    nloc = mine > 0u ? mine : 1u; nx = cnt > 0u ? cnt : 1u;
}

__device__ __forceinline__ void xcd_barrier(const XcdBarrier& b) {
    asm volatile("s_waitcnt vmcnt(0)" ::: "memory");
    __syncthreads();
    if (threadIdx.x == 0) {
        unsigned* bar = b.bar; unsigned bx_ = b.x; asm volatile("" : "+s"(bar), "+s"(bx_));
        __builtin_amdgcn_s_waitcnt(0);
        unsigned nloc = b.st[0], nx = b.st[1];
        if (nloc == 0u) { xcd_barrier_complete(bar, bx_, nloc, nx); b.st[0] = nloc; b.st[1] = nx; }
        const unsigned old = xb_add(&bar[XB_XSUB(bx_)], 1u);
        const unsigned gen = old / nloc;
        if (old + 1u == (gen + 1u) * nloc) {
            __builtin_amdgcn_fence(__ATOMIC_RELEASE, "agent");
            asm volatile("s_waitcnt vmcnt(0)" ::: "memory");
            const unsigned og = xb_add(&bar[XB_TOP], 1u);
            const unsigned tg = og / nx;
            if (og + 1u == (tg + 1u) * nx) xb_add(&bar[XB_TOPGEN], 1u);
            else XB_SPIN(xb_ld(&bar[XB_TOPGEN]) == tg, bar);
            __builtin_amdgcn_fence(__ATOMIC_ACQUIRE, "agent");
            xb_add(&bar[XB_XGEN(bx_)], 1u);
            asm volatile("s_waitcnt vmcnt(0)" ::: "memory");
        } else {
            XB_SPIN(xb_ld(&bar[XB_XGEN(bx_)]) == gen, bar);
            __builtin_amdgcn_fence(__ATOMIC_ACQUIRE, "agent");
            asm volatile("s_waitcnt vmcnt(0)" ::: "memory");
        }
    }
    __syncthreads();
}

#define XB_LSUB(j)  (3456 + 64 * (j))
#define XB_LGEN(j)  (3456 + 1024 + 64 * (j))
#define XB_TICKET   (3456 + 2048)
__device__ __forceinline__ void xcd_local_barrier(const XcdBarrier& b) {
    asm volatile("s_waitcnt vmcnt(0)" ::: "memory");
    __syncthreads();
    if (threadIdx.x == 0) {
        unsigned* bar = b.bar; unsigned bx_ = b.x; asm volatile("" : "+s"(bar), "+s"(bx_));
        const unsigned nloc = b.st[0];
        const unsigned old = xb_add(&bar[XB_LSUB(bx_)], 1u);
        const unsigned gen = old / nloc;
        if (old + 1u == (gen + 1u) * nloc) xb_add(&bar[XB_LGEN(bx_)], 1u);
        else XB_SPIN(xb_ld(&bar[XB_LGEN(bx_)]) == gen, bar);
        __builtin_amdgcn_fence(__ATOMIC_ACQUIRE, "agent");
        asm volatile("s_waitcnt vmcnt(0)" ::: "memory");
    }
    __syncthreads();
}

__device__ __forceinline__ float wave_sum(float v) {
    v += __builtin_bit_cast(float, __builtin_amdgcn_ds_swizzle(__builtin_bit_cast(int, v), 0x041F));
    v += __builtin_bit_cast(float, __builtin_amdgcn_ds_swizzle(__builtin_bit_cast(int, v), 0x081F));
    v += __builtin_bit_cast(float, __builtin_amdgcn_ds_swizzle(__builtin_bit_cast(int, v), 0x101F));
    v += __builtin_bit_cast(float, __builtin_amdgcn_ds_swizzle(__builtin_bit_cast(int, v), 0x201F));
    return add_xor32(add_xor16(v));
}
__device__ __forceinline__ unsigned off_b(unsigned row, unsigned ch) { return 256u * row + 16u * (ch ^ (((row & 3u) << 2) | ((row >> 2) & 3u))); }
__device__ __forceinline__ unsigned tr_addr_nat(unsigned lane, unsigned c, unsigned ks, unsigned t) {
    const unsigned h = lane >> 5, blk = (lane >> 4) & 1u, q = (lane & 15u) >> 2, p = lane & 3u;
    return off_b(16u * ks + 8u * h + 4u * t + q, 4u * c + 2u * blk + (p >> 1)) + 8u * (p & 1u);
}
__device__ __forceinline__ unsigned tr_addr_perm(unsigned lane, unsigned c, unsigned ks, unsigned t) {
    const unsigned h = lane >> 5, blk = (lane >> 4) & 1u, q = (lane & 15u) >> 2, p = lane & 3u;
    return off_b(16u * ks + 8u * t + 4u * h + q, 4u * c + 2u * blk + (p >> 1)) + 8u * (p & 1u);
}
__device__ __forceinline__ unsigned tr_addr16(unsigned lane, unsigned c, unsigned ks, unsigned t) {
    const unsigned g = lane >> 4, q = (lane & 15u) >> 2, p = lane & 3u;
    return off_b(32u * ks + 8u * g + 4u * t + q, 2u * c + (p >> 1)) + 8u * (p & 1u);
}
__device__ __forceinline__ void glds16(const void* gsrc, unsigned lds_dst) { unsigned keep;
    asm volatile("s_mov_b32 %0, m0\n\ts_mov_b32 m0, %2\n\ts_nop 0\n\tglobal_load_lds_dwordx4 %1, off\n\ts_mov_b32 m0, %0" : "=&s"(keep) : "v"(gsrc), "s"(lds_dst) : "memory"); }
typedef short v4i16_t __attribute__((ext_vector_type(4)));
__device__ __forceinline__ s16x4 tr_read(LAS unsigned char* p) { return __builtin_bit_cast(s16x4, __builtin_amdgcn_ds_read_tr16_b64_v4i16((LAS v4i16_t*)p)); }
__device__ __forceinline__ bf16x8 cat4(s16x4 a, s16x4 b) { return (bf16x8){a[0], a[1], a[2], a[3], b[0], b[1], b[2], b[3]}; }
__device__ __forceinline__ unsigned cvtpk(float lo, float hi) { return pg8::cvt_pk_bf16(lo, hi); }
__device__ __forceinline__ int crow(int r, int hi) { return (r & 3) + 8 * (r >> 2) + 4 * hi; }
__device__ __forceinline__ bf16x8 pack_acc(const f32x16& a, int s) {
    v4u w; w.x = cvtpk(a[8 * s + 0], a[8 * s + 1]); w.y = cvtpk(a[8 * s + 2], a[8 * s + 3]); w.z = cvtpk(a[8 * s + 4], a[8 * s + 5]); w.w = cvtpk(a[8 * s + 6], a[8 * s + 7]);
    return __builtin_bit_cast(bf16x8, w);
}

__device__ __forceinline__ void tr_item(const float* W, int ldw, int srccol0, int k0, const float* gain, float scal, bf16* WT, int K, int dstrow0, LAS float* scr, int lane) {
    float r[32], gv[32];
    const float* wp = W + (size_t)(k0 + (lane >> 5)) * ldw + srccol0 + (lane & 31);
#pragma unroll
    for (int i = 0; i < 32; ++i) r[i] = __builtin_nontemporal_load(wp + (size_t)(2 * i) * ldw);
    if (gain) {
#pragma unroll
        for (int i = 0; i < 32; ++i) gv[i] = gain[k0 + 2 * i + (lane >> 5)] * scal;
    } else {
#pragma unroll
        for (int i = 0; i < 32; ++i) gv[i] = scal;
    }
#pragma unroll
    for (int i = 0; i < 32; ++i) scr[(2 * i + (lane >> 5)) * 33 + (lane & 31)] = r[i] * gv[i];
    LDS_WAIT(); asm volatile("" ::: "memory");
    const int c = lane & 7;
#pragma unroll
    for (int j = 0; j < 4; ++j) { const int n = (lane >> 3) + 8 * j; const LAS float* s = scr + (8 * c) * 33 + n;
        v4u o; o.x = pk2(s[0 * 33], s[1 * 33]); o.y = pk2(s[2 * 33], s[3 * 33]); o.z = pk2(s[4 * 33], s[5 * 33]); o.w = pk2(s[6 * 33], s[7 * 33]);
        *(GAS v4u*)(WT + (size_t)(dstrow0 + n) * K + k0 + 8 * c) = o; }
    LDS_WAIT(); asm volatile("" ::: "memory");
}

struct Args { const float* x; const float* p; const int* pos; const float* g_mix; const float* w_in; const float* pool_w; const float* pool_scale; const float* w_out; const float* g_ffn;
              const float* w_gate; const float* w_up; const float* w_down; const float* g_ple; const float* w_ple_gate; const float* w_ple_proj; const float* g_final; float* out; unsigned char* ws; };

template <int W> __device__ __forceinline__ void pool_rows(const bf16* uw, bf16* mix, int b, int s0, int c0) {
    constexpr int NR = W - 1 + 16;
    v2u xr[NR];
#pragma unroll
    for (int i = 0; i < NR; ++i) { const int s = s0 - (W - 1) + i;
        xr[i] = (s >= 0) ? *(const GAS v2u*)(uw + (size_t)(b * SEQ + s) * 512 + c0) : (v2u){0u, 0u}; }
    float sum[4];
#pragma unroll
    for (int j = 0; j < 4; ++j) sum[j] = 0.f;
#pragma unroll
    for (int i = 0; i < W - 1; ++i)
#pragma unroll
        for (int j = 0; j < 2; ++j) { sum[2 * j] += bf_lo(xr[i][j]); sum[2 * j + 1] += bf_hi(xr[i][j]); }
#pragma unroll
    for (int i = 0; i < 16; ++i) {
        const int s = s0 + i; const float inv = 1.0f / (float)((s + 1 < W) ? (s + 1) : W);
        float o[4];
#pragma unroll
        for (int j = 0; j < 2; ++j) { const float a = bf_lo(xr[W - 1 + i][j]), c = bf_hi(xr[W - 1 + i][j]);
            sum[2 * j] += a; sum[2 * j + 1] += c; o[2 * j] = sum[2 * j] * inv - a; o[2 * j + 1] = sum[2 * j + 1] * inv - c;
            sum[2 * j] -= bf_lo(xr[i][j]); sum[2 * j + 1] -= bf_hi(xr[i][j]); }
        *(GAS v2u*)(mix + (size_t)(b * SEQ + s) * 1024 + 512 + c0) = (v2u){pk2(o[0], o[1]), pk2(o[2], o[3])};
    }
}

__global__ void __launch_bounds__(NWAVES * 64, 2) fwd(Args a_in) {
    extern __shared__ __attribute__((aligned(16))) unsigned char lds_raw[];
    LAS unsigned char* lds = (LAS unsigned char*)lds_raw;
    volatile LAS unsigned* MISC = (volatile LAS unsigned*)(lds + MISC_OFF);
    const int tid = threadIdx.x, lane = tid & 63, wave = __builtin_amdgcn_readfirstlane(tid >> 6);
    const int G = gridDim.x, bx = blockIdx.x;
    const int gw = bx * NWAVES + wave, NGW = G * NWAVES;
    typedef const __attribute__((address_space(4))) Args CArgs;
#define PHASE_ENVB(bi_) CArgs* ap_ = (CArgs*)__builtin_amdgcn_kernarg_segment_ptr(); asm volatile("" : "+s"(ap_)); CArgs& a = *ap_; \
    unsigned char* const ws = a.ws; float* const ssqA = (float*)(ws + WS_SSQA) + (size_t)(bi_) * SEQ * 16; float* const ssqB = (float*)(ws + WS_SSQB) + (size_t)(bi_) * SEQ * 16; \
    bf16* const xb = (bf16*)(ws + WS_XB) + (size_t)(bi_) * SEQ * D; bf16* const xb1 = (bf16*)(ws + WS_XB1) + (size_t)(bi_) * SEQ * D; bf16* const pb = (bf16*)(ws + WS_PB) + (size_t)(bi_) * SEQ * PLE; \
    unsigned char* const R = ws + WS_R + (size_t)(bi_) * R_BATCH; \
    bf16* const qb = (bf16*)(R + R_Q); bf16* const kb = (bf16*)(R + R_K); bf16* const vb = (bf16*)(R + R_V); bf16* const gb = (bf16*)(R + R_G); bf16* const uwb = (bf16*)(R + R_UW); \
    bf16* const kvb = (bf16*)(R + R_KV); bf16* const mix = (bf16*)(R + R_MIX); bf16* const hmid = (bf16*)(R + R_H); bf16* const eb = (bf16*)(R + R_E); float* const utmp = (float*)(ws + WS_R + R_UT); \
    (void)ssqA; (void)ssqB; (void)xb; (void)xb1; (void)pb; (void)qb; (void)kb; (void)vb; (void)gb; (void)uwb; (void)kvb; (void)mix; (void)hmid; (void)eb; (void)utmp
#define PHASE_ENV() PHASE_ENVB(batch)
    gu32* ctl = (gu32*)(a_in.ws + WS_CTL);
    for (int u = tid; u < (LDS_BYTES - LDSCTL_OFF) / 4; u += NWAVES * 64) ((LAS unsigned*)(lds + LDSCTL_OFF))[u] = 0u;
    __syncthreads();
    XcdBarrier bar = xcd_barrier_post((unsigned*)(ctl + CW_BAR), MISC + 8);

#ifndef PHMASK
#define PHMASK 0xFFFF
#endif
#define PH(n) ((PHMASK >> (n)) & 1)
#define FRESH_TID(name) int name = threadIdx.x; asm volatile("" : "+v"(name))
    if (PH(0)) { PHASE_ENVB(0);
    for (int task = gw; task < DEPTH * 4 * 2 * 128; task += NGW) {
        const int kb8 = task & 127, dh = (task >> 7) & 1, g = (task >> 8) & 3, L = task >> 10;
        const int d = dh * 64 + lane;
        const float* pw = a.pool_w + (size_t)((L * 4 + g) * 128) * 128 + d;
        const float* wi = a.w_in + (size_t)(L * 1024 + kb8 * 8) * INW + 2048 + g * 128;
        float acc[8];
#pragma unroll
        for (int i = 0; i < 8; ++i) acc[i] = 0.f;
#pragma unroll 4
        for (int c = 0; c < 128; ++c) { const float bv = pw[(size_t)c * 128];
#pragma unroll
            for (int i = 0; i < 8; ++i) acc[i] += wi[(size_t)i * INW + c] * bv; }
        const float sc = a.pool_scale[L * 512 + g * 128 + d];
#pragma unroll
        for (int i = 0; i < 8; ++i) utmp[(size_t)(L * 1024 + kb8 * 8 + i) * 512 + g * 128 + d] = acc[i] * sc;
    }
    }
    xcd_barrier(bar);
#ifndef FORCE_FALLBACK
#define FORCE_FALLBACK 0
#endif
    if (threadIdx.x == 0) {
        unsigned* barw = (unsigned*)(ctl + CW_BAR);
        const unsigned nloc_ = MISC[8], nx_ = MISC[9], rk_ = MISC[10], myx_ = xb_xcc_id();
        unsigned mode_ = 0u, batch_ = 0u, rank_ = 0u, gsz_ = 1u;
        if (nx_ == 8u && !FORCE_FALLBACK) { mode_ = 1u; for (unsigned j = 0; j < 16; ++j) if (j < myx_ && xb_ld(&barw[XB_XCNT(j)]) > 0u) ++batch_; rank_ = rk_; gsz_ = nloc_; }
        else { const unsigned t_ = xb_add(&barw[XB_TICKET], 1u); batch_ = t_ % 8u; rank_ = t_ / 8u; gsz_ = (unsigned)G / 8u + ((batch_ < (unsigned)G % 8u) ? 1u : 0u); }
        MISC[11] = mode_; MISC[12] = batch_; MISC[13] = rank_; MISC[14] = gsz_;
    }
    __syncthreads();
    const int lmode = __builtin_amdgcn_readfirstlane((int)MISC[11]), batch = __builtin_amdgcn_readfirstlane((int)MISC[12]), rank = __builtin_amdgcn_readfirstlane((int)MISC[13]), gsz = __builtin_amdgcn_readfirstlane((int)MISC[14]);
#define LBAR() do { if (lmode) xcd_local_barrier(bar); else xcd_barrier(bar); } while (0)

    if (PH(1)) { PHASE_ENVB(0);
        LAS float* scr = (LAS float*)(lds + wave * 16384);
        constexpr int I_IN = 16 * 80, I_OUT = 16 * 32, I_GU = 16 * 176, I_DN = 44 * 32, I_PG = 16 * 32, I_PP = 4 * 32, I_L = I_IN + I_OUT + I_GU + I_DN + I_PG + I_PP;
        for (int it = gw; it < DEPTH * I_L; it += NGW) {
            const int L = it / I_L; int r = it % I_L;
            unsigned char* wl = ws + WS_W + (size_t)L * W_LAYER;
            if (r < I_IN) { const int kbk = r / 80, nb = r % 80, n0 = 32 * nb, k0 = 64 * kbk; const float* gn = a.g_mix + L * 1024;
                if (n0 < 1024) { const int sec = n0 >> 9, w = n0 & 511, t = w >> 8, bj = (w >> 7) & 1, hh = (w >> 6) & 1, dd0 = w & 63;
                    tr_item(a.w_in + (size_t)L * 1024 * INW, INW, sec * 512 + (2 * t + hh) * 128 + bj * 64 + dd0, k0, gn, sec == 0 ? 0.08838834764831845f : 1.0f, (bf16*)(wl + WO_IN), 1024, n0, scr, lane); }
                else if (n0 < 2048) tr_item(a.w_in + (size_t)L * 1024 * INW, INW, n0, k0, gn, 1.0f, (bf16*)(wl + WO_IN), 1024, n0, scr, lane);
                else tr_item(utmp + (size_t)L * 1024 * 512, 512, n0 - 2048, k0, gn, 1.0f, (bf16*)(wl + WO_IN), 1024, n0, scr, lane);
                continue; } r -= I_IN;
            if (r < I_OUT) { const int kbk = r / 32, nb = r % 32; tr_item(a.w_out + (size_t)L * 1024 * 1024, 1024, 32 * nb, 64 * kbk, nullptr, 1.0f, (bf16*)(wl + WO_OUT), 1024, 32 * nb, scr, lane); continue; } r -= I_OUT;
            if (r < I_GU) { const int kbk = r / 176, nb = r % 176, n0 = 32 * nb, t = n0 >> 8, bj = (n0 >> 7) & 1, j0 = n0 & 127;
                tr_item((bj ? a.w_up : a.w_gate) + (size_t)L * 1024 * FF, FF, 128 * t + j0, 64 * kbk, a.g_ffn + L * 1024, 1.0f, (bf16*)(wl + WO_GU), 1024, n0, scr, lane); continue; } r -= I_GU;
            if (r < I_DN) { const int kbk = r / 32, nb = r % 32; tr_item(a.w_down + (size_t)L * FF * 1024, 1024, 32 * nb, 64 * kbk, nullptr, 1.0f, (bf16*)(wl + WO_DOWN), FF, 32 * nb, scr, lane); continue; } r -= I_DN;
            if (r < I_PG) { const int kbk = r / 32, nb = r % 32; tr_item(a.w_ple_gate + (size_t)L * 1024 * 1024, 1024, 32 * nb, 64 * kbk, a.g_ple + L * 1024, 1.0f, (bf16*)(wl + WO_PG), 1024, 32 * nb, scr, lane); continue; } r -= I_PG;
            { const int kbk = r / 32, nb = r % 32; tr_item(a.w_ple_proj + (size_t)L * PLE * 1024, 1024, 32 * nb, 64 * kbk, nullptr, 1.0f, (bf16*)(wl + WO_PP), PLE, 32 * nb, scr, lane); }
        }
        for (int m = 2 * gw; m < M; m += 2 * NGW) {
            const GAS f32x4* xr = (const GAS f32x4*)(a.x + (size_t)m * D) + lane; GAS v2u* o8 = (GAS v2u*)(xb1 + (size_t)m * D) + lane;
            f32x4 v[8];
#pragma unroll
            for (int j = 0; j < 8; ++j) v[j] = __builtin_nontemporal_load(xr + 64 * j);
            float ss0 = 0.f, ss1 = 0.f;
#pragma unroll
            for (int j = 0; j < 4; ++j) { ss0 += (v[j][0] * v[j][0] + v[j][1] * v[j][1]) + (v[j][2] * v[j][2] + v[j][3] * v[j][3]); o8[64 * j] = (v2u){pk2(v[j][0], v[j][1]), pk2(v[j][2], v[j][3])}; }
#pragma unroll
            for (int j = 4; j < 8; ++j) { ss1 += (v[j][0] * v[j][0] + v[j][1] * v[j][1]) + (v[j][2] * v[j][2] + v[j][3] * v[j][3]); o8[64 * j] = (v2u){pk2(v[j][0], v[j][1]), pk2(v[j][2], v[j][3])}; }
            ss0 = wave_sum(ss0); ss1 = wave_sum(ss1);
            if (lane < 32) ssqB[(size_t)m * 16 + lane] = (lane == 0) ? ss0 : (lane == 16) ? ss1 : 0.f;
        }
        for (size_t i = (size_t)bx * 512 + tid; i < (size_t)M * PLE / 8; i += (size_t)G * 512) {
            const f32x4 v0 = ((const GAS f32x4*)a.p)[2 * i], v1 = ((const GAS f32x4*)a.p)[2 * i + 1];
            ((GAS v4u*)pb)[i] = (v4u){pk2(v0[0], v0[1]), pk2(v0[2], v0[3]), pk2(v1[0], v1[1]), pk2(v1[2], v1[3])};
        }
    }
    xcd_barrier(bar);

    for (int L = 0; L < DEPTH; ++L) {

#ifndef REP_P1
#define REP_P1 1
#endif
#pragma unroll 1
        for (int rep_ = 0; rep_ < REP_P1; ++rep_) {
        if (PH(2)) {
            PHASE_ENV(); const unsigned char* wl = ws + WS_W + (size_t)L * W_LAYER; (void)wl; FRESH_TID(ptid); pg8::Gemm g{xb1, (const bf16*)(wl + WO_IN), SEQ, INW, D}; pg8::BatchOrder S; S.init(INW, gsz, rank);
            PG8_LAS float* side = (PG8_LAS float*)(lds + SIDE_OFF); const int npu = (S.nwg + gsz - 1) / gsz;     PG8_LAS float* posf = side + npu * 256; PG8_LAS float* rope = posf + npu * 256;
            pg8::fill_rstd(S, ssqB, side, a.pos + batch * SEQ, posf, ptid); if (ptid < 64) { rope[ptid] = ROPE_HI[ptid]; rope[64 + ptid] = ROPE_LO[ptid]; } __syncthreads();
            pg8::EpiInProj E{side, posf, rope, qb, kb, vb, gb, uwb};
            pg8::gemm_phase<pg8::EpiInProj, pg8::BatchOrder, true, true>(lds, g, S, E, ptid);
        }
        LBAR();


        }
#ifndef REP_RET
#define REP_RET 1
#endif
#pragma unroll 1
        for (int rep_ = 0; rep_ < REP_RET; ++rep_) {
        if (PH(3)) { PHASE_ENV();
            FRESH_TID(t_); const int tid = t_, lane = t_ & 63, wave = __builtin_amdgcn_readfirstlane(t_ >> 6); (void)tid; (void)lane; (void)wave;
            {
                const unsigned ldsb = (unsigned)__builtin_amdgcn_readfirstlane((int)(unsigned)(size_t)lds);
                unsigned soff[4];
#pragma unroll
                for (int p = 0; p < 4; ++p) { const unsigned row = 4u * (unsigned)(wave * 4 + p) + ((unsigned)lane >> 4), pc = (unsigned)lane & 15u; soff[p] = 256u * row + 16u * (pc ^ (((row & 3u) << 2) | ((row >> 2) & 3u))); }
#define P2_DMA(u_, buf_) do { const char* ks_ = (const char*)(kb + (size_t)(u_) * 16384); const char* vs_ = (const char*)(vb + (size_t)(u_) * 16384); \
                    _Pragma("unroll") for (int p_ = 0; p_ < 4; ++p_) { glds16(ks_ + soff[p_], ldsb + (unsigned)((buf_) * 65536 + (wave * 4 + p_) * 1024)); \
                        glds16(vs_ + soff[p_], ldsb + (unsigned)((buf_) * 65536 + 32768 + (wave * 4 + p_) * 1024)); } } while (0)
                int buf = 0;
                if (rank < NH * NCH) P2_DMA(rank, 0);
                asm volatile("s_waitcnt vmcnt(0)" ::: "memory");
                for (int u = rank; u < NH * NCH; u += gsz, buf ^= 1) {
                    asm volatile("s_waitcnt vmcnt(4)" ::: "memory"); __builtin_amdgcn_s_barrier(); asm volatile("" ::: "memory");
                    if (u + gsz < NH * NCH) P2_DMA(u + gsz, buf ^ 1);
                    LAS unsigned char* kl = lds + buf * 65536; LAS unsigned char* vl2 = kl + 32768;
                    const int dt = wave >> 1, et0 = (wave & 1) * 2;
                    f32x16 acc0, acc1;
#pragma unroll
                    for (int r = 0; r < 16; ++r) { acc0[r] = 0.f; acc1[r] = 0.f; }
#pragma unroll
                    for (int ks = 0; ks < 8; ++ks) {
                        const bf16x8 A = cat4(tr_read(kl + tr_addr_nat(lane, dt, ks, 0)), tr_read(kl + tr_addr_nat(lane, dt, ks, 1)));
                        const bf16x8 B0 = cat4(tr_read(vl2 + tr_addr_nat(lane, et0, ks, 0)), tr_read(vl2 + tr_addr_nat(lane, et0, ks, 1)));
                        const bf16x8 B1 = cat4(tr_read(vl2 + tr_addr_nat(lane, et0 + 1, ks, 0)), tr_read(vl2 + tr_addr_nat(lane, et0 + 1, ks, 1)));
                        acc0 = __builtin_amdgcn_mfma_f32_32x32x16_bf16(A, B0, acc0, 0, 0, 0);
                        acc1 = __builtin_amdgcn_mfma_f32_32x32x16_bf16(A, B1, acc1, 0, 0, 0);
                    }
                    bf16* kvt = kvb + (size_t)u * 16384;
#pragma unroll
                    for (int s = 0; s < 2; ++s) {
                        *(GAS bf16x8*)(kvt + ((dt * 4 + et0) * 2 + s) * 512 + lane * 8) = pack_acc(acc0, s);
                        *(GAS bf16x8*)(kvt + ((dt * 4 + et0 + 1) * 2 + s) * 512 + lane * 8) = pack_acc(acc1, s);
                    }
                }
                asm volatile("s_waitcnt vmcnt(0)" ::: "memory"); __syncthreads();
#undef P2_DMA
            }
            for (int it = rank; it < NCH; it += gsz) {
                const int b = it >> 5, n = it & 31, gi = wave & 3, half = wave >> 2;
#pragma unroll 1
                for (int ps = 0; ps < 2; ++ps) {
                    const int s0 = n * 128 + half * 64 + ps * 32 + (lane >> 5) * 16, c0 = gi * 128 + (lane & 31) * 4;
                    if (gi == 0) pool_rows<2>(uwb, mix, b, s0, c0); else if (gi == 1) pool_rows<4>(uwb, mix, b, s0, c0); else if (gi == 2) pool_rows<8>(uwb, mix, b, s0, c0); else pool_rows<16>(uwb, mix, b, s0, c0);
                }
            }
            if (L > 0) {
                const GAS f32x4* ps = (const GAS f32x4*)(a.p + ((size_t)L * M + (size_t)batch * SEQ) * PLE);
                for (size_t i = (size_t)rank * 512 + tid; i < (size_t)SEQ * PLE / 8; i += (size_t)gsz * 512) {
                    const f32x4 v0 = ps[2 * i], v1 = ps[2 * i + 1];
                    ((GAS v4u*)pb)[i] = (v4u){pk2(v0[0], v0[1]), pk2(v0[2], v0[3]), pk2(v1[0], v1[1]), pk2(v1[2], v1[3])};
                }
            }
        }
        LBAR();


        if (PH(4)) { PHASE_ENV(); FRESH_TID(t_); const int tid = t_, lane = t_ & 63, wave = __builtin_amdgcn_readfirstlane(t_ >> 6); (void)tid; (void)lane; (void)wave;
        for (int c = rank * 512 + tid; c < NH * 4096; c += gsz * 512) {
            const int bh = c >> 12; const float cd = __builtin_amdgcn_exp2f(128.0f * lg2gamma(bh & 3));
            GAS v2u* base = (GAS v2u*)(kvb + (size_t)bh * NCH * 16384) + (c & 4095);
            v2u t[NCH];
#pragma unroll
            for (int n = 0; n < NCH; ++n) t[n] = base[(size_t)n * 4096];
            float r0 = 0.f, r1 = 0.f, r2 = 0.f, r3 = 0.f;
#pragma unroll
            for (int n = 0; n < NCH; ++n) {
                const v2u in = t[n];
                base[(size_t)n * 4096] = (v2u){pk2(r0, r1), pk2(r2, r3)};
                r0 = cd * (r0 + bf_lo(in[0])); r1 = cd * (r1 + bf_hi(in[0])); r2 = cd * (r2 + bf_lo(in[1])); r3 = cd * (r3 + bf_hi(in[1]));
            }
        }
        }
        LBAR();

        if (PH(5)) { PHASE_ENV(); FRESH_TID(t_); const int tid = t_, lane = t_ & 63, wave = __builtin_amdgcn_readfirstlane(t_ >> 6);
        LAS float* red = (LAS float*)(lds + SIDE_OFF);
        for (int u = rank; u < NH * NCH; u += gsz) {
            const int bh = u >> 5, n = u & 31, h = bh & 3, b = bh >> 2;
            const int qt = wave & 3, eh = wave >> 2, ql = lane & 31, hh = lane >> 5;
            const size_t tile = ((size_t)bh * SEQ + n * 128) * 128;
            {
                v4u rg[16];
#pragma unroll
                for (int ti = 0; ti < 4; ++ti) { const bf16* src = (ti == 0 ? kb : ti == 1 ? vb : ti == 2 ? qb : gb) + tile;
#pragma unroll
                    for (int i = 0; i < 4; ++i) rg[ti * 4 + i] = ((const GAS v4u*)src)[tid + 512 * i]; }
#pragma unroll
                for (int ti = 0; ti < 4; ++ti)
#pragma unroll
                    for (int i = 0; i < 4; ++i) { const unsigned c = tid + 512 * i; *(LAS v4u*)(lds + ti * 32768 + off_b(c >> 4, c & 15)) = rg[ti * 4 + i]; }
            }
            const bf16* stt = kvb + (size_t)u * 16384;
            bf16x8 sf[2][4][2];
#pragma unroll
            for (int ei = 0; ei < 2; ++ei)
#pragma unroll
                for (int dt = 0; dt < 4; ++dt)
#pragma unroll
                    for (int s = 0; s < 2; ++s) sf[ei][dt][s] = *(const GAS bf16x8*)(stt + ((dt * 4 + 2 * eh + ei) * 2 + s) * 512 + lane * 8);
            __syncthreads();
            LAS unsigned char* kzl = lds; LAS unsigned char* vl = lds + 32768; LAS unsigned char* qlds = lds + 65536; LAS unsigned char* glds = lds + 98304;
            bf16x8 qf[4][2];
            { const unsigned qrow = 32u * qt + (unsigned)ql;
#pragma unroll
              for (int dt = 0; dt < 4; ++dt)
#pragma unroll
                for (int s = 0; s < 2; ++s) { const v2u lo = *(const LAS v2u*)(qlds + off_b(qrow, 4 * dt + 2 * s) + 8 * hh), hi = *(const LAS v2u*)(qlds + off_b(qrow, 4 * dt + 2 * s + 1) + 8 * hh);
                    qf[dt][s] = __builtin_bit_cast(bf16x8, (v4u){lo[0], lo[1], hi[0], hi[1]}); } }
            bf16x8 pf[4][2];
#pragma unroll
            for (int kt = 0; kt < 4; ++kt) {
                if (kt <= qt) {
                    f32x16 sa;
#pragma unroll
                    for (int r = 0; r < 16; ++r) sa[r] = 0.f;
                    const unsigned krow = 32 * kt + ql;
#pragma unroll
                    for (int dt = 0; dt < 4; ++dt)
#pragma unroll
                        for (int s = 0; s < 2; ++s) {
                            const v2u lo = *(const LAS v2u*)(kzl + off_b(krow, 4 * dt + 2 * s) + 8 * hh), hi = *(const LAS v2u*)(kzl + off_b(krow, 4 * dt + 2 * s + 1) + 8 * hh);
                            sa = __builtin_amdgcn_mfma_f32_32x32x16_bf16(__builtin_bit_cast(bf16x8, (v4u){lo[0], lo[1], hi[0], hi[1]}), qf[dt][s], sa, 0, 0, 0); }
                    if (kt == qt) {
#pragma unroll
                        for (int r = 0; r < 16; ++r) sa[r] = (crow(r, hh) > ql) ? 0.f : sa[r];
                    }
                    pf[kt][0] = pack_acc(sa, 0); pf[kt][1] = pack_acc(sa, 1);
                } else { pf[kt][0] = (bf16x8){0, 0, 0, 0, 0, 0, 0, 0}; pf[kt][1] = (bf16x8){0, 0, 0, 0, 0, 0, 0, 0}; }
            }
            f32x16 oacc[2];
#pragma unroll
            for (int ei = 0; ei < 2; ++ei) {
                const int et = 2 * eh + ei; f32x16 o;
#pragma unroll
                for (int r = 0; r < 16; ++r) o[r] = 0.f;
#pragma unroll
                for (int kt = 0; kt < 4; ++kt) {
                    if (kt <= qt) {
#pragma unroll
                        for (int s = 0; s < 2; ++s) {
                            const bf16x8 vf = cat4(tr_read(vl + tr_addr_perm(lane, et, 2 * kt + s, 0)), tr_read(vl + tr_addr_perm(lane, et, 2 * kt + s, 1)));
                            o = __builtin_amdgcn_mfma_f32_32x32x16_bf16(vf, pf[kt][s], o, 0, 0, 0); }
                    }
                }
#pragma unroll
                for (int dt = 0; dt < 4; ++dt)
#pragma unroll
                    for (int s = 0; s < 2; ++s) o = __builtin_amdgcn_mfma_f32_32x32x16_bf16(sf[ei][dt][s], qf[dt][s], o, 0, 0, 0);
                oacc[ei] = o;
            }
            const float rsc = __builtin_amdgcn_exp2f((float)(32 * qt + ql - 127) * lg2gamma(h));
            float ss = 0.f;
#pragma unroll
            for (int ei = 0; ei < 2; ++ei)
#pragma unroll
                for (int r = 0; r < 16; ++r) { const float y = oacc[ei][r] * rsc; oacc[ei][r] = y; ss += y * y; }
            ss = add_xor32(ss);
            if (hh == 0) red[eh * 128 + 32 * qt + ql] = ss;
            __syncthreads();
            const float rn = rsqrtf((red[32 * qt + ql] + red[128 + 32 * qt + ql]) * (1.0f / 128.0f) + EPS);
            { const unsigned yrow = 32u * qt + (unsigned)ql;
#pragma unroll
              for (int ei = 0; ei < 2; ++ei)
#pragma unroll
                for (int rg = 0; rg < 4; ++rg) {
                    const unsigned e0 = 32u * (2 * eh + ei) + 8u * rg + 4u * hh, ch = e0 >> 3, sub = (e0 & 7u) * 2u;
                    const v2u gv = *(const LAS v2u*)(glds + off_b(yrow, ch) + sub);
                    float o[4];
#pragma unroll
                    for (int j = 0; j < 4; ++j) { const float gt = (j & 1) ? bf_hi(gv[j >> 1]) : bf_lo(gv[j >> 1]);
                        o[j] = gt * __builtin_amdgcn_rcpf(1.0f + __builtin_amdgcn_exp2f(-1.4426950408889634f * gt)) * (oacc[ei][4 * rg + j] * rn); }
                    *(LAS v2u*)(qlds + off_b(yrow, ch) + sub) = (v2u){pk2(o[0], o[1]), pk2(o[2], o[3])};
                } }
            __syncthreads();
            { bf16* orow = mix + ((size_t)b * SEQ + n * 128) * 1024 + h * 128;
#pragma unroll
              for (int i = 0; i < 4; ++i) { const unsigned c = tid + 512 * i, row = c >> 4, ch = c & 15; *(GAS v4u*)(orow + (size_t)row * 1024 + ch * 8) = *(const LAS v4u*)(qlds + off_b(row, ch)); } }
            __syncthreads();
        }
        }
        LBAR();

        }
        if (PH(6)) {
            PHASE_ENV(); const unsigned char* wl = ws + WS_W + (size_t)L * W_LAYER; (void)wl; FRESH_TID(ptid); pg8::Gemm g{mix, (const bf16*)(wl + WO_OUT), SEQ, D, D}; pg8::BatchOrder S; S.init(D, gsz, rank);
            pg8::EpiResid E{xb1, xb, ssqA};
            pg8::gemm_phase<pg8::EpiResid, pg8::BatchOrder, true, true>(lds, g, S, E, ptid);
        }
        LBAR();


#ifndef REP_P6
#define REP_P6 1
#endif
#pragma unroll 1
        for (int rep_ = 0; rep_ < REP_P6; ++rep_) {
        if (PH(7)) {
            PHASE_ENV(); const unsigned char* wl = ws + WS_W + (size_t)L * W_LAYER; (void)wl; FRESH_TID(ptid); pg8::Gemm g{xb, (const bf16*)(wl + WO_GU), SEQ, 2 * FF, D}; pg8::BatchOrder S; S.init(2 * FF, gsz, rank);
            PG8_LAS float* side = (PG8_LAS float*)(lds + SIDE_OFF); pg8::fill_rstd(S, ssqA, side, (const int*)nullptr, (PG8_LAS float*)nullptr, ptid); __syncthreads();
            pg8::EpiSwiGLU E{side, hmid};
            pg8::gemm_phase<pg8::EpiSwiGLU, pg8::BatchOrder, true, true>(lds, g, S, E, ptid);
        }
        LBAR();

        }
        if (PH(8)) {
            PHASE_ENV(); const unsigned char* wl = ws + WS_W + (size_t)L * W_LAYER; (void)wl; FRESH_TID(ptid); pg8::Gemm g{hmid, (const bf16*)(wl + WO_DOWN), SEQ, D, FF}; pg8::BatchOrder S; S.init(D, gsz, rank);
            pg8::EpiResid E{xb, xb, ssqA};
            pg8::gemm_phase<pg8::EpiResid, pg8::BatchOrder, true, true>(lds, g, S, E, ptid);
        }
#ifndef REP_PE
#define REP_PE 1
#endif
#pragma unroll 1
        for (int rep_ = 0; rep_ < REP_PE; ++rep_)
        if (PH(9)) {
            PHASE_ENV(); const unsigned char* wl = ws + WS_W + (size_t)L * W_LAYER; (void)wl; FRESH_TID(ptid); pg8::Gemm g{pb, (const bf16*)(wl + WO_PP), SEQ, D, PLE}; pg8::BatchOrder S; S.init(D, gsz, rank);
            pg8::EpiPlain E{eb, D};
            pg8::gemm_phase<pg8::EpiPlain, pg8::BatchOrder, true, true>(lds, g, S, E, ptid);
        }
        LBAR();

        if (PH(10)) {
            PHASE_ENV(); const unsigned char* wl = ws + WS_W + (size_t)L * W_LAYER; (void)wl; FRESH_TID(ptid); pg8::Gemm g{xb, (const bf16*)(wl + WO_PG), SEQ, D, D}; pg8::BatchOrder S; S.init(D, gsz, rank);
            PG8_LAS float* side = (PG8_LAS float*)(lds + SIDE_OFF); pg8::fill_rstd(S, ssqA, side, (const int*)nullptr, (PG8_LAS float*)nullptr, ptid); __syncthreads();
            pg8::EpiPle E{side, eb, xb, xb1, ssqB};
            pg8::gemm_phase<pg8::EpiPle, pg8::BatchOrder, true, true>(lds, g, S, E, ptid);
        }
        LBAR();
    }

    if (PH(11)) { PHASE_ENV(); FRESH_TID(t_); const int lane = t_ & 63, gw = rank * NWAVES + __builtin_amdgcn_readfirstlane(t_ >> 6);
        const unsigned tmo = __hip_atomic_load((unsigned*)(ws + WS_CTL) + CW_BAR + XB_TMO, RLX_AGENT);
        for (int m = gw; m < SEQ; m += gsz * NWAVES) {
            float s = (lane < 16) ? ssqB[(size_t)m * 16 + lane] : 0.f; s = wave_sum(s);
            float rs = rsqrtf(s * (1.0f / 1024.0f) + EPS); if (tmo) rs = __builtin_nanf("");
#pragma unroll
            for (int j = 0; j < 2; ++j) { const v4u w = ((const GAS v4u*)(xb1 + (size_t)m * D))[lane + 64 * j]; const GAS f32x4* gp = (const GAS f32x4*)(a.g_final + (lane + 64 * j) * 8);
                f32x4 v0, v1; pg8::unpack8(w, v0, v1); GAS f32x4* op = (GAS f32x4*)(a.out + ((size_t)batch * SEQ + m) * D + (lane + 64 * j) * 8);
                op[0] = v0 * rs * gp[0]; op[1] = v1 * rs * gp[1]; }
        }
    }
}

extern "C" void kernel_launch(void* const* d_in, const int* in_sizes, int n_in, void* d_out, int out_size, void* d_ws, size_t ws_size, hipStream_t stream) {
    static int grid = 0;
    if (grid == 0) {
        if (n_in != 16 || in_sizes[0] != M * D || out_size != M * D || ws_size < WS_END) { fprintf(stderr, "kernel_launch: unexpected shapes (n_in %d, in0 %d, out %d, ws %zu < %zu)\n", n_in, n_in > 0 ? in_sizes[0] : -1, out_size, ws_size, (size_t)WS_END); grid = -1; return; }
        int dev = 0, cus = 0, per_cu = 0;
        if (hipGetDevice(&dev) != hipSuccess || hipDeviceGetAttribute(&cus, hipDeviceAttributeMultiprocessorCount, dev) != hipSuccess) { grid = -1; return; }
        if (hipFuncSetAttribute((const void*)fwd, hipFuncAttributeMaxDynamicSharedMemorySize, LDS_BYTES) != hipSuccess) { fprintf(stderr, "kernel_launch: hipFuncSetAttribute failed\n"); grid = -1; return; }
        if (hipOccupancyMaxActiveBlocksPerMultiprocessor(&per_cu, (const void*)fwd, NWAVES * 64, LDS_BYTES) != hipSuccess || per_cu < 1) fprintf(stderr, "kernel_launch: occupancy query reports %d\n", per_cu);
        (void)hipGetLastError();
        grid = cus;
    }
    if (grid < 0) return;
    if (hipMemsetAsync((char*)d_ws + WS_CTL, 0, CTL_ZERO_BYTES, stream) != hipSuccess) return;
    Args a{};
    a.x = (const float*)d_in[0]; a.p = (const float*)d_in[1]; a.pos = (const int*)d_in[2]; a.g_mix = (const float*)d_in[3]; a.w_in = (const float*)d_in[4]; a.pool_w = (const float*)d_in[5];
    a.pool_scale = (const float*)d_in[6]; a.w_out = (const float*)d_in[7]; a.g_ffn = (const float*)d_in[8]; a.w_gate = (const float*)d_in[9]; a.w_up = (const float*)d_in[10]; a.w_down = (const float*)d_in[11];
    a.g_ple = (const float*)d_in[12]; a.w_ple_gate = (const float*)d_in[13]; a.w_ple_proj = (const float*)d_in[14]; a.g_final = (const float*)d_in[15]; a.out = (float*)d_out; a.ws = (unsigned char*)d_ws;
    hipLaunchKernelGGL(fwd, dim3(grid), dim3(NWAVES * 64), LDS_BYTES, stream, a);
}
```

```cpp
#include <hip/hip_runtime.h>
#include <cstdio>
#include <cstdint>
namespace pg8 {
#define PG8_LAS __attribute__((address_space(3)))
typedef unsigned short bf16_t;
typedef short bf16x8 __attribute__((ext_vector_type(8)));
typedef float f32x4 __attribute__((ext_vector_type(4)));
typedef unsigned u32x4 __attribute__((ext_vector_type(4)));
constexpr int BM = 256, BK = 64, HALF = 128, HTB = HALF * BK * 2  , STAGE_BYTES = 8 * HTB, NXCD = 8, WGM = 8;

__host__ __device__ __forceinline__ int lds_byte(int r, int c) { const int st = (r >> 4) * 2 + (c >> 5), rr = r & 15, cc = c & 31, ob = rr * 64 + cc * 2; return st * 1024 + (ob ^ (((ob >> 9) & 1) << 5)); }
__host__ __device__ __forceinline__ void stage_rc(int b, int& R, int& C) { const int st = b / 1024, sb = b % 1024, swz = sb ^ (((sb >> 9) & 1) << 5); R = (st >> 1) * 16 + swz / 64; C = (st & 1) * 32 + (swz % 64) / 2; }
__host__ __device__ __forceinline__ int perm32(int rho) { const int n = rho >> 4, i = rho & 15; return 8 * (i >> 2) + 4 * n + (i & 3); }

struct Unit { int pm, pn; };
struct Gemm { const bf16_t* A; const bf16_t* Bt; int M, N, K; };

struct StaticOrder {
    int nM, nN, nwg, G, c;
    __host__ __device__ void init(int M, int N, int G_, int c_) { nM = M / BM; nN = N / BM; nwg = nM * nN; G = G_; c = c_; }
    __host__ __device__ bool next(int i, Unit& u) const {
        const long L = (long)i * G + c; if (L >= nwg) return false;
        int wgid = (int)L; { const int q = nwg / NXCD, r = nwg % NXCD, xcd = wgid % NXCD, off = wgid / NXCD; wgid = (xcd < r ? xcd * (q + 1) : r * (q + 1) + (xcd - r) * q) + off; }
        const int nig = WGM * nN, gid = wgid / nig, fm = gid * WGM, gsz = (nM - fm) < WGM ? (nM - fm) : WGM;
        u.pm = fm + ((wgid % nig) % gsz); u.pn = (wgid % nig) / gsz; return true;
    }
    __device__ __forceinline__ void a_ready(const Unit&) const {}
    __device__ __forceinline__ void done(const Unit&) const {}
};

typedef float f32x2_t __attribute__((ext_vector_type(2))); typedef __bf16 bf16x2_t __attribute__((ext_vector_type(2)));
__device__ __forceinline__ unsigned cvt_pk_bf16(float lo, float hi) { f32x2_t v = {lo, hi}; bf16x2_t b = __builtin_convertvector(v, bf16x2_t); return __builtin_bit_cast(unsigned, b); }
template <class Epi, class Sched, bool ALIGN_EPI = false, bool SP2 = false>
__device__ __forceinline__ void gemm_phase(PG8_LAS unsigned char* lds, const Gemm g, const Sched& S, const Epi& E, const int tid_in) {
    const int tid = tid_in, wid = __builtin_amdgcn_readfirstlane(tid >> 6), lane = tid & 63, wr = wid >> 2, wc = wid & 3, fr = lane & 15, fq = lane >> 4;
    const int K = g.K, nt = K / BK;
    unsigned voffA[2], voffB[2];
#pragma unroll
    for (int i = 0; i < 2; ++i) { int R, C; stage_rc(tid * 16 + i * 8192, R, C); const int Rb = Epi::PERM ? ((R & ~31) + perm32(R & 31)) : R;
        voffA[i] = (unsigned)(R * K + C) * 2u; voffB[i] = (unsigned)(Rb * K + C) * 2u; }
    const size_t kstep = (size_t)(BK * 2);
    const size_t hstep = (size_t)HALF * K * 2;
    const size_t tstep = 2 * hstep;
    const unsigned ldsw = (unsigned)wid * 1024u;
    const int aoff = lds_byte(wr * 64 + fr, fq * 8), boff = lds_byte(wc * 32 + fr, fq * 8);
#define PG8_SA(b, h) (((b) * 2 + (h)) * HTB)
#define PG8_SB(b, h) ((4 + (b) * 2 + (h)) * HTB)
#define PG8_STAGE(bufoff, gbase, voff) do { _Pragma("unroll") for (int _i = 0; _i < 2; ++_i) \
        __builtin_amdgcn_global_load_lds((const unsigned*)((const char*)(gbase) + (voff)[_i]), (PG8_LAS unsigned*)(lds + (bufoff) + ldsw + _i * 8192), 16, 0, 0); } while (0)
#define PG8_LDA(dst, b, h) do { _Pragma("unroll") for (int m = 0; m < 4; ++m) _Pragma("unroll") for (int k = 0; k < 2; ++k) dst[m][k] = *(const PG8_LAS bf16x8*)(lds + PG8_SA(b, h) + aoff + m * 2048 + k * 1024); } while (0)
#define PG8_LDB(dst, b, h) do { _Pragma("unroll") for (int n = 0; n < 2; ++n) _Pragma("unroll") for (int k = 0; k < 2; ++k) dst[n][k] = *(const PG8_LAS bf16x8*)(lds + PG8_SB(b, h) + boff + n * 2048 + k * 1024); } while (0)
#define PG8_MMA(ai, bj, At, Bt) do { __builtin_amdgcn_s_setprio(1); _Pragma("unroll") for (int m = 0; m < 4; ++m) _Pragma("unroll") for (int n = 0; n < 2; ++n) _Pragma("unroll") for (int k = 0; k < 2; ++k) \
        acc[ai][bj][m][n] = __builtin_amdgcn_mfma_f32_16x16x32_bf16(Bt[n][k], At[m][k], acc[ai][bj][m][n], 0, 0, 0); __builtin_amdgcn_s_setprio(0); } while (0)
#define PG8_WAIT_V(n) asm volatile("s_waitcnt vmcnt(" #n ")" ::: "memory")
#define PG8_WAIT_L(n) asm volatile("s_waitcnt lgkmcnt(" #n ")" ::: "memory")
#define PG8_BAR __builtin_amdgcn_s_barrier()
#define PG8_SCHED __builtin_amdgcn_sched_barrier(0)
    Unit cur, nxt; int ui = 0;
    if (!S.next(0, cur)) return;
    f32x4 acc[2][2][4][2];
    E.init(acc, cur, wr, wc, fr, fq);
    bf16x8 At[4][2], B0[2][2], B1[2][2];
    const char* cA = (const char*)g.A + (size_t)cur.pm * tstep; const char* cB = (const char*)g.Bt + (size_t)cur.pn * tstep;
    S.a_ready(cur);
    if constexpr (SP2) {
        PG8_STAGE(PG8_SB(0, 0), cB, voffB); PG8_STAGE(PG8_SB(0, 1), cB + hstep, voffB); PG8_STAGE(PG8_SA(0, 0), cA, voffA); PG8_STAGE(PG8_SA(0, 1), cA + hstep, voffA);
        if (wr == 1) PG8_BAR;
        PG8_WAIT_V(2); PG8_BAR;
        PG8_STAGE(PG8_SB(1, 0), cB + kstep, voffB); PG8_STAGE(PG8_SA(1, 0), cA + kstep, voffA); PG8_STAGE(PG8_SB(1, 1), cB + hstep + kstep, voffB);
        PG8_WAIT_V(6); PG8_BAR;
    } else {
        PG8_STAGE(PG8_SB(0, 0), cB, voffB); PG8_STAGE(PG8_SA(0, 0), cA, voffA); PG8_STAGE(PG8_SB(0, 1), cB + hstep, voffB); PG8_STAGE(PG8_SA(0, 1), cA + hstep, voffA);
        if (wr == 1) PG8_BAR;
        PG8_WAIT_V(4); PG8_BAR;
        PG8_STAGE(PG8_SB(1, 0), cB + kstep, voffB); PG8_STAGE(PG8_SA(1, 0), cA + kstep, voffA); PG8_STAGE(PG8_SB(1, 1), cB + hstep + kstep, voffB);
        PG8_WAIT_V(6); PG8_BAR;
    }
    for (;;) {
        const bool has_next = S.next(ui + 1, nxt);
        const char* nA = has_next ? (const char*)g.A + (size_t)nxt.pm * tstep : cA; const char* nB = has_next ? (const char*)g.Bt + (size_t)nxt.pn * tstep : cB;
#pragma unroll 1
        for (int t = 0; t < nt; t += 2) {
            const bool last = (t == nt - 2);
            const char* a1 = cA + (size_t)(t + 1) * kstep;
            const char* a2 = last ? nA : cA + (size_t)(t + 2) * kstep; const char* b2 = last ? nB : cB + (size_t)(t + 2) * kstep;
            const char* a3 = a2 + kstep; const char* b3 = b2 + kstep;
            if (last && has_next) S.a_ready(nxt);
            if constexpr (SP2) {
            PG8_LDB(B0, 0, 0); PG8_LDB(B1, 0, 1); PG8_SCHED; PG8_LDA(At, 0, 0); PG8_STAGE(PG8_SA(1, 1), a1 + hstep, voffA);
            PG8_WAIT_V(8); PG8_WAIT_L(0); PG8_BAR; PG8_MMA(0, 0, At, B0); PG8_MMA(0, 1, At, B1); PG8_BAR; PG8_SCHED;
            PG8_LDA(At, 0, 1); PG8_STAGE(PG8_SB(0, 0), b2, voffB); PG8_STAGE(PG8_SB(0, 1), b2 + hstep, voffB); PG8_STAGE(PG8_SA(0, 0), a2, voffA);
            PG8_WAIT_V(8); PG8_WAIT_L(0); PG8_BAR; PG8_MMA(1, 0, At, B0); PG8_MMA(1, 1, At, B1); PG8_BAR; PG8_SCHED;
            PG8_LDB(B0, 1, 0); PG8_LDB(B1, 1, 1); PG8_SCHED; PG8_LDA(At, 1, 0); PG8_STAGE(PG8_SA(0, 1), a2 + hstep, voffA);
            PG8_WAIT_V(8); PG8_WAIT_L(0); PG8_BAR; PG8_MMA(0, 0, At, B0); PG8_MMA(0, 1, At, B1); PG8_BAR; PG8_SCHED;
            PG8_LDA(At, 1, 1); PG8_STAGE(PG8_SB(1, 0), b3, voffB); PG8_STAGE(PG8_SB(1, 1), b3 + hstep, voffB); PG8_STAGE(PG8_SA(1, 0), a3, voffA);
            PG8_WAIT_V(8); PG8_WAIT_L(0); PG8_BAR; PG8_MMA(1, 0, At, B0); PG8_MMA(1, 1, At, B1); PG8_BAR; PG8_SCHED;
            } else {
            PG8_LDB(B0, 0, 0); PG8_SCHED; PG8_LDA(At, 0, 0); PG8_STAGE(PG8_SA(1, 1), a1 + hstep, voffA);
            PG8_WAIT_L(8); PG8_BAR; PG8_WAIT_L(0); PG8_MMA(0, 0, At, B0); PG8_BAR; PG8_SCHED;
            PG8_LDB(B1, 0, 1); PG8_STAGE(PG8_SB(0, 0), b2, voffB);
            PG8_BAR; PG8_WAIT_L(0); PG8_MMA(0, 1, At, B1); PG8_BAR;
            PG8_LDA(At, 0, 1); PG8_STAGE(PG8_SA(0, 0), a2, voffA);
            PG8_BAR; PG8_WAIT_L(0); PG8_MMA(1, 0, At, B0); PG8_BAR; PG8_SCHED;
            PG8_STAGE(PG8_SB(0, 1), b2 + hstep, voffB);
            PG8_WAIT_V(6); PG8_BAR; PG8_MMA(1, 1, At, B1); PG8_BAR;
            PG8_LDB(B0, 1, 0); PG8_SCHED; PG8_LDA(At, 1, 0); PG8_STAGE(PG8_SA(0, 1), a2 + hstep, voffA);
            PG8_WAIT_L(8); PG8_BAR; PG8_WAIT_L(0); PG8_MMA(0, 0, At, B0); PG8_BAR; PG8_SCHED;
            PG8_LDB(B1, 1, 1); PG8_STAGE(PG8_SB(1, 0), b3, voffB);
            PG8_BAR; PG8_WAIT_L(0); PG8_MMA(0, 1, At, B1); PG8_BAR;
            PG8_LDA(At, 1, 1); PG8_STAGE(PG8_SA(1, 0), a3, voffA);
            PG8_BAR; PG8_WAIT_L(0); PG8_MMA(1, 0, At, B0); PG8_BAR; PG8_SCHED;
            PG8_STAGE(PG8_SB(1, 1), b3 + hstep, voffB);
            PG8_WAIT_V(6); PG8_BAR; PG8_MMA(1, 1, At, B1); PG8_BAR;
            }
        }
        if constexpr (ALIGN_EPI) { if (wr == 0) PG8_BAR; }
        if constexpr (!Epi::AFTER_DRAIN) { E(acc, cur, wr, wc, fr, fq, ui); S.done(cur); }
        if (!has_next) break;
        E.init(acc, nxt, wr, wc, fr, fq);
        cur = nxt; cA = nA; cB = nB; ++ui;
        if constexpr (ALIGN_EPI) { if (wr == 1) PG8_BAR; }
    }
    PG8_WAIT_V(0);
    if constexpr (!ALIGN_EPI) { if (wr == 0) PG8_BAR; }
    PG8_BAR;
    if constexpr (Epi::AFTER_DRAIN) { E.fused(acc, cur, wr, wc, fr, fq, lds, wid, lane); S.done(cur); }
#undef PG8_SA
#undef PG8_SB
#undef PG8_STAGE
#undef PG8_LDA
#undef PG8_LDB
#undef PG8_MMA
#undef PG8_WAIT_V
#undef PG8_WAIT_L
#undef PG8_BAR
#undef PG8_SCHED
}
}

constexpr int BATCH = 8, SEQ = 4096, D = 1024, DEPTH = 4, M = BATCH * SEQ;
constexpr int NH = 4, DH = 128, RW = 512, CHUNK = 128, NCH = SEQ / CHUNK;
constexpr int INW = 2560, FF = 2816, PLE = 256;
constexpr float EPS = 1e-6f;
constexpr int NWAVES = 8;

constexpr size_t MiB = 1u << 20;
constexpr size_t WS_CTL = 0, CTL_ZERO_BYTES = 1 * MiB;
constexpr size_t WS_SSQA = 1 * MiB, WS_SSQB = 3 * MiB;
constexpr size_t WS_W = 8 * MiB, W_LAYER = 26 * MiB;
constexpr size_t WO_IN = 0, WO_OUT = 5 * MiB, WO_GU = 7 * MiB, WO_DOWN = 18 * MiB, WO_PG = 18 * MiB + 5632 * 1024, WO_PP = WO_PG + 2 * MiB;
static_assert(WO_PP + 512 * 1024 == W_LAYER, "weight map");
constexpr size_t WS_XB = 112 * MiB;
constexpr size_t WS_PB = 176 * MiB;
constexpr size_t WS_R = 192 * MiB;
constexpr size_t R_BATCH = 32 * MiB;
constexpr size_t R_Q = 0, R_K = 4 * MiB, R_V = 8 * MiB, R_G = 12 * MiB, R_UW = 16 * MiB, R_KV = 20 * MiB, R_MIX = 24 * MiB;
constexpr size_t R_H = 0, R_E = 24 * MiB, R_UT = 0;
constexpr size_t WS_XB1 = WS_R + 256 * MiB;
constexpr size_t WS_END = WS_XB1 + 64 * MiB;
static_assert((size_t)SEQ * FF * 2 <= R_MIX && R_MIX + (size_t)SEQ * D * 2 == R_BATCH, "per-batch scratch map");
constexpr int CW_BAR = 4096;

constexpr int RING_BYTES = 131072;
constexpr int LDSCTL_OFF = RING_BYTES, MISC_OFF = LDSCTL_OFF + 320;
constexpr int SIDE_OFF = LDSCTL_OFF + 1024;
constexpr int LDS_BYTES = 147456;

#define GAS __attribute__((address_space(1)))
#define LAS __attribute__((address_space(3)))
typedef unsigned short bf16;
typedef unsigned v4u __attribute__((ext_vector_type(4)));
typedef unsigned v2u __attribute__((ext_vector_type(2)));
typedef float f32x4 __attribute__((ext_vector_type(4)));
typedef float f32x16 __attribute__((ext_vector_type(16)));
typedef short bf16x8 __attribute__((ext_vector_type(8)));
typedef short s16x4 __attribute__((ext_vector_type(4)));
typedef GAS unsigned gu32;
#define RLX_AGENT __ATOMIC_RELAXED, __HIP_MEMORY_SCOPE_AGENT
#define LDS_WAIT() asm volatile("s_waitcnt lgkmcnt(0)" ::: "memory")
#define VM_WAIT() asm volatile("s_waitcnt vmcnt(0)" ::: "memory")
__device__ __forceinline__ unsigned f2bf(float f) { unsigned u = __builtin_bit_cast(unsigned, f); return (u + 0x7fffu + ((u >> 16) & 1u)) >> 16; }
__device__ __forceinline__ unsigned pk2(float lo, float hi) { return f2bf(lo) | (f2bf(hi) << 16); }
__device__ __forceinline__ float bf_lo(unsigned w) { return __builtin_bit_cast(float, w << 16); }
__device__ __forceinline__ float bf_hi(unsigned w) { return __builtin_bit_cast(float, w & 0xffff0000u); }

__device__ const float ROPE_HI[64] = {1.591186523e-01f, 1.378173828e-01f, 1.193237305e-01f, 1.033325195e-01f, 8.947753906e-02f, 7.748413086e-02f, 6.710815430e-02f, 5.810546875e-02f, 5.032348633e-02f, 4.357910156e-02f, 3.773498535e-02f, 3.266906738e-02f, 2.829742432e-02f, 2.450561523e-02f, 2.121734619e-02f, 1.837158203e-02f, 1.591491699e-02f, 1.377868652e-02f, 1.193237305e-02f, 1.033401489e-02f, 8.949279785e-03f, 7.749557495e-03f, 6.710052490e-03f, 5.811691284e-03f, 5.031585693e-03f, 4.358291626e-03f, 3.773689270e-03f, 3.268241882e-03f, 2.829551697e-03f, 2.449989319e-03f, 2.121925354e-03f, 1.837730408e-03f, 1.591205597e-03f, 1.378059387e-03f, 1.193046570e-03f, 1.033306122e-03f, 8.947849274e-04f, 7.748603821e-04f, 6.711483002e-04f, 5.810260773e-04f, 5.030632019e-04f, 4.358291626e-04f, 3.772974014e-04f, 3.267526627e-04f, 2.830028534e-04f, 2.449750900e-04f, 2.121925354e-04f, 1.837611198e-04f, 1.591444016e-04f, 1.378059387e-04f, 1.193284988e-04f, 1.033246517e-04f, 8.949637413e-05f, 7.748603821e-05f, 6.711483002e-05f, 5.811452866e-05f, 5.032122135e-05f, 4.357099533e-05f, 3.772974014e-05f, 3.267824650e-05f, 2.829730511e-05f, 2.450495958e-05f, 2.121925354e-05f, 1.837313175e-05f};
__device__ const float ROPE_LO[64] = {3.629074854e-05f, 5.119791695e-06f, 2.563974340e-05f, 1.977708780e-05f, 2.186254642e-05f, 1.915789653e-05f, 6.928708444e-06f, 1.379869173e-05f, 5.725776191e-06f, 4.200542662e-06f, 6.599365861e-06f, 1.379848982e-05f, 4.771514341e-06f, 3.076627763e-06f, 6.306573596e-06f, 7.344074220e-06f, 5.773169960e-07f, 3.563736982e-06f, 2.563974249e-06f, 1.214769213e-06f, 6.603757470e-07f, 7.713804280e-07f, 1.455810320e-06f, 2.354600070e-07f, 1.335517140e-06f, 3.858455244e-08f, 4.692017228e-07f, 4.470491177e-08f, 6.678862974e-07f, 8.798673434e-07f, 4.399224736e-07f, 1.622028520e-07f, 3.438339888e-07f, 1.656388378e-07f, 4.471322939e-07f, 2.168443558e-07f, 2.090887250e-07f, 1.725054801e-07f, 2.529881415e-09f, 1.665971467e-07f, 2.289191343e-07f, 3.858455333e-09f, 1.184457474e-07f, 7.599606278e-08f, 1.910491321e-08f, 1.118285908e-07f, 4.399224807e-08f, 2.814121380e-08f, 1.054154186e-08f, 1.656388271e-08f, 2.087137041e-08f, 2.764489970e-08f, 3.027478712e-09f, 1.725054766e-08f, 2.529881304e-10f, 4.738785808e-09f, 7.990752948e-09f, 1.230677427e-08f, 1.184457421e-08f, 4.619374216e-09f, 4.890723382e-09f, 3.732278930e-09f, 4.399224540e-09f, 5.794353886e-09f};
__device__ __forceinline__ float lg2gamma(int h) { return h == 0 ? -0.04580368961312479f : h == 1 ? -0.02272007650008353f : h == 2 ? -0.011315313227834146f : -0.005646563141142063f; }

__device__ __forceinline__ float add_xor16(float v) { return v + __builtin_bit_cast(float, __builtin_amdgcn_ds_swizzle(__builtin_bit_cast(int, v), 0x401F)); }
__device__ __forceinline__ float add_xor32(float v) { float a_ = v, b_ = v; asm volatile("s_nop 1\n\tv_permlane32_swap_b32 %0, %1" : "+v"(a_), "+v"(b_)); return a_ + b_; }
namespace pg8 {
#ifndef BO_GRP
#define BO_GRP 8
#endif
struct BatchOrder {
    int nN, gsize, rank, nwg;
    __device__ __forceinline__ void init(int N, int gsize_, int rank_) { nN = N / BM; gsize = gsize_; rank = rank_; nwg = 16 * nN; }
    __device__ __forceinline__ bool next(int i, Unit& u) const {
        const int L = i * gsize + rank; if (L >= nwg) return false;
#if defined(BO_ORDER) && BO_ORDER == 1
        const int nb = nN >> 2;
        if (L < nb * 64) { const int q = L >> 6, r = L & 63, g = r >> 5, w = r & 31; u.pm = 8 * g + (w & 7); u.pn = 4 * q + (w >> 3); }
        else { const int Lt = L - nb * 64, rem = nN - 4 * nb, g = Lt / (8 * rem), w = Lt - g * 8 * rem; u.pm = 8 * g + (w & 7); u.pn = 4 * nb + (w >> 3); }
        return true;
#else
        const int grp = L / (BO_GRP * nN), r = L - grp * BO_GRP * nN; u.pm = BO_GRP * grp + (r % BO_GRP); u.pn = r / BO_GRP; return true;
#endif
    }
    __device__ __forceinline__ void a_ready(const Unit&) const {}
    __device__ __forceinline__ void done(const Unit&) const {}
};
__device__ __forceinline__ void load_rstd(const PG8_LAS float* side, int ui, int wr, int fr, float (&rs)[2][4]) {
#pragma unroll
    for (int ai = 0; ai < 2; ++ai)
#pragma unroll
        for (int m = 0; m < 4; ++m) rs[ai][m] = side[ui * 256 + ai * HALF + wr * 64 + m * 16 + fr];
}
template <class Sched> __device__ __forceinline__ void fill_rstd(const Sched& S, const float* ssq, PG8_LAS float* side, const int* pos, PG8_LAS float* posf, int tid) {
    Unit u;
    for (int i = 0; S.next(i, u); ++i) {
        const int row = u.pm * BM + (tid >> 1), hf = tid & 1;
        const f32x4 a = *(const f32x4*)(ssq + (size_t)row * 16 + 8 * hf), b = *(const f32x4*)(ssq + (size_t)row * 16 + 8 * hf + 4);
        float s = ((a[0] + a[1]) + (a[2] + a[3])) + ((b[0] + b[1]) + (b[2] + b[3]));
        s += __builtin_bit_cast(float, __builtin_amdgcn_ds_swizzle(__builtin_bit_cast(int, s), 0x041F));
        if (hf == 0) { side[i * 256 + (tid >> 1)] = rsqrtf(s * (1.0f / 1024.0f) + 1e-6f); if (pos) posf[i * 256 + (tid >> 1)] = (float)pos[row]; }
    }
}
#ifndef WTM
#define WTM 0
#endif
template <int BIT> __device__ __forceinline__ void st16(void* p, const u32x4 v) {
    if constexpr ((WTM >> BIT) & 1) asm volatile("global_store_dwordx4 %0, %1, off sc1\n\ts_nop 0" :: "v"(p), "v"(v) : "memory");
    else *(u32x4*)p = v;
}
__device__ __forceinline__ u32x4 pack8(const f32x4 a, const f32x4 b) { u32x4 w; w.x = cvt_pk_bf16(a[0], a[1]); w.y = cvt_pk_bf16(a[2], a[3]); w.z = cvt_pk_bf16(b[0], b[1]); w.w = cvt_pk_bf16(b[2], b[3]); return w; }

struct EpiInProj {
    static constexpr bool PERM = true, AFTER_DRAIN = false;
    const PG8_LAS float* side; const PG8_LAS float* posf; const PG8_LAS float* rope; bf16_t *q, *k, *v, *g, *uw;
    __device__ __forceinline__ void init(f32x4 (&acc)[2][2][4][2], const Unit&, int, int, int, int) const {
#pragma unroll
        for (int a = 0; a < 2; ++a)
#pragma unroll
            for (int b = 0; b < 2; ++b)
#pragma unroll
                for (int m = 0; m < 4; ++m)
#pragma unroll
                    for (int n = 0; n < 2; ++n) acc[a][b][m][n] = (f32x4){0.f, 0.f, 0.f, 0.f};
    }
    __device__ __forceinline__ void operator()(const f32x4 (&acc)[2][2][4][2], const Unit& u, int wr, int wc, int fr, int fq, int ui) const {
        const int rowbase = u.pm * BM + wr * 64 + fr;
        float rs[2][4]; load_rstd(side, ui, wr, fr, rs);
        if (u.pn < 4) {
            const int sec = u.pn >> 1, head = 2 * (u.pn & 1) + (wc >> 1), dd0 = 32 * (wc & 1) + 8 * fq;
            bf16_t* dst = sec ? k : q;
            const f32x4 h0 = *(const PG8_LAS f32x4*)(rope + dd0), h1 = *(const PG8_LAS f32x4*)(rope + dd0 + 4), l0 = *(const PG8_LAS f32x4*)(rope + 64 + dd0), l1 = *(const PG8_LAS f32x4*)(rope + 64 + dd0 + 4);
            const float lg = lg2gamma(head);
#pragma unroll
            for (int ai = 0; ai < 2; ++ai)
#pragma unroll
                for (int m = 0; m < 4; ++m) {
                    const int row = rowbase + ai * HALF + m * 16, b = row >> 12, s = row & 4095;
                    const float p = posf[ui * 256 + ai * HALF + wr * 64 + m * 16 + fr];
                    const float sc = rs[ai][m] * (sec ? __builtin_amdgcn_exp2f((float)(127 - (s & 127)) * lg) : 1.0f);
                    f32x4 o1[2], o2[2];
#pragma unroll
                    for (int n = 0; n < 2; ++n) { const f32x4 fh = n ? h1 : h0, fl = n ? l1 : l0;
#pragma unroll
                        for (int j = 0; j < 4; ++j) { const float ph = p * fh[j]; const float rev = (ph - __builtin_floorf(ph)) + p * fl[j];
                            const float cs = __builtin_amdgcn_cosf(rev), sn = __builtin_amdgcn_sinf(rev);
                            const float x1 = acc[ai][0][m][n][j] * sc, x2 = acc[ai][1][m][n][j] * sc;
                            o1[n][j] = x1 * cs - x2 * sn; o2[n][j] = x2 * cs + x1 * sn; } }
                    bf16_t* rp = dst + ((size_t)((b * NH_ + head) * SEQ_ + s)) * 128 + dd0;
                    st16<0>(rp, pack8(o1[0], o1[1])); st16<0>((rp + 64), pack8(o2[0], o2[1]));
                    asm volatile("" ::: "memory");
                }
        } else {
            const int sec = (u.pn - 4) >> 1;
            const int c0 = 256 * (u.pn & 1) + 32 * wc + 8 * fq;
#pragma unroll
            for (int ai = 0; ai < 2; ++ai)
#pragma unroll
                for (int m = 0; m < 4; ++m) {
                    const int row = rowbase + ai * HALF + m * 16, b = row >> 12, s = row & 4095; const float sc = rs[ai][m];
#pragma unroll
                    for (int bj = 0; bj < 2; ++bj) { const u32x4 w = pack8(acc[ai][bj][m][0] * sc, acc[ai][bj][m][1] * sc); const int c = c0 + 128 * bj;
                        if (sec == 2) st16<0>((uw + (size_t)row * 512 + c), w);
                        else { bf16_t* dst = sec ? g : v; st16<0>((dst + ((size_t)((b * NH_ + (c >> 7)) * SEQ_ + s)) * 128 + (c & 127)), w); } }
                }
        }
    }
    static constexpr int NH_ = 4, SEQ_ = 4096;
};

__device__ __forceinline__ void unpack8(const u32x4 w, f32x4& a, f32x4& b) {
    a[0] = __builtin_bit_cast(float, w.x << 16); a[1] = __builtin_bit_cast(float, w.x & 0xffff0000u); a[2] = __builtin_bit_cast(float, w.y << 16); a[3] = __builtin_bit_cast(float, w.y & 0xffff0000u);
    b[0] = __builtin_bit_cast(float, w.z << 16); b[1] = __builtin_bit_cast(float, w.z & 0xffff0000u); b[2] = __builtin_bit_cast(float, w.w << 16); b[3] = __builtin_bit_cast(float, w.w & 0xffff0000u);
}
struct EpiResid {
    static constexpr bool PERM = true, AFTER_DRAIN = false;
    const bf16_t* xin; bf16_t* xout; float* ssq_out;
    __device__ __forceinline__ void init(f32x4 (&acc)[2][2][4][2], const Unit& u, int wr, int wc, int fr, int fq) const {
        const int rowbase = u.pm * BM + wr * 64 + fr, col0 = u.pn * BM + 32 * wc + 8 * fq;
        u32x4 w[2][4][2];
#pragma unroll
        for (int ai = 0; ai < 2; ++ai)
#pragma unroll
            for (int m = 0; m < 4; ++m)
#pragma unroll
                for (int bj = 0; bj < 2; ++bj) w[ai][m][bj] = *(const u32x4*)(xin + (size_t)(rowbase + ai * HALF + m * 16) * 1024 + col0 + bj * HALF);
#pragma unroll
        for (int ai = 0; ai < 2; ++ai)
#pragma unroll
            for (int m = 0; m < 4; ++m)
#pragma unroll
                for (int bj = 0; bj < 2; ++bj) unpack8(w[ai][m][bj], acc[ai][bj][m][0], acc[ai][bj][m][1]);
    }
    __device__ __forceinline__ void operator()(const f32x4 (&acc)[2][2][4][2], const Unit& u, int wr, int wc, int fr, int fq, int) const {
        const int rowbase = u.pm * BM + wr * 64 + fr, col0 = u.pn * BM + 32 * wc + 8 * fq;
#pragma unroll
        for (int ai = 0; ai < 2; ++ai)
#pragma unroll
            for (int m = 0; m < 4; ++m) {
                const int row = rowbase + ai * HALF + m * 16; const size_t off = (size_t)row * 1024 + col0; float ss = 0.f;
#pragma unroll
                for (int bj = 0; bj < 2; ++bj) {
                    const f32x4 v0 = acc[ai][bj][m][0], v1 = acc[ai][bj][m][1];
                    st16<1>((xout + off + bj * HALF), pack8(v0, v1));
                    ss += (v0[0] * v0[0] + v0[1] * v0[1]) + (v0[2] * v0[2] + v0[3] * v0[3]) + (v1[0] * v1[0] + v1[1] * v1[1]) + (v1[2] * v1[2] + v1[3] * v1[3]); }
                ss = add_xor32(add_xor16(ss));
                if (fq == 0) ssq_out[(size_t)row * 16 + u.pn * 4 + wc] = ss;
            }
    }
};

struct EpiSwiGLU {
    static constexpr bool PERM = true, AFTER_DRAIN = false;
    const PG8_LAS float* side; bf16_t* h;
    __device__ __forceinline__ void init(f32x4 (&acc)[2][2][4][2], const Unit&, int, int, int, int) const {
#pragma unroll
        for (int a = 0; a < 2; ++a)
#pragma unroll
            for (int b = 0; b < 2; ++b)
#pragma unroll
                for (int m = 0; m < 4; ++m)
#pragma unroll
                    for (int n = 0; n < 2; ++n) acc[a][b][m][n] = (f32x4){0.f, 0.f, 0.f, 0.f};
    }
    __device__ __forceinline__ void operator()(const f32x4 (&acc)[2][2][4][2], const Unit& u, int wr, int wc, int fr, int fq, int ui) const {
        const int rowbase = u.pm * BM + wr * 64 + fr, col0 = u.pn * HALF + 32 * wc + 8 * fq;
        float rs[2][4]; load_rstd(side, ui, wr, fr, rs);
#pragma unroll
        for (int ai = 0; ai < 2; ++ai)
#pragma unroll
            for (int m = 0; m < 4; ++m) { const float sc = rs[ai][m], c1 = -1.4426950408889634f * sc, sc2 = sc * sc; f32x4 o[2];
#pragma unroll
                for (int n = 0; n < 2; ++n)
#pragma unroll
                    for (int jp = 0; jp < 2; ++jp) { const f32x2_t av = {acc[ai][0][m][n][2 * jp], acc[ai][0][m][n][2 * jp + 1]}, bv = {acc[ai][1][m][n][2 * jp], acc[ai][1][m][n][2 * jp + 1]};
                        const f32x2_t t = av * c1; f32x2_t ex; ex.x = __builtin_amdgcn_exp2f(t.x); ex.y = __builtin_amdgcn_exp2f(t.y);
                        const f32x2_t d = ex + 1.0f; f32x2_t r; r.x = __builtin_amdgcn_rcpf(d.x); r.y = __builtin_amdgcn_rcpf(d.y);
                        const f32x2_t ov = (av * bv) * (r * sc2); o[n][2 * jp] = ov.x; o[n][2 * jp + 1] = ov.y; }
                st16<2>((h + (size_t)(rowbase + ai * HALF + m * 16) * 2816 + col0), pack8(o[0], o[1])); }
    }
};

struct EpiPlain {
    static constexpr bool PERM = true, AFTER_DRAIN = false;
    bf16_t* O; int ldc;
    __device__ __forceinline__ void init(f32x4 (&acc)[2][2][4][2], const Unit&, int, int, int, int) const {
#pragma unroll
        for (int a = 0; a < 2; ++a)
#pragma unroll
            for (int b = 0; b < 2; ++b)
#pragma unroll
                for (int m = 0; m < 4; ++m)
#pragma unroll
                    for (int n = 0; n < 2; ++n) acc[a][b][m][n] = (f32x4){0.f, 0.f, 0.f, 0.f};
    }
    __device__ __forceinline__ void operator()(const f32x4 (&acc)[2][2][4][2], const Unit& u, int wr, int wc, int fr, int fq, int) const {
        const int rowbase = u.pm * BM + wr * 64 + fr, col0 = u.pn * BM + 32 * wc + 8 * fq;
#pragma unroll
        for (int ai = 0; ai < 2; ++ai)
#pragma unroll
            for (int m = 0; m < 4; ++m)
#pragma unroll
                for (int bj = 0; bj < 2; ++bj) st16<3>((O + (size_t)(rowbase + ai * HALF + m * 16) * ldc + col0 + bj * HALF), pack8(acc[ai][bj][m][0], acc[ai][bj][m][1]));
    }
};

struct EpiPle {
    static constexpr bool PERM = true, AFTER_DRAIN = false;
    const PG8_LAS float* side; const bf16_t* e; const bf16_t* xin; bf16_t* xout; float* ssq_out;
    __device__ __forceinline__ void init(f32x4 (&acc)[2][2][4][2], const Unit&, int, int, int, int) const {
#pragma unroll
        for (int a = 0; a < 2; ++a)
#pragma unroll
            for (int b = 0; b < 2; ++b)
#pragma unroll
                for (int m = 0; m < 4; ++m)
#pragma unroll
                    for (int n = 0; n < 2; ++n) acc[a][b][m][n] = (f32x4){0.f, 0.f, 0.f, 0.f};
    }
    __device__ __forceinline__ void operator()(const f32x4 (&acc)[2][2][4][2], const Unit& u, int wr, int wc, int fr, int fq, int ui) const {
        const int rowbase = u.pm * BM + wr * 64 + fr, col0 = u.pn * BM + 32 * wc + 8 * fq;
        float rs[2][4]; load_rstd(side, ui, wr, fr, rs);
#pragma unroll
        for (int ai = 0; ai < 2; ++ai)
#pragma unroll
            for (int m = 0; m < 4; ++m) {
                const int row = rowbase + ai * HALF + m * 16; const size_t off = (size_t)row * 1024 + col0; float ss = 0.f; const float sc = -1.4426950408889634f * rs[ai][m];
#pragma unroll
                for (int bj = 0; bj < 2; ++bj) {
                    f32x4 e0, e1, x0, x1; unpack8(*(const u32x4*)(e + off + bj * HALF), e0, e1); unpack8(*(const u32x4*)(xin + off + bj * HALF), x0, x1);
                    f32x4 v0, v1;
#pragma unroll
                    for (int j = 0; j < 4; ++j) {
                        v0[j] = x0[j] + __builtin_amdgcn_rcpf(1.0f + __builtin_amdgcn_exp2f(sc * acc[ai][bj][m][0][j])) * e0[j];
                        v1[j] = x1[j] + __builtin_amdgcn_rcpf(1.0f + __builtin_amdgcn_exp2f(sc * acc[ai][bj][m][1][j])) * e1[j]; }
                    st16<4>((xout + off + bj * HALF), pack8(v0, v1));
                    ss += (v0[0] * v0[0] + v0[1] * v0[1]) + (v0[2] * v0[2] + v0[3] * v0[3]) + (v1[0] * v1[0] + v1[1] * v1[1]) + (v1[2] * v1[2] + v1[3] * v1[3]); }
                ss = add_xor32(add_xor16(ss));
                if (fq == 0) ssq_out[(size_t)row * 16 + u.pn * 4 + wc] = ss;
            }
    }
};
}
#define XB_TMO      128
#define XB_XCNT(j)  (256  + 64 * (j))
#define XB_XSUB(j)  (1280 + 64 * (j))
#define XB_XGEN(j)  (2304 + 64 * (j))
#define XB_TOP      3328
#define XB_TOPGEN   3392
#define XCD_BAR_WORDS 3456
#define XB_SPIN_CAP (1u << 18)

__device__ __forceinline__ unsigned xb_ld(unsigned* p)              { return __hip_atomic_load(p, __ATOMIC_RELAXED, __HIP_MEMORY_SCOPE_AGENT); }
__device__ __forceinline__ unsigned xb_add(unsigned* p, unsigned v) { return __hip_atomic_fetch_add(p, v, __ATOMIC_RELAXED, __HIP_MEMORY_SCOPE_AGENT); }
__device__ __forceinline__ unsigned xb_xcc_id() { return (unsigned)__builtin_amdgcn_s_getreg((3 << 11) | 20) & 0xFu; }
#define XB_SPIN(cond, bar) do { unsigned _sp = 0; while (cond) { __builtin_amdgcn_s_sleep(1); \
    if ((++_sp & 255u) == 0u) { if (xb_ld(&(bar)[XB_TMO])) break; if (_sp > XB_SPIN_CAP) { atomicAdd(&(bar)[XB_TMO], 1u); break; } } } } while (0)

struct XcdBarrier {
    unsigned* bar; unsigned x;
    volatile LAS unsigned* st;
};

__device__ __forceinline__ XcdBarrier xcd_barrier_post(unsigned* bar, volatile LAS unsigned* st) {
    XcdBarrier b; b.bar = bar; b.x = xb_xcc_id(); b.st = st;
    if (threadIdx.x == 0) st[2] = xb_add(&bar[XB_XCNT(b.x)], 1u);
    return b;
}
__device__ __forceinline__ void xcd_barrier_complete(unsigned* bar, unsigned x, unsigned& nloc, unsigned& nx) {
    const unsigned G = gridDim.x * gridDim.y * gridDim.z;
    unsigned sum, cnt, mine, sp = 0u;
    for (;;) {
        sum = 0u; cnt = 0u; mine = 0u;
#pragma unroll
        for (unsigned j = 0; j < 16; ++j) { const unsigned c = xb_ld(&bar[XB_XCNT(j)]); sum += c; cnt += (c > 0u) ? 1u : 0u; mine = (j == x) ? c : mine; }
        if (sum == G) break;
        __builtin_amdgcn_s_sleep(1);
        if ((++sp & 255u) == 0u) { if (xb_ld(&bar[XB_TMO])) break; if (sp > XB_SPIN_CAP) { atomicAdd(&bar[XB_TMO], 1u); break; } }
    }
    nloc = mine > 0u ? mine : 1u; nx = cnt > 0u ? cnt : 1u;
}

__device__ __forceinline__ void xcd_barrier(const XcdBarrier& b) {
    asm volatile("s_waitcnt vmcnt(0)" ::: "memory");
    __syncthreads();
    if (threadIdx.x == 0) {
        unsigned* bar = b.bar; unsigned bx_ = b.x; asm volatile("" : "+s"(bar), "+s"(bx_));
        __builtin_amdgcn_s_waitcnt(0);
        unsigned nloc = b.st[0], nx = b.st[1];
        if (nloc == 0u) { xcd_barrier_complete(bar, bx_, nloc, nx); b.st[0] = nloc; b.st[1] = nx; }
        const unsigned old = xb_add(&bar[XB_XSUB(bx_)], 1u);
        const unsigned gen = old / nloc;
        if (old + 1u == (gen + 1u) * nloc) {
            __builtin_amdgcn_fence(__ATOMIC_RELEASE, "agent");
            asm volatile("s_waitcnt vmcnt(0)" ::: "memory");
            const unsigned og = xb_add(&bar[XB_TOP], 1u);
            const unsigned tg = og / nx;
            if (og + 1u == (tg + 1u) * nx) xb_add(&bar[XB_TOPGEN], 1u);
            else XB_SPIN(xb_ld(&bar[XB_TOPGEN]) == tg, bar);
            __builtin_amdgcn_fence(__ATOMIC_ACQUIRE, "agent");
            xb_add(&bar[XB_XGEN(bx_)], 1u);
            asm volatile("s_waitcnt vmcnt(0)" ::: "memory");
        } else {
            XB_SPIN(xb_ld(&bar[XB_XGEN(bx_)]) == gen, bar);
            __builtin_amdgcn_fence(__ATOMIC_ACQUIRE, "agent");
            asm volatile("s_waitcnt vmcnt(0)" ::: "memory");
        }
    }
    __syncthreads();
}

#define XB_LSUB(j)  (3456 + 64 * (j))
#define XB_LGEN(j)  (3456 + 1024 + 64 * (j))
#define XB_TICKET   (3456 + 2048)
__device__ __forceinline__ void xcd_local_barrier(const XcdBarrier& b) {
    asm volatile("s_waitcnt vmcnt(0)" ::: "memory");
    __syncthreads();
    if (threadIdx.x == 0) {
        unsigned* bar = b.bar; unsigned bx_ = b.x; asm volatile("" : "+s"(bar), "+s"(bx_));
        const unsigned nloc = b.st[0];
        const unsigned old = xb_add(&bar[XB_LSUB(bx_)], 1u);
        const unsigned gen = old / nloc;
        if (old + 1u == (gen + 1u) * nloc) xb_add(&bar[XB_LGEN(bx_)], 1u);
        else XB_SPIN(xb_ld(&bar[XB_LGEN(bx_)]) == gen, bar);
        __builtin_amdgcn_fence(__ATOMIC_ACQUIRE, "agent");
        asm volatile("s_waitcnt vmcnt(0)" ::: "memory");
    }
    __syncthreads();
}

__device__ __forceinline__ float wave_sum(float v) {
    v += __builtin_bit_cast(float, __builtin_amdgcn_ds_swizzle(__builtin_bit_cast(int, v), 0x041F));
    v += __builtin_bit_cast(float, __builtin_amdgcn_ds_swizzle(__builtin_bit_cast(int, v), 0x081F));
    v += __builtin_bit_cast(float, __builtin_amdgcn_ds_swizzle(__builtin_bit_cast(int, v), 0x101F));
    v += __builtin_bit_cast(float, __builtin_amdgcn_ds_swizzle(__builtin_bit_cast(int, v), 0x201F));
    return add_xor32(add_xor16(v));
}
__device__ __forceinline__ unsigned off_b(unsigned row, unsigned ch) { return 256u * row + 16u * (ch ^ (((row & 3u) << 2) | ((row >> 2) & 3u))); }
__device__ __forceinline__ unsigned tr_addr_nat(unsigned lane, unsigned c, unsigned ks, unsigned t) {
    const unsigned h = lane >> 5, blk = (lane >> 4) & 1u, q = (lane & 15u) >> 2, p = lane & 3u;
    return off_b(16u * ks + 8u * h + 4u * t + q, 4u * c + 2u * blk + (p >> 1)) + 8u * (p & 1u);
}
__device__ __forceinline__ unsigned tr_addr_perm(unsigned lane, unsigned c, unsigned ks, unsigned t) {
    const unsigned h = lane >> 5, blk = (lane >> 4) & 1u, q = (lane & 15u) >> 2, p = lane & 3u;
    return off_b(16u * ks + 8u * t + 4u * h + q, 4u * c + 2u * blk + (p >> 1)) + 8u * (p & 1u);
}
__device__ __forceinline__ unsigned tr_addr16(unsigned lane, unsigned c, unsigned ks, unsigned t) {
    const unsigned g = lane >> 4, q = (lane & 15u) >> 2, p = lane & 3u;
    return off_b(32u * ks + 8u * g + 4u * t + q, 2u * c + (p >> 1)) + 8u * (p & 1u);
}
__device__ __forceinline__ void glds16(const void* gsrc, unsigned lds_dst) { unsigned keep;
    asm volatile("s_mov_b32 %0, m0\n\ts_mov_b32 m0, %2\n\ts_nop 0\n\tglobal_load_lds_dwordx4 %1, off\n\ts_mov_b32 m0, %0" : "=&s"(keep) : "v"(gsrc), "s"(lds_dst) : "memory"); }
typedef short v4i16_t __attribute__((ext_vector_type(4)));
__device__ __forceinline__ s16x4 tr_read(LAS unsigned char* p) { return __builtin_bit_cast(s16x4, __builtin_amdgcn_ds_read_tr16_b64_v4i16((LAS v4i16_t*)p)); }
__device__ __forceinline__ bf16x8 cat4(s16x4 a, s16x4 b) { return (bf16x8){a[0], a[1], a[2], a[3], b[0], b[1], b[2], b[3]}; }
__device__ __forceinline__ unsigned cvtpk(float lo, float hi) { return pg8::cvt_pk_bf16(lo, hi); }
__device__ __forceinline__ int crow(int r, int hi) { return (r & 3) + 8 * (r >> 2) + 4 * hi; }
__device__ __forceinline__ bf16x8 pack_acc(const f32x16& a, int s) {
    v4u w; w.x = cvtpk(a[8 * s + 0], a[8 * s + 1]); w.y = cvtpk(a[8 * s + 2], a[8 * s + 3]); w.z = cvtpk(a[8 * s + 4], a[8 * s + 5]); w.w = cvtpk(a[8 * s + 6], a[8 * s + 7]);
    return __builtin_bit_cast(bf16x8, w);
}

__device__ __forceinline__ void tr_item(const float* W, int ldw, int srccol0, int k0, const float* gain, float scal, bf16* WT, int K, int dstrow0, LAS float* scr, int lane) {
    float r[32], gv[32];
    const float* wp = W + (size_t)(k0 + (lane >> 5)) * ldw + srccol0 + (lane & 31);
#pragma unroll
    for (int i = 0; i < 32; ++i) r[i] = __builtin_nontemporal_load(wp + (size_t)(2 * i) * ldw);
    if (gain) {
#pragma unroll
        for (int i = 0; i < 32; ++i) gv[i] = gain[k0 + 2 * i + (lane >> 5)] * scal;
    } else {
#pragma unroll
        for (int i = 0; i < 32; ++i) gv[i] = scal;
    }
#pragma unroll
    for (int i = 0; i < 32; ++i) scr[(2 * i + (lane >> 5)) * 33 + (lane & 31)] = r[i] * gv[i];
    LDS_WAIT(); asm volatile("" ::: "memory");
    const int c = lane & 7;
#pragma unroll
    for (int j = 0; j < 4; ++j) { const int n = (lane >> 3) + 8 * j; const LAS float* s = scr + (8 * c) * 33 + n;
        v4u o; o.x = pk2(s[0 * 33], s[1 * 33]); o.y = pk2(s[2 * 33], s[3 * 33]); o.z = pk2(s[4 * 33], s[5 * 33]); o.w = pk2(s[6 * 33], s[7 * 33]);
        *(GAS v4u*)(WT + (size_t)(dstrow0 + n) * K + k0 + 8 * c) = o; }
    LDS_WAIT(); asm volatile("" ::: "memory");
}

struct Args { const float* x; const float* p; const int* pos; const float* g_mix; const float* w_in; const float* pool_w; const float* pool_scale; const float* w_out; const float* g_ffn;
              const float* w_gate; const float* w_up; const float* w_down; const float* g_ple; const float* w_ple_gate; const float* w_ple_proj; const float* g_final; float* out; unsigned char* ws; };

template <int W> __device__ __forceinline__ void pool_rows(const bf16* uw, bf16* mix, int b, int s0, int c0) {
    constexpr int NR = W - 1 + 16;
    v2u xr[NR];
#pragma unroll
    for (int i = 0; i < NR; ++i) { const int s = s0 - (W - 1) + i;
        xr[i] = (s >= 0) ? *(const GAS v2u*)(uw + (size_t)(b * SEQ + s) * 512 + c0) : (v2u){0u, 0u}; }
    float sum[4];
#pragma unroll
    for (int j = 0; j < 4; ++j) sum[j] = 0.f;
#pragma unroll
    for (int i = 0; i < W - 1; ++i)
#pragma unroll
        for (int j = 0; j < 2; ++j) { sum[2 * j] += bf_lo(xr[i][j]); sum[2 * j + 1] += bf_hi(xr[i][j]); }
#pragma unroll
    for (int i = 0; i < 16; ++i) {
        const int s = s0 + i; const float inv = 1.0f / (float)((s + 1 < W) ? (s + 1) : W);
        float o[4];
#pragma unroll
        for (int j = 0; j < 2; ++j) { const float a = bf_lo(xr[W - 1 + i][j]), c = bf_hi(xr[W - 1 + i][j]);
            sum[2 * j] += a; sum[2 * j + 1] += c; o[2 * j] = sum[2 * j] * inv - a; o[2 * j + 1] = sum[2 * j + 1] * inv - c;
            sum[2 * j] -= bf_lo(xr[i][j]); sum[2 * j + 1] -= bf_hi(xr[i][j]); }
        *(GAS v2u*)(mix + (size_t)(b * SEQ + s) * 1024 + 512 + c0) = (v2u){pk2(o[0], o[1]), pk2(o[2], o[3])};
    }
}

__global__ void __launch_bounds__(NWAVES * 64, 2) fwd(Args a_in) {
    extern __shared__ __attribute__((aligned(16))) unsigned char lds_raw[];
    LAS unsigned char* lds = (LAS unsigned char*)lds_raw;
    volatile LAS unsigned* MISC = (volatile LAS unsigned*)(lds + MISC_OFF);
    const int tid = threadIdx.x, lane = tid & 63, wave = __builtin_amdgcn_readfirstlane(tid >> 6);
    const int G = gridDim.x, bx = blockIdx.x;
    const int gw = bx * NWAVES + wave, NGW = G * NWAVES;
    typedef const __attribute__((address_space(4))) Args CArgs;
#define PHASE_ENVB(bi_) CArgs* ap_ = (CArgs*)__builtin_amdgcn_kernarg_segment_ptr(); asm volatile("" : "+s"(ap_)); CArgs& a = *ap_; \
    unsigned char* const ws = a.ws; float* const ssqA = (float*)(ws + WS_SSQA) + (size_t)(bi_) * SEQ * 16; float* const ssqB = (float*)(ws + WS_SSQB) + (size_t)(bi_) * SEQ * 16; \
    bf16* const xb = (bf16*)(ws + WS_XB) + (size_t)(bi_) * SEQ * D; bf16* const xb1 = (bf16*)(ws + WS_XB1) + (size_t)(bi_) * SEQ * D; bf16* const pb = (bf16*)(ws + WS_PB) + (size_t)(bi_) * SEQ * PLE; \
    unsigned char* const R = ws + WS_R + (size_t)(bi_) * R_BATCH; \
    bf16* const qb = (bf16*)(R + R_Q); bf16* const kb = (bf16*)(R + R_K); bf16* const vb = (bf16*)(R + R_V); bf16* const gb = (bf16*)(R + R_G); bf16* const uwb = (bf16*)(R + R_UW); \
    bf16* const kvb = (bf16*)(R + R_KV); bf16* const mix = (bf16*)(R + R_MIX); bf16* const hmid = (bf16*)(R + R_H); bf16* const eb = (bf16*)(R + R_E); float* const utmp = (float*)(ws + WS_R + R_UT); \
    (void)ssqA; (void)ssqB; (void)xb; (void)xb1; (void)pb; (void)qb; (void)kb; (void)vb; (void)gb; (void)uwb; (void)kvb; (void)mix; (void)hmid; (void)eb; (void)utmp
#define PHASE_ENV() PHASE_ENVB(batch)
    gu32* ctl = (gu32*)(a_in.ws + WS_CTL);
    for (int u = tid; u < (LDS_BYTES - LDSCTL_OFF) / 4; u += NWAVES * 64) ((LAS unsigned*)(lds + LDSCTL_OFF))[u] = 0u;
    __syncthreads();
    XcdBarrier bar = xcd_barrier_post((unsigned*)(ctl + CW_BAR), MISC + 8);

#ifndef PHMASK
#define PHMASK 0xFFFF
#endif
#define PH(n) ((PHMASK >> (n)) & 1)
#define FRESH_TID(name) int name = threadIdx.x; asm volatile("" : "+v"(name))
    if (PH(0)) { PHASE_ENVB(0);
    for (int task = gw; task < DEPTH * 4 * 2 * 128; task += NGW) {
        const int kb8 = task & 127, dh = (task >> 7) & 1, g = (task >> 8) & 3, L = task >> 10;
        const int d = dh * 64 + lane;
        const float* pw = a.pool_w + (size_t)((L * 4 + g) * 128) * 128 + d;
        const float* wi = a.w_in + (size_t)(L * 1024 + kb8 * 8) * INW + 2048 + g * 128;
        float acc[8];
#pragma unroll
        for (int i = 0; i < 8; ++i) acc[i] = 0.f;
#pragma unroll 4
        for (int c = 0; c < 128; ++c) { const float bv = pw[(size_t)c * 128];
#pragma unroll
            for (int i = 0; i < 8; ++i) acc[i] += wi[(size_t)i * INW + c] * bv; }
        const float sc = a.pool_scale[L * 512 + g * 128 + d];
#pragma unroll
        for (int i = 0; i < 8; ++i) utmp[(size_t)(L * 1024 + kb8 * 8 + i) * 512 + g * 128 + d] = acc[i] * sc;
    }
    }
    xcd_barrier(bar);
#ifndef FORCE_FALLBACK
#define FORCE_FALLBACK 0
#endif
    if (threadIdx.x == 0) {
        unsigned* barw = (unsigned*)(ctl + CW_BAR);
        const unsigned nloc_ = MISC[8], nx_ = MISC[9], rk_ = MISC[10], myx_ = xb_xcc_id();
        unsigned mode_ = 0u, batch_ = 0u, rank_ = 0u, gsz_ = 1u;
        if (nx_ == 8u && !FORCE_FALLBACK) { mode_ = 1u; for (unsigned j = 0; j < 16; ++j) if (j < myx_ && xb_ld(&barw[XB_XCNT(j)]) > 0u) ++batch_; rank_ = rk_; gsz_ = nloc_; }
        else { const unsigned t_ = xb_add(&barw[XB_TICKET], 1u); batch_ = t_ % 8u; rank_ = t_ / 8u; gsz_ = (unsigned)G / 8u + ((batch_ < (unsigned)G % 8u) ? 1u : 0u); }
        MISC[11] = mode_; MISC[12] = batch_; MISC[13] = rank_; MISC[14] = gsz_;
    }
    __syncthreads();
    const int lmode = __builtin_amdgcn_readfirstlane((int)MISC[11]), batch = __builtin_amdgcn_readfirstlane((int)MISC[12]), rank = __builtin_amdgcn_readfirstlane((int)MISC[13]), gsz = __builtin_amdgcn_readfirstlane((int)MISC[14]);
#define LBAR() do { if (lmode) xcd_local_barrier(bar); else xcd_barrier(bar); } while (0)

    if (PH(1)) { PHASE_ENVB(0);
        LAS float* scr = (LAS float*)(lds + wave * 16384);
        constexpr int I_IN = 16 * 80, I_OUT = 16 * 32, I_GU = 16 * 176, I_DN = 44 * 32, I_PG = 16 * 32, I_PP = 4 * 32, I_L = I_IN + I_OUT + I_GU + I_DN + I_PG + I_PP;
        for (int it = gw; it < DEPTH * I_L; it += NGW) {
            const int L = it / I_L; int r = it % I_L;
            unsigned char* wl = ws + WS_W + (size_t)L * W_LAYER;
            if (r < I_IN) { const int kbk = r / 80, nb = r % 80, n0 = 32 * nb, k0 = 64 * kbk; const float* gn = a.g_mix + L * 1024;
                if (n0 < 1024) { const int sec = n0 >> 9, w = n0 & 511, t = w >> 8, bj = (w >> 7) & 1, hh = (w >> 6) & 1, dd0 = w & 63;
                    tr_item(a.w_in + (size_t)L * 1024 * INW, INW, sec * 512 + (2 * t + hh) * 128 + bj * 64 + dd0, k0, gn, sec == 0 ? 0.08838834764831845f : 1.0f, (bf16*)(wl + WO_IN), 1024, n0, scr, lane); }
                else if (n0 < 2048) tr_item(a.w_in + (size_t)L * 1024 * INW, INW, n0, k0, gn, 1.0f, (bf16*)(wl + WO_IN), 1024, n0, scr, lane);
                else tr_item(utmp + (size_t)L * 1024 * 512, 512, n0 - 2048, k0, gn, 1.0f, (bf16*)(wl + WO_IN), 1024, n0, scr, lane);
                continue; } r -= I_IN;
            if (r < I_OUT) { const int kbk = r / 32, nb = r % 32; tr_item(a.w_out + (size_t)L * 1024 * 1024, 1024, 32 * nb, 64 * kbk, nullptr, 1.0f, (bf16*)(wl + WO_OUT), 1024, 32 * nb, scr, lane); continue; } r -= I_OUT;
            if (r < I_GU) { const int kbk = r / 176, nb = r % 176, n0 = 32 * nb, t = n0 >> 8, bj = (n0 >> 7) & 1, j0 = n0 & 127;
                tr_item((bj ? a.w_up : a.w_gate) + (size_t)L * 1024 * FF, FF, 128 * t + j0, 64 * kbk, a.g_ffn + L * 1024, 1.0f, (bf16*)(wl + WO_GU), 1024, n0, scr, lane); continue; } r -= I_GU;
            if (r < I_DN) { const int kbk = r / 32, nb = r % 32; tr_item(a.w_down + (size_t)L * FF * 1024, 1024, 32 * nb, 64 * kbk, nullptr, 1.0f, (bf16*)(wl + WO_DOWN), FF, 32 * nb, scr, lane); continue; } r -= I_DN;
            if (r < I_PG) { const int kbk = r / 32, nb = r % 32; tr_item(a.w_ple_gate + (size_t)L * 1024 * 1024, 1024, 32 * nb, 64 * kbk, a.g_ple + L * 1024, 1.0f, (bf16*)(wl + WO_PG), 1024, 32 * nb, scr, lane); continue; } r -= I_PG;
            { const int kbk = r / 32, nb = r % 32; tr_item(a.w_ple_proj + (size_t)L * PLE * 1024, 1024, 32 * nb, 64 * kbk, nullptr, 1.0f, (bf16*)(wl + WO_PP), PLE, 32 * nb, scr, lane); }
        }
        for (int m = 2 * gw; m < M; m += 2 * NGW) {
            const GAS f32x4* xr = (const GAS f32x4*)(a.x + (size_t)m * D) + lane; GAS v2u* o8 = (GAS v2u*)(xb1 + (size_t)m * D) + lane;
            f32x4 v[8];
#pragma unroll
            for (int j = 0; j < 8; ++j) v[j] = __builtin_nontemporal_load(xr + 64 * j);
            float ss0 = 0.f, ss1 = 0.f;
#pragma unroll
            for (int j = 0; j < 4; ++j) { ss0 += (v[j][0] * v[j][0] + v[j][1] * v[j][1]) + (v[j][2] * v[j][2] + v[j][3] * v[j][3]); o8[64 * j] = (v2u){pk2(v[j][0], v[j][1]), pk2(v[j][2], v[j][3])}; }
#pragma unroll
            for (int j = 4; j < 8; ++j) { ss1 += (v[j][0] * v[j][0] + v[j][1] * v[j][1]) + (v[j][2] * v[j][2] + v[j][3] * v[j][3]); o8[64 * j] = (v2u){pk2(v[j][0], v[j][1]), pk2(v[j][2], v[j][3])}; }
            ss0 = wave_sum(ss0); ss1 = wave_sum(ss1);
            if (lane < 32) ssqB[(size_t)m * 16 + lane] = (lane == 0) ? ss0 : (lane == 16) ? ss1 : 0.f;
        }
        for (size_t i = (size_t)bx * 512 + tid; i < (size_t)M * PLE / 8; i += (size_t)G * 512) {
            const f32x4 v0 = ((const GAS f32x4*)a.p)[2 * i], v1 = ((const GAS f32x4*)a.p)[2 * i + 1];
            ((GAS v4u*)pb)[i] = (v4u){pk2(v0[0], v0[1]), pk2(v0[2], v0[3]), pk2(v1[0], v1[1]), pk2(v1[2], v1[3])};
        }
    }
    xcd_barrier(bar);

    for (int L = 0; L < DEPTH; ++L) {

#ifndef REP_P1
#define REP_P1 1
#endif
#pragma unroll 1
        for (int rep_ = 0; rep_ < REP_P1; ++rep_) {
        if (PH(2)) {
            PHASE_ENV(); const unsigned char* wl = ws + WS_W + (size_t)L * W_LAYER; (void)wl; FRESH_TID(ptid); pg8::Gemm g{xb1, (const bf16*)(wl + WO_IN), SEQ, INW, D}; pg8::BatchOrder S; S.init(INW, gsz, rank);
            PG8_LAS float* side = (PG8_LAS float*)(lds + SIDE_OFF); const int npu = (S.nwg + gsz - 1) / gsz;     PG8_LAS float* posf = side + npu * 256; PG8_LAS float* rope = posf + npu * 256;
            pg8::fill_rstd(S, ssqB, side, a.pos + batch * SEQ, posf, ptid); if (ptid < 64) { rope[ptid] = ROPE_HI[ptid]; rope[64 + ptid] = ROPE_LO[ptid]; } __syncthreads();
            pg8::EpiInProj E{side, posf, rope, qb, kb, vb, gb, uwb};
            pg8::gemm_phase<pg8::EpiInProj, pg8::BatchOrder, true, true>(lds, g, S, E, ptid);
        }
        LBAR();


        }
#ifndef REP_RET
#define REP_RET 1
#endif
#pragma unroll 1
        for (int rep_ = 0; rep_ < REP_RET; ++rep_) {
        if (PH(3)) { PHASE_ENV();
            FRESH_TID(t_); const int tid = t_, lane = t_ & 63, wave = __builtin_amdgcn_readfirstlane(t_ >> 6); (void)tid; (void)lane; (void)wave;
            {
                const unsigned ldsb = (unsigned)__builtin_amdgcn_readfirstlane((int)(unsigned)(size_t)lds);
                unsigned soff[4];
#pragma unroll
                for (int p = 0; p < 4; ++p) { const unsigned row = 4u * (unsigned)(wave * 4 + p) + ((unsigned)lane >> 4), pc = (unsigned)lane & 15u; soff[p] = 256u * row + 16u * (pc ^ (((row & 3u) << 2) | ((row >> 2) & 3u))); }
#define P2_DMA(u_, buf_) do { const char* ks_ = (const char*)(kb + (size_t)(u_) * 16384); const char* vs_ = (const char*)(vb + (size_t)(u_) * 16384); \
                    _Pragma("unroll") for (int p_ = 0; p_ < 4; ++p_) { glds16(ks_ + soff[p_], ldsb + (unsigned)((buf_) * 65536 + (wave * 4 + p_) * 1024)); \
                        glds16(vs_ + soff[p_], ldsb + (unsigned)((buf_) * 65536 + 32768 + (wave * 4 + p_) * 1024)); } } while (0)
                int buf = 0;
                if (rank < NH * NCH) P2_DMA(rank, 0);
                asm volatile("s_waitcnt vmcnt(0)" ::: "memory");
                for (int u = rank; u < NH * NCH; u += gsz, buf ^= 1) {
                    asm volatile("s_waitcnt vmcnt(4)" ::: "memory"); __builtin_amdgcn_s_barrier(); asm volatile("" ::: "memory");
                    if (u + gsz < NH * NCH) P2_DMA(u + gsz, buf ^ 1);
                    LAS unsigned char* kl = lds + buf * 65536; LAS unsigned char* vl2 = kl + 32768;
                    const int dt = wave >> 1, et0 = (wave & 1) * 2;
                    f32x16 acc0, acc1;
#pragma unroll
                    for (int r = 0; r < 16; ++r) { acc0[r] = 0.f; acc1[r] = 0.f; }
#pragma unroll
                    for (int ks = 0; ks < 8; ++ks) {
                        const bf16x8 A = cat4(tr_read(kl + tr_addr_nat(lane, dt, ks, 0)), tr_read(kl + tr_addr_nat(lane, dt, ks, 1)));
                        const bf16x8 B0 = cat4(tr_read(vl2 + tr_addr_nat(lane, et0, ks, 0)), tr_read(vl2 + tr_addr_nat(lane, et0, ks, 1)));
                        const bf16x8 B1 = cat4(tr_read(vl2 + tr_addr_nat(lane, et0 + 1, ks, 0)), tr_read(vl2 + tr_addr_nat(lane, et0 + 1, ks, 1)));
                        acc0 = __builtin_amdgcn_mfma_f32_32x32x16_bf16(A, B0, acc0, 0, 0, 0);
                        acc1 = __builtin_amdgcn_mfma_f32_32x32x16_bf16(A, B1, acc1, 0, 0, 0);
                    }
                    bf16* kvt = kvb + (size_t)u * 16384;
#pragma unroll
                    for (int s = 0; s < 2; ++s) {
                        *(GAS bf16x8*)(kvt + ((dt * 4 + et0) * 2 + s) * 512 + lane * 8) = pack_acc(acc0, s);
                        *(GAS bf16x8*)(kvt + ((dt * 4 + et0 + 1) * 2 + s) * 512 + lane * 8) = pack_acc(acc1, s);
                    }
                }
                asm volatile("s_waitcnt vmcnt(0)" ::: "memory"); __syncthreads();
#undef P2_DMA
            }
            for (int it = rank; it < NCH; it += gsz) {
                const int b = it >> 5, n = it & 31, gi = wave & 3, half = wave >> 2;
#pragma unroll 1
                for (int ps = 0; ps < 2; ++ps) {
                    const int s0 = n * 128 + half * 64 + ps * 32 + (lane >> 5) * 16, c0 = gi * 128 + (lane & 31) * 4;
                    if (gi == 0) pool_rows<2>(uwb, mix, b, s0, c0); else if (gi == 1) pool_rows<4>(uwb, mix, b, s0, c0); else if (gi == 2) pool_rows<8>(uwb, mix, b, s0, c0); else pool_rows<16>(uwb, mix, b, s0, c0);
                }
            }
            if (L > 0) {
                const GAS f32x4* ps = (const GAS f32x4*)(a.p + ((size_t)L * M + (size_t)batch * SEQ) * PLE);
                for (size_t i = (size_t)rank * 512 + tid; i < (size_t)SEQ * PLE / 8; i += (size_t)gsz * 512) {
                    const f32x4 v0 = ps[2 * i], v1 = ps[2 * i + 1];
                    ((GAS v4u*)pb)[i] = (v4u){pk2(v0[0], v0[1]), pk2(v0[2], v0[3]), pk2(v1[0], v1[1]), pk2(v1[2], v1[3])};
                }
            }
        }
        LBAR();


        if (PH(4)) { PHASE_ENV(); FRESH_TID(t_); const int tid = t_, lane = t_ & 63, wave = __builtin_amdgcn_readfirstlane(t_ >> 6); (void)tid; (void)lane; (void)wave;
        for (int c = rank * 512 + tid; c < NH * 4096; c += gsz * 512) {
            const int bh = c >> 12; const float cd = __builtin_amdgcn_exp2f(128.0f * lg2gamma(bh & 3));
            GAS v2u* base = (GAS v2u*)(kvb + (size_t)bh * NCH * 16384) + (c & 4095);
            v2u t[NCH];
#pragma unroll
            for (int n = 0; n < NCH; ++n) t[n] = base[(size_t)n * 4096];
            float r0 = 0.f, r1 = 0.f, r2 = 0.f, r3 = 0.f;
#pragma unroll
            for (int n = 0; n < NCH; ++n) {
                const v2u in = t[n];
                base[(size_t)n * 4096] = (v2u){pk2(r0, r1), pk2(r2, r3)};
                r0 = cd * (r0 + bf_lo(in[0])); r1 = cd * (r1 + bf_hi(in[0])); r2 = cd * (r2 + bf_lo(in[1])); r3 = cd * (r3 + bf_hi(in[1]));
            }
        }
        }
        LBAR();

        if (PH(5)) { PHASE_ENV(); FRESH_TID(t_); const int tid = t_, lane = t_ & 63, wave = __builtin_amdgcn_readfirstlane(t_ >> 6);
        LAS float* red = (LAS float*)(lds + SIDE_OFF);
        const unsigned ldsb = (unsigned)__builtin_amdgcn_readfirstlane((int)(unsigned)(size_t)lds);
        unsigned soff[4];
#pragma unroll
        for (int p = 0; p < 4; ++p) { const unsigned row = 4u * (unsigned)(wave * 4 + p) + ((unsigned)lane >> 4), pc = (unsigned)lane & 15u; soff[p] = 256u * row + 16u * (pc ^ (((row & 3u) << 2) | ((row >> 2) & 3u))); }
        const int qt = (wave < 4) ? wave : 7 - wave, eh = wave >> 2;
        v4u sfr[16];
#define P4_TILE(src_, u_, reg_) do { const char* s_ = (const char*)((src_) + (size_t)(u_) * 16384); \
            _Pragma("unroll") for (int p_ = 0; p_ < 4; ++p_) glds16(s_ + soff[p_], ldsb + (unsigned)((reg_) * 32768 + (wave * 4 + p_) * 1024)); } while (0)
#define P4_SF(u_) do { const bf16* st_ = kvb + (size_t)(u_) * 16384 + lane * 8; \
            _Pragma("unroll") for (int k_ = 0; k_ < 16; ++k_) { const int ei_ = k_ >> 3, dt_ = (k_ >> 1) & 3, s_ = k_ & 1; \
                asm volatile("global_load_dwordx4 %0, %1, off" : "=v"(sfr[k_]) : "v"(st_ + ((dt_ * 4 + 2 * eh + ei_) * 2 + s_) * 512) : "memory"); } } while (0)
#define P4_WAIT_SF(n_) asm volatile("s_waitcnt vmcnt(" #n_ ")" : "+v"(sfr[0]), "+v"(sfr[1]), "+v"(sfr[2]), "+v"(sfr[3]), "+v"(sfr[4]), "+v"(sfr[5]), "+v"(sfr[6]), "+v"(sfr[7]), \
            "+v"(sfr[8]), "+v"(sfr[9]), "+v"(sfr[10]), "+v"(sfr[11]), "+v"(sfr[12]), "+v"(sfr[13]), "+v"(sfr[14]), "+v"(sfr[15]) :: "memory")
#define P4_BAR() do { asm volatile("s_waitcnt lgkmcnt(0)" ::: "memory"); __builtin_amdgcn_s_barrier(); asm volatile("" ::: "memory"); } while (0)
        { const int u0 = (rank < NH * NCH) ? rank : NH * NCH - 1;
          P4_TILE(kb, u0, 0); P4_TILE(qb, u0, 2); P4_SF(u0); P4_TILE(vb, u0, 1); }
        P4_WAIT_SF(0);
        for (int u = rank; u < NH * NCH; u += gsz) {
            const int bh = u >> 5, n = u & 31, h = bh & 3, b = bh >> 2;
            const bool has_next = (u + gsz < NH * NCH);
            P4_WAIT_SF(4); P4_BAR();
            P4_TILE(gb, u, 3);
            int ln = lane; asm volatile("" : "+v"(ln)); const int ql = ln & 31, hh = ln >> 5;
            LAS unsigned char* kzl = lds; LAS unsigned char* vl = lds + 32768; LAS unsigned char* qlds = lds + 65536; LAS unsigned char* glds = lds + 98304;
            bf16x8 qf[4][2];
            { const unsigned qrow = 32u * qt + (unsigned)ql;
#pragma unroll
              for (int dt = 0; dt < 4; ++dt)
#pragma unroll
                for (int s = 0; s < 2; ++s) { const v2u lo = *(const LAS v2u*)(qlds + off_b(qrow, 4 * dt + 2 * s) + 8 * hh), hi = *(const LAS v2u*)(qlds + off_b(qrow, 4 * dt + 2 * s + 1) + 8 * hh);
                    qf[dt][s] = __builtin_bit_cast(bf16x8, (v4u){lo[0], lo[1], hi[0], hi[1]}); } }
            bf16x8 pf[4][2];
#pragma unroll
            for (int kt = 0; kt < 4; ++kt) {
                if (kt <= qt) {
                    f32x16 sa;
#pragma unroll
                    for (int r = 0; r < 16; ++r) sa[r] = 0.f;
                    const unsigned krow = 32 * kt + ql;
#pragma unroll
                    for (int dt = 0; dt < 4; ++dt)
#pragma unroll
                        for (int s = 0; s < 2; ++s) {
                            const v2u lo = *(const LAS v2u*)(kzl + off_b(krow, 4 * dt + 2 * s) + 8 * hh), hi = *(const LAS v2u*)(kzl + off_b(krow, 4 * dt + 2 * s + 1) + 8 * hh);
                            sa = __builtin_amdgcn_mfma_f32_32x32x16_bf16(__builtin_bit_cast(bf16x8, (v4u){lo[0], lo[1], hi[0], hi[1]}), qf[dt][s], sa, 0, 0, 0); }
                    if (kt == qt) {
#pragma unroll
                        for (int r = 0; r < 16; ++r) sa[r] = (crow(r, hh) > ql) ? 0.f : sa[r];
                    }
                    pf[kt][0] = pack_acc(sa, 0); pf[kt][1] = pack_acc(sa, 1);
                } else { pf[kt][0] = (bf16x8){0, 0, 0, 0, 0, 0, 0, 0}; pf[kt][1] = (bf16x8){0, 0, 0, 0, 0, 0, 0, 0}; }
            }
            P4_BAR();
            if (has_next) { P4_TILE(kb, u + gsz, 0); P4_TILE(qb, u + gsz, 2); }
            f32x16 oacc[2]; int ln2 = lane; asm volatile("" : "+v"(ln2));
#pragma unroll
            for (int ei = 0; ei < 2; ++ei) {
                f32x16 o;
#pragma unroll
                for (int r = 0; r < 16; ++r) o[r] = 0.f;
#pragma unroll
                for (int dt = 0; dt < 4; ++dt)
#pragma unroll
                    for (int s = 0; s < 2; ++s) o = __builtin_amdgcn_mfma_f32_32x32x16_bf16(__builtin_bit_cast(bf16x8, sfr[ei * 8 + dt * 2 + s]), qf[dt][s], o, 0, 0, 0);
                oacc[ei] = o;
            }
#pragma unroll
            for (int ei = 0; ei < 2; ++ei) {
                const int et = 2 * eh + ei; f32x16 o = oacc[ei];
#pragma unroll
                for (int kt = 0; kt < 4; ++kt) {
                    if (kt <= qt) {
#pragma unroll
                        for (int s = 0; s < 2; ++s) {
                            const bf16x8 vf = cat4(tr_read(vl + tr_addr_perm(ln2, et, 2 * kt + s, 0)), tr_read(vl + tr_addr_perm(ln2, et, 2 * kt + s, 1)));
                            o = __builtin_amdgcn_mfma_f32_32x32x16_bf16(vf, pf[kt][s], o, 0, 0, 0); }
                    }
                }
                oacc[ei] = o;
            }
            const float rsc = __builtin_amdgcn_exp2f((float)(32 * qt + ql - 127) * lg2gamma(h));
            float ss = 0.f;
#pragma unroll
            for (int ei = 0; ei < 2; ++ei)
#pragma unroll
                for (int r = 0; r < 16; ++r) { const float y = oacc[ei][r] * rsc; oacc[ei][r] = y; ss += y * y; }
            ss = add_xor32(ss);
            if (hh == 0) red[eh * 128 + 32 * qt + ql] = ss;
            if (has_next) asm volatile("s_waitcnt vmcnt(8)" ::: "memory"); else asm volatile("s_waitcnt vmcnt(0)" ::: "memory");
            P4_BAR();
            if (has_next) { P4_SF(u + gsz); P4_TILE(vb, u + gsz, 1); }
            int ln3 = lane; asm volatile("" : "+v"(ln3)); const int ql3 = ln3 & 31, hh3 = ln3 >> 5;
            const float rn = rsqrtf((red[32 * qt + ql3] + red[128 + 32 * qt + ql3]) * (1.0f / 128.0f) + EPS);
            { const unsigned yrow = 32u * qt + (unsigned)ql3;
#pragma unroll
              for (int ei = 0; ei < 2; ++ei)
#pragma unroll
                for (int rg = 0; rg < 4; ++rg) {
                    const unsigned e0 = 32u * (2 * eh + ei) + 8u * rg + 4u * hh3, ch = e0 >> 3, sub = (e0 & 7u) * 2u;
                    const v2u gv = *(const LAS v2u*)(glds + off_b(yrow, ch) + sub);
                    float o[4];
#pragma unroll
                    for (int j = 0; j < 4; ++j) { const float gt = (j & 1) ? bf_hi(gv[j >> 1]) : bf_lo(gv[j >> 1]);
                        o[j] = gt * __builtin_amdgcn_rcpf(1.0f + __builtin_amdgcn_exp2f(-1.4426950408889634f * gt)) * (oacc[ei][4 * rg + j] * rn); }
                    *(LAS v2u*)(glds + off_b(yrow, ch) + sub) = (v2u){pk2(o[0], o[1]), pk2(o[2], o[3])};
                } }
            P4_BAR();
            { bf16* orow = mix + ((size_t)b * SEQ + n * 128) * 1024 + h * 128;
              int t4 = tid; asm volatile("" : "+v"(t4));
#pragma unroll
              for (int i = 0; i < 4; ++i) { const unsigned c = t4 + 512 * i, row = c >> 4, ch = c & 15; *(GAS v4u*)(orow + (size_t)row * 1024 + ch * 8) = *(const LAS v4u*)(glds + off_b(row, ch)); } }
        }
        asm volatile("s_waitcnt vmcnt(0)" ::: "memory"); __syncthreads();
#undef P4_TILE
#undef P4_SF
#undef P4_WAIT_SF
#undef P4_BAR
        }
        LBAR();

        }
        if (PH(6)) {
            PHASE_ENV(); const unsigned char* wl = ws + WS_W + (size_t)L * W_LAYER; (void)wl; FRESH_TID(ptid); pg8::Gemm g{mix, (const bf16*)(wl + WO_OUT), SEQ, D, D}; pg8::BatchOrder S; S.init(D, gsz, rank);
            pg8::EpiResid E{xb1, xb, ssqA};
            pg8::gemm_phase<pg8::EpiResid, pg8::BatchOrder, true, true>(lds, g, S, E, ptid);
        }
        LBAR();


#ifndef REP_P6
#define REP_P6 1
#endif
#pragma unroll 1
        for (int rep_ = 0; rep_ < REP_P6; ++rep_) {
        if (PH(7)) {
            PHASE_ENV(); const unsigned char* wl = ws + WS_W + (size_t)L * W_LAYER; (void)wl; FRESH_TID(ptid); pg8::Gemm g{xb, (const bf16*)(wl + WO_GU), SEQ, 2 * FF, D}; pg8::BatchOrder S; S.init(2 * FF, gsz, rank);
            PG8_LAS float* side = (PG8_LAS float*)(lds + SIDE_OFF); pg8::fill_rstd(S, ssqA, side, (const int*)nullptr, (PG8_LAS float*)nullptr, ptid); __syncthreads();
            pg8::EpiSwiGLU E{side, hmid};
            pg8::gemm_phase<pg8::EpiSwiGLU, pg8::BatchOrder, true, true>(lds, g, S, E, ptid);
        }
        LBAR();

        }
        if (PH(8)) {
            PHASE_ENV(); const unsigned char* wl = ws + WS_W + (size_t)L * W_LAYER; (void)wl; FRESH_TID(ptid); pg8::Gemm g{hmid, (const bf16*)(wl + WO_DOWN), SEQ, D, FF}; pg8::BatchOrder S; S.init(D, gsz, rank);
            pg8::EpiResid E{xb, xb, ssqA};
            pg8::gemm_phase<pg8::EpiResid, pg8::BatchOrder, true, true>(lds, g, S, E, ptid);
        }
#ifndef REP_PE
#define REP_PE 1
#endif
#pragma unroll 1
        for (int rep_ = 0; rep_ < REP_PE; ++rep_)
        if (PH(9)) {
            PHASE_ENV(); const unsigned char* wl = ws + WS_W + (size_t)L * W_LAYER; (void)wl; FRESH_TID(ptid); pg8::Gemm g{pb, (const bf16*)(wl + WO_PP), SEQ, D, PLE}; pg8::BatchOrder S; S.init(D, gsz, rank);
            pg8::EpiPlain E{eb, D};
            pg8::gemm_phase<pg8::EpiPlain, pg8::BatchOrder, true, true>(lds, g, S, E, ptid);
        }
        LBAR();

        if (PH(10)) {
            PHASE_ENV(); const unsigned char* wl = ws + WS_W + (size_t)L * W_LAYER; (void)wl; FRESH_TID(ptid); pg8::Gemm g{xb, (const bf16*)(wl + WO_PG), SEQ, D, D}; pg8::BatchOrder S; S.init(D, gsz, rank);
            PG8_LAS float* side = (PG8_LAS float*)(lds + SIDE_OFF); pg8::fill_rstd(S, ssqA, side, (const int*)nullptr, (PG8_LAS float*)nullptr, ptid); __syncthreads();
            pg8::EpiPle E{side, eb, xb, xb1, ssqB};
            pg8::gemm_phase<pg8::EpiPle, pg8::BatchOrder, true, true>(lds, g, S, E, ptid);
        }
        LBAR();
    }

    if (PH(11)) { PHASE_ENV(); FRESH_TID(t_); const int lane = t_ & 63, gw = rank * NWAVES + __builtin_amdgcn_readfirstlane(t_ >> 6);
        const unsigned tmo = __hip_atomic_load((unsigned*)(ws + WS_CTL) + CW_BAR + XB_TMO, RLX_AGENT);
        for (int m = gw; m < SEQ; m += gsz * NWAVES) {
            float s = (lane < 16) ? ssqB[(size_t)m * 16 + lane] : 0.f; s = wave_sum(s);
            float rs = rsqrtf(s * (1.0f / 1024.0f) + EPS); if (tmo) rs = __builtin_nanf("");
#pragma unroll
            for (int j = 0; j < 2; ++j) { const v4u w = ((const GAS v4u*)(xb1 + (size_t)m * D))[lane + 64 * j]; const GAS f32x4* gp = (const GAS f32x4*)(a.g_final + (lane + 64 * j) * 8);
                f32x4 v0, v1; pg8::unpack8(w, v0, v1); GAS f32x4* op = (GAS f32x4*)(a.out + ((size_t)batch * SEQ + m) * D + (lane + 64 * j) * 8);
                op[0] = v0 * rs * gp[0]; op[1] = v1 * rs * gp[1]; }
        }
    }
}

extern "C" void kernel_launch(void* const* d_in, const int* in_sizes, int n_in, void* d_out, int out_size, void* d_ws, size_t ws_size, hipStream_t stream) {
    static int grid = 0;
    if (grid == 0) {
        if (n_in != 16 || in_sizes[0] != M * D || out_size != M * D || ws_size < WS_END) { fprintf(stderr, "kernel_launch: unexpected shapes (n_in %d, in0 %d, out %d, ws %zu < %zu)\n", n_in, n_in > 0 ? in_sizes[0] : -1, out_size, ws_size, (size_t)WS_END); grid = -1; return; }
        int dev = 0, cus = 0, per_cu = 0;
        if (hipGetDevice(&dev) != hipSuccess || hipDeviceGetAttribute(&cus, hipDeviceAttributeMultiprocessorCount, dev) != hipSuccess) { grid = -1; return; }
        if (hipFuncSetAttribute((const void*)fwd, hipFuncAttributeMaxDynamicSharedMemorySize, LDS_BYTES) != hipSuccess) { fprintf(stderr, "kernel_launch: hipFuncSetAttribute failed\n"); grid = -1; return; }
        if (hipOccupancyMaxActiveBlocksPerMultiprocessor(&per_cu, (const void*)fwd, NWAVES * 64, LDS_BYTES) != hipSuccess || per_cu < 1) fprintf(stderr, "kernel_launch: occupancy query reports %d\n", per_cu);
        (void)hipGetLastError();
        grid = cus;
    }
    if (grid < 0) return;
    if (hipMemsetAsync((char*)d_ws + WS_CTL, 0, CTL_ZERO_BYTES, stream) != hipSuccess) return;
    Args a{};
    a.x = (const float*)d_in[0]; a.p = (const float*)d_in[1]; a.pos = (const int*)d_in[2]; a.g_mix = (const float*)d_in[3]; a.w_in = (const float*)d_in[4]; a.pool_w = (const float*)d_in[5];
    a.pool_scale = (const float*)d_in[6]; a.w_out = (const float*)d_in[7]; a.g_ffn = (const float*)d_in[8]; a.w_gate = (const float*)d_in[9]; a.w_up = (const float*)d_in[10]; a.w_down = (const float*)d_in[11];
    a.g_ple = (const float*)d_in[12]; a.w_ple_gate = (const float*)d_in[13]; a.w_ple_proj = (const float*)d_in[14]; a.g_final = (const float*)d_in[15]; a.out = (float*)d_out; a.ws = (unsigned char*)d_ws;
    hipLaunchKernelGGL(fwd, dim3(grid), dim3(NWAVES * 64), LDS_BYTES, stream, a);
}
```

```cpp
#include <hip/hip_runtime.h>
#include <cstdio>
#include <cstdint>
namespace pg8 {
#define PG8_LAS __attribute__((address_space(3)))
typedef unsigned short bf16_t;
typedef short bf16x8 __attribute__((ext_vector_type(8)));
typedef float f32x4 __attribute__((ext_vector_type(4)));
typedef unsigned u32x4 __attribute__((ext_vector_type(4)));
constexpr int BM = 256, BK = 64, HALF = 128, HTB = HALF * BK * 2  , STAGE_BYTES = 8 * HTB, NXCD = 8, WGM = 8;

__host__ __device__ __forceinline__ int lds_byte(int r, int c) { const int st = (r >> 4) * 2 + (c >> 5), rr = r & 15, cc = c & 31, ob = rr * 64 + cc * 2; return st * 1024 + (ob ^ (((ob >> 9) & 1) << 5)); }
__host__ __device__ __forceinline__ void stage_rc(int b, int& R, int& C) { const int st = b / 1024, sb = b % 1024, swz = sb ^ (((sb >> 9) & 1) << 5); R = (st >> 1) * 16 + swz / 64; C = (st & 1) * 32 + (swz % 64) / 2; }
__host__ __device__ __forceinline__ int perm32(int rho) { const int n = rho >> 4, i = rho & 15; return 8 * (i >> 2) + 4 * n + (i & 3); }

struct Unit { int pm, pn; };
struct Gemm { const bf16_t* A; const bf16_t* Bt; int M, N, K; };

struct StaticOrder {
    int nM, nN, nwg, G, c;
    __host__ __device__ void init(int M, int N, int G_, int c_) { nM = M / BM; nN = N / BM; nwg = nM * nN; G = G_; c = c_; }
    __host__ __device__ bool next(int i, Unit& u) const {
        const long L = (long)i * G + c; if (L >= nwg) return false;
        int wgid = (int)L; { const int q = nwg / NXCD, r = nwg % NXCD, xcd = wgid % NXCD, off = wgid / NXCD; wgid = (xcd < r ? xcd * (q + 1) : r * (q + 1) + (xcd - r) * q) + off; }
        const int nig = WGM * nN, gid = wgid / nig, fm = gid * WGM, gsz = (nM - fm) < WGM ? (nM - fm) : WGM;
        u.pm = fm + ((wgid % nig) % gsz); u.pn = (wgid % nig) / gsz; return true;
    }
    __device__ __forceinline__ void a_ready(const Unit&) const {}
    __device__ __forceinline__ void done(const Unit&) const {}
};

typedef float f32x2_t __attribute__((ext_vector_type(2))); typedef __bf16 bf16x2_t __attribute__((ext_vector_type(2)));
__device__ __forceinline__ unsigned cvt_pk_bf16(float lo, float hi) { f32x2_t v = {lo, hi}; bf16x2_t b = __builtin_convertvector(v, bf16x2_t); return __builtin_bit_cast(unsigned, b); }
template <class Epi, class Sched, bool ALIGN_EPI = false, bool SP2 = false>
__device__ __forceinline__ void gemm_phase(PG8_LAS unsigned char* lds, const Gemm g, const Sched& S, const Epi& E, const int tid_in) {
    const int tid = tid_in, wid = __builtin_amdgcn_readfirstlane(tid >> 6), lane = tid & 63, wr = wid >> 2, wc = wid & 3, fr = lane & 15, fq = lane >> 4;
    const int K = g.K, nt = K / BK;
    unsigned voffA[2], voffB[2];
#pragma unroll
    for (int i = 0; i < 2; ++i) { int R, C; stage_rc(tid * 16 + i * 8192, R, C); const int Rb = Epi::PERM ? ((R & ~31) + perm32(R & 31)) : R;
        voffA[i] = (unsigned)(R * K + C) * 2u; voffB[i] = (unsigned)(Rb * K + C) * 2u; }
    const size_t kstep = (size_t)(BK * 2);
    const size_t hstep = (size_t)HALF * K * 2;
    const size_t tstep = 2 * hstep;
    const unsigned ldsw = (unsigned)wid * 1024u;
    const int aoff = lds_byte(wr * 64 + fr, fq * 8), boff = lds_byte(wc * 32 + fr, fq * 8);
#define PG8_SA(b, h) (((b) * 2 + (h)) * HTB)
#define PG8_SB(b, h) ((4 + (b) * 2 + (h)) * HTB)
#define PG8_STAGE(bufoff, gbase, voff) do { _Pragma("unroll") for (int _i = 0; _i < 2; ++_i) \
        __builtin_amdgcn_global_load_lds((const unsigned*)((const char*)(gbase) + (voff)[_i]), (PG8_LAS unsigned*)(lds + (bufoff) + ldsw + _i * 8192), 16, 0, 0); } while (0)
#define PG8_LDA(dst, b, h) do { _Pragma("unroll") for (int m = 0; m < 4; ++m) _Pragma("unroll") for (int k = 0; k < 2; ++k) dst[m][k] = *(const PG8_LAS bf16x8*)(lds + PG8_SA(b, h) + aoff + m * 2048 + k * 1024); } while (0)
#define PG8_LDB(dst, b, h) do { _Pragma("unroll") for (int n = 0; n < 2; ++n) _Pragma("unroll") for (int k = 0; k < 2; ++k) dst[n][k] = *(const PG8_LAS bf16x8*)(lds + PG8_SB(b, h) + boff + n * 2048 + k * 1024); } while (0)
#define PG8_MMA(ai, bj, At, Bt) do { __builtin_amdgcn_s_setprio(1); _Pragma("unroll") for (int m = 0; m < 4; ++m) _Pragma("unroll") for (int n = 0; n < 2; ++n) _Pragma("unroll") for (int k = 0; k < 2; ++k) \
        acc[ai][bj][m][n] = __builtin_amdgcn_mfma_f32_16x16x32_bf16(Bt[n][k], At[m][k], acc[ai][bj][m][n], 0, 0, 0); __builtin_amdgcn_s_setprio(0); } while (0)
#define PG8_WAIT_V(n) asm volatile("s_waitcnt vmcnt(" #n ")" ::: "memory")
#define PG8_WAIT_L(n) asm volatile("s_waitcnt lgkmcnt(" #n ")" ::: "memory")
#define PG8_BAR __builtin_amdgcn_s_barrier()
#define PG8_SCHED __builtin_amdgcn_sched_barrier(0)
    Unit cur, nxt; int ui = 0;
    if (!S.next(0, cur)) return;
    f32x4 acc[2][2][4][2];
    E.init(acc, cur, wr, wc, fr, fq);
    bf16x8 At[4][2], B0[2][2], B1[2][2];
    const char* cA = (const char*)g.A + (size_t)cur.pm * tstep; const char* cB = (const char*)g.Bt + (size_t)cur.pn * tstep;
    S.a_ready(cur);
    if constexpr (SP2) {
        PG8_STAGE(PG8_SB(0, 0), cB, voffB); PG8_STAGE(PG8_SB(0, 1), cB + hstep, voffB); PG8_STAGE(PG8_SA(0, 0), cA, voffA); PG8_STAGE(PG8_SA(0, 1), cA + hstep, voffA);
        if (wr == 1) PG8_BAR;
        PG8_WAIT_V(2); PG8_BAR;
        PG8_STAGE(PG8_SB(1, 0), cB + kstep, voffB); PG8_STAGE(PG8_SA(1, 0), cA + kstep, voffA); PG8_STAGE(PG8_SB(1, 1), cB + hstep + kstep, voffB);
        PG8_WAIT_V(6); PG8_BAR;
    } else {
        PG8_STAGE(PG8_SB(0, 0), cB, voffB); PG8_STAGE(PG8_SA(0, 0), cA, voffA); PG8_STAGE(PG8_SB(0, 1), cB + hstep, voffB); PG8_STAGE(PG8_SA(0, 1), cA + hstep, voffA);
        if (wr == 1) PG8_BAR;
        PG8_WAIT_V(4); PG8_BAR;
        PG8_STAGE(PG8_SB(1, 0), cB + kstep, voffB); PG8_STAGE(PG8_SA(1, 0), cA + kstep, voffA); PG8_STAGE(PG8_SB(1, 1), cB + hstep + kstep, voffB);
        PG8_WAIT_V(6); PG8_BAR;
    }
    for (;;) {
        const bool has_next = S.next(ui + 1, nxt);
        const char* nA = has_next ? (const char*)g.A + (size_t)nxt.pm * tstep : cA; const char* nB = has_next ? (const char*)g.Bt + (size_t)nxt.pn * tstep : cB;
#pragma unroll 1
        for (int t = 0; t < nt; t += 2) {
            const bool last = (t == nt - 2);
            const char* a1 = cA + (size_t)(t + 1) * kstep;
            const char* a2 = last ? nA : cA + (size_t)(t + 2) * kstep; const char* b2 = last ? nB : cB + (size_t)(t + 2) * kstep;
            const char* a3 = a2 + kstep; const char* b3 = b2 + kstep;
            if (last && has_next) S.a_ready(nxt);
            if constexpr (SP2) {
            PG8_LDB(B0, 0, 0); PG8_LDB(B1, 0, 1); PG8_SCHED; PG8_LDA(At, 0, 0); PG8_STAGE(PG8_SA(1, 1), a1 + hstep, voffA);
            PG8_WAIT_V(8); PG8_WAIT_L(0); PG8_BAR; PG8_MMA(0, 0, At, B0); PG8_MMA(0, 1, At, B1); PG8_BAR; PG8_SCHED;
            PG8_LDA(At, 0, 1); PG8_STAGE(PG8_SB(0, 0), b2, voffB); PG8_STAGE(PG8_SB(0, 1), b2 + hstep, voffB); PG8_STAGE(PG8_SA(0, 0), a2, voffA);
            PG8_WAIT_V(8); PG8_WAIT_L(0); PG8_BAR; PG8_MMA(1, 0, At, B0); PG8_MMA(1, 1, At, B1); PG8_BAR; PG8_SCHED;
            PG8_LDB(B0, 1, 0); PG8_LDB(B1, 1, 1); PG8_SCHED; PG8_LDA(At, 1, 0); PG8_STAGE(PG8_SA(0, 1), a2 + hstep, voffA);
            PG8_WAIT_V(8); PG8_WAIT_L(0); PG8_BAR; PG8_MMA(0, 0, At, B0); PG8_MMA(0, 1, At, B1); PG8_BAR; PG8_SCHED;
            PG8_LDA(At, 1, 1); PG8_STAGE(PG8_SB(1, 0), b3, voffB); PG8_STAGE(PG8_SB(1, 1), b3 + hstep, voffB); PG8_STAGE(PG8_SA(1, 0), a3, voffA);
            PG8_WAIT_V(8); PG8_WAIT_L(0); PG8_BAR; PG8_MMA(1, 0, At, B0); PG8_MMA(1, 1, At, B1); PG8_BAR; PG8_SCHED;
            } else {
            PG8_LDB(B0, 0, 0); PG8_SCHED; PG8_LDA(At, 0, 0); PG8_STAGE(PG8_SA(1, 1), a1 + hstep, voffA);
            PG8_WAIT_L(8); PG8_BAR; PG8_WAIT_L(0); PG8_MMA(0, 0, At, B0); PG8_BAR; PG8_SCHED;
            PG8_LDB(B1, 0, 1); PG8_STAGE(PG8_SB(0, 0), b2, voffB);
            PG8_BAR; PG8_WAIT_L(0); PG8_MMA(0, 1, At, B1); PG8_BAR;
            PG8_LDA(At, 0, 1); PG8_STAGE(PG8_SA(0, 0), a2, voffA);
            PG8_BAR; PG8_WAIT_L(0); PG8_MMA(1, 0, At, B0); PG8_BAR; PG8_SCHED;
            PG8_STAGE(PG8_SB(0, 1), b2 + hstep, voffB);
            PG8_WAIT_V(6); PG8_BAR; PG8_MMA(1, 1, At, B1); PG8_BAR;
            PG8_LDB(B0, 1, 0); PG8_SCHED; PG8_LDA(At, 1, 0); PG8_STAGE(PG8_SA(0, 1), a2 + hstep, voffA);
            PG8_WAIT_L(8); PG8_BAR; PG8_WAIT_L(0); PG8_MMA(0, 0, At, B0); PG8_BAR; PG8_SCHED;
            PG8_LDB(B1, 1, 1); PG8_STAGE(PG8_SB(1, 0), b3, voffB);
            PG8_BAR; PG8_WAIT_L(0); PG8_MMA(0, 1, At, B1); PG8_BAR;
            PG8_LDA(At, 1, 1); PG8_STAGE(PG8_SA(1, 0), a3, voffA);
            PG8_BAR; PG8_WAIT_L(0); PG8_MMA(1, 0, At, B0); PG8_BAR; PG8_SCHED;
            PG8_STAGE(PG8_SB(1, 1), b3 + hstep, voffB);
            PG8_WAIT_V(6); PG8_BAR; PG8_MMA(1, 1, At, B1); PG8_BAR;
            }
        }
        if constexpr (ALIGN_EPI) { if (wr == 0) PG8_BAR; }
        if constexpr (!Epi::AFTER_DRAIN) { E(acc, cur, wr, wc, fr, fq, ui); S.done(cur); }
        if (!has_next) break;
        E.init(acc, nxt, wr, wc, fr, fq);
        cur = nxt; cA = nA; cB = nB; ++ui;
        if constexpr (ALIGN_EPI) { if (wr == 1) PG8_BAR; }
    }
    PG8_WAIT_V(0);
    if constexpr (!ALIGN_EPI) { if (wr == 0) PG8_BAR; }
    PG8_BAR;
    if constexpr (Epi::AFTER_DRAIN) { E.fused(acc, cur, wr, wc, fr, fq, lds, wid, lane); S.done(cur); }
#undef PG8_SA
#undef PG8_SB
#undef PG8_STAGE
#undef PG8_LDA
#undef PG8_LDB
#undef PG8_MMA
#undef PG8_WAIT_V
#undef PG8_WAIT_L
#undef PG8_BAR
#undef PG8_SCHED
}
}

constexpr int BATCH = 8, SEQ = 4096, D = 1024, DEPTH = 4, M = BATCH * SEQ;
constexpr int NH = 4, DH = 128, RW = 512, CHUNK = 128, NCH = SEQ / CHUNK;
constexpr int INW = 2560, FF = 2816, PLE = 256;
constexpr float EPS = 1e-6f;
constexpr int NWAVES = 8;

constexpr size_t MiB = 1u << 20;
constexpr size_t WS_CTL = 0, CTL_ZERO_BYTES = 1 * MiB;
constexpr size_t WS_SSQA = 1 * MiB, WS_SSQB = 3 * MiB;
constexpr size_t WS_W = 8 * MiB, W_LAYER = 26 * MiB;
constexpr size_t WO_IN = 0, WO_OUT = 5 * MiB, WO_GU = 7 * MiB, WO_DOWN = 18 * MiB, WO_PG = 18 * MiB + 5632 * 1024, WO_PP = WO_PG + 2 * MiB;
static_assert(WO_PP + 512 * 1024 == W_LAYER, "weight map");
constexpr size_t WS_XB = 112 * MiB;
constexpr size_t WS_PB = 176 * MiB;
constexpr size_t WS_R = 192 * MiB;
constexpr size_t R_BATCH = 32 * MiB;
constexpr size_t R_Q = 0, R_K = 4 * MiB, R_V = 8 * MiB, R_G = 12 * MiB, R_UW = 16 * MiB, R_KV = 20 * MiB, R_MIX = 24 * MiB;
constexpr size_t R_H = 0, R_E = 24 * MiB, R_UT = 0;
constexpr size_t WS_XB1 = WS_R + 256 * MiB;
constexpr size_t WS_END = WS_XB1 + 64 * MiB;
static_assert((size_t)SEQ * FF * 2 <= R_MIX && R_MIX + (size_t)SEQ * D * 2 == R_BATCH, "per-batch scratch map");
constexpr int CW_BAR = 4096;

constexpr int RING_BYTES = 131072;
constexpr int LDSCTL_OFF = RING_BYTES, MISC_OFF = LDSCTL_OFF + 320;
constexpr int SIDE_OFF = LDSCTL_OFF + 1024;
constexpr int LDS_BYTES = 147456;

#define GAS __attribute__((address_space(1)))
#define LAS __attribute__((address_space(3)))
typedef unsigned short bf16;
typedef unsigned v4u __attribute__((ext_vector_type(4)));
typedef unsigned v2u __attribute__((ext_vector_type(2)));
typedef float f32x4 __attribute__((ext_vector_type(4)));
typedef float f32x16 __attribute__((ext_vector_type(16)));
typedef short bf16x8 __attribute__((ext_vector_type(8)));
typedef short s16x4 __attribute__((ext_vector_type(4)));
typedef GAS unsigned gu32;
#define RLX_AGENT __ATOMIC_RELAXED, __HIP_MEMORY_SCOPE_AGENT
#define LDS_WAIT() asm volatile("s_waitcnt lgkmcnt(0)" ::: "memory")
#define VM_WAIT() asm volatile("s_waitcnt vmcnt(0)" ::: "memory")
__device__ __forceinline__ unsigned f2bf(float f) { unsigned u = __builtin_bit_cast(unsigned, f); return (u + 0x7fffu + ((u >> 16) & 1u)) >> 16; }
__device__ __forceinline__ unsigned pk2(float lo, float hi) { return f2bf(lo) | (f2bf(hi) << 16); }
__device__ __forceinline__ float bf_lo(unsigned w) { return __builtin_bit_cast(float, w << 16); }
__device__ __forceinline__ float bf_hi(unsigned w) { return __builtin_bit_cast(float, w & 0xffff0000u); }

__device__ const float ROPE_HI[64] = {1.591186523e-01f, 1.378173828e-01f, 1.193237305e-01f, 1.033325195e-01f, 8.947753906e-02f, 7.748413086e-02f, 6.710815430e-02f, 5.810546875e-02f, 5.032348633e-02f, 4.357910156e-02f, 3.773498535e-02f, 3.266906738e-02f, 2.829742432e-02f, 2.450561523e-02f, 2.121734619e-02f, 1.837158203e-02f, 1.591491699e-02f, 1.377868652e-02f, 1.193237305e-02f, 1.033401489e-02f, 8.949279785e-03f, 7.749557495e-03f, 6.710052490e-03f, 5.811691284e-03f, 5.031585693e-03f, 4.358291626e-03f, 3.773689270e-03f, 3.268241882e-03f, 2.829551697e-03f, 2.449989319e-03f, 2.121925354e-03f, 1.837730408e-03f, 1.591205597e-03f, 1.378059387e-03f, 1.193046570e-03f, 1.033306122e-03f, 8.947849274e-04f, 7.748603821e-04f, 6.711483002e-04f, 5.810260773e-04f, 5.030632019e-04f, 4.358291626e-04f, 3.772974014e-04f, 3.267526627e-04f, 2.830028534e-04f, 2.449750900e-04f, 2.121925354e-04f, 1.837611198e-04f, 1.591444016e-04f, 1.378059387e-04f, 1.193284988e-04f, 1.033246517e-04f, 8.949637413e-05f, 7.748603821e-05f, 6.711483002e-05f, 5.811452866e-05f, 5.032122135e-05f, 4.357099533e-05f, 3.772974014e-05f, 3.267824650e-05f, 2.829730511e-05f, 2.450495958e-05f, 2.121925354e-05f, 1.837313175e-05f};
__device__ const float ROPE_LO[64] = {3.629074854e-05f, 5.119791695e-06f, 2.563974340e-05f, 1.977708780e-05f, 2.186254642e-05f, 1.915789653e-05f, 6.928708444e-06f, 1.379869173e-05f, 5.725776191e-06f, 4.200542662e-06f, 6.599365861e-06f, 1.379848982e-05f, 4.771514341e-06f, 3.076627763e-06f, 6.306573596e-06f, 7.344074220e-06f, 5.773169960e-07f, 3.563736982e-06f, 2.563974249e-06f, 1.214769213e-06f, 6.603757470e-07f, 7.713804280e-07f, 1.455810320e-06f, 2.354600070e-07f, 1.335517140e-06f, 3.858455244e-08f, 4.692017228e-07f, 4.470491177e-08f, 6.678862974e-07f, 8.798673434e-07f, 4.399224736e-07f, 1.622028520e-07f, 3.438339888e-07f, 1.656388378e-07f, 4.471322939e-07f, 2.168443558e-07f, 2.090887250e-07f, 1.725054801e-07f, 2.529881415e-09f, 1.665971467e-07f, 2.289191343e-07f, 3.858455333e-09f, 1.184457474e-07f, 7.599606278e-08f, 1.910491321e-08f, 1.118285908e-07f, 4.399224807e-08f, 2.814121380e-08f, 1.054154186e-08f, 1.656388271e-08f, 2.087137041e-08f, 2.764489970e-08f, 3.027478712e-09f, 1.725054766e-08f, 2.529881304e-10f, 4.738785808e-09f, 7.990752948e-09f, 1.230677427e-08f, 1.184457421e-08f, 4.619374216e-09f, 4.890723382e-09f, 3.732278930e-09f, 4.399224540e-09f, 5.794353886e-09f};
__device__ __forceinline__ float lg2gamma(int h) { return h == 0 ? -0.04580368961312479f : h == 1 ? -0.02272007650008353f : h == 2 ? -0.011315313227834146f : -0.005646563141142063f; }

__device__ __forceinline__ float add_xor16(float v) { return v + __builtin_bit_cast(float, __builtin_amdgcn_ds_swizzle(__builtin_bit_cast(int, v), 0x401F)); }
__device__ __forceinline__ float add_xor32(float v) { float a_ = v, b_ = v; asm volatile("s_nop 1\n\tv_permlane32_swap_b32 %0, %1" : "+v"(a_), "+v"(b_)); return a_ + b_; }
namespace pg8 {
#ifndef BO_GRP
#define BO_GRP 8
#endif
struct BatchOrder {
    int nN, gsize, rank, nwg;
    __device__ __forceinline__ void init(int N, int gsize_, int rank_) { nN = N / BM; gsize = gsize_; rank = rank_; nwg = 16 * nN; }
    __device__ __forceinline__ bool next(int i, Unit& u) const {
        const int L = i * gsize + rank; if (L >= nwg) return false;
#if defined(BO_ORDER) && BO_ORDER == 1
        const int nb = nN >> 2;
        if (L < nb * 64) { const int q = L >> 6, r = L & 63, g = r >> 5, w = r & 31; u.pm = 8 * g + (w & 7); u.pn = 4 * q + (w >> 3); }
        else { const int Lt = L - nb * 64, rem = nN - 4 * nb, g = Lt / (8 * rem), w = Lt - g * 8 * rem; u.pm = 8 * g + (w & 7); u.pn = 4 * nb + (w >> 3); }
        return true;
#else
        const int grp = L / (BO_GRP * nN), r = L - grp * BO_GRP * nN; u.pm = BO_GRP * grp + (r % BO_GRP); u.pn = r / BO_GRP; return true;
#endif
    }
    __device__ __forceinline__ void a_ready(const Unit&) const {}
    __device__ __forceinline__ void done(const Unit&) const {}
};
__device__ __forceinline__ void load_rstd(const PG8_LAS float* side, int ui, int wr, int fr, float (&rs)[2][4]) {
#pragma unroll
    for (int ai = 0; ai < 2; ++ai)
#pragma unroll
        for (int m = 0; m < 4; ++m) rs[ai][m] = side[ui * 256 + ai * HALF + wr * 64 + m * 16 + fr];
}
template <class Sched> __device__ __forceinline__ void fill_rstd(const Sched& S, const float* ssq, PG8_LAS float* side, const int* pos, PG8_LAS float* posf, int tid) {
    Unit u;
    for (int i = 0; S.next(i, u); ++i) {
        const int row = u.pm * BM + (tid >> 1), hf = tid & 1;
        const f32x4 a = *(const f32x4*)(ssq + (size_t)row * 16 + 8 * hf), b = *(const f32x4*)(ssq + (size_t)row * 16 + 8 * hf + 4);
        float s = ((a[0] + a[1]) + (a[2] + a[3])) + ((b[0] + b[1]) + (b[2] + b[3]));
        s += __builtin_bit_cast(float, __builtin_amdgcn_ds_swizzle(__builtin_bit_cast(int, s), 0x041F));
        if (hf == 0) { side[i * 256 + (tid >> 1)] = rsqrtf(s * (1.0f / 1024.0f) + 1e-6f); if (pos) posf[i * 256 + (tid >> 1)] = (float)pos[row]; }
    }
}
#ifndef WTM
#define WTM 0
#endif
template <int BIT> __device__ __forceinline__ void st16(void* p, const u32x4 v) {
    if constexpr ((WTM >> BIT) & 1) asm volatile("global_store_dwordx4 %0, %1, off sc1\n\ts_nop 0" :: "v"(p), "v"(v) : "memory");
    else *(u32x4*)p = v;
}
__device__ __forceinline__ u32x4 pack8(const f32x4 a, const f32x4 b) { u32x4 w; w.x = cvt_pk_bf16(a[0], a[1]); w.y = cvt_pk_bf16(a[2], a[3]); w.z = cvt_pk_bf16(b[0], b[1]); w.w = cvt_pk_bf16(b[2], b[3]); return w; }

struct EpiInProj {
    static constexpr bool PERM = true, AFTER_DRAIN = false;
    const PG8_LAS float* side; const PG8_LAS float* posf; const PG8_LAS float* rope; bf16_t *q, *k, *v, *g, *uw;
    __device__ __forceinline__ void init(f32x4 (&acc)[2][2][4][2], const Unit&, int, int, int, int) const {
#pragma unroll
        for (int a = 0; a < 2; ++a)
#pragma unroll
            for (int b = 0; b < 2; ++b)
#pragma unroll
                for (int m = 0; m < 4; ++m)
#pragma unroll
                    for (int n = 0; n < 2; ++n) acc[a][b][m][n] = (f32x4){0.f, 0.f, 0.f, 0.f};
    }
    __device__ __forceinline__ void operator()(const f32x4 (&acc)[2][2][4][2], const Unit& u, int wr, int wc, int fr, int fq, int ui) const {
        const int rowbase = u.pm * BM + wr * 64 + fr;
        float rs[2][4]; load_rstd(side, ui, wr, fr, rs);
        if (u.pn < 4) {
            const int sec = u.pn >> 1, head = 2 * (u.pn & 1) + (wc >> 1), dd0 = 32 * (wc & 1) + 8 * fq;
            bf16_t* dst = sec ? k : q;
            const f32x4 h0 = *(const PG8_LAS f32x4*)(rope + dd0), h1 = *(const PG8_LAS f32x4*)(rope + dd0 + 4), l0 = *(const PG8_LAS f32x4*)(rope + 64 + dd0), l1 = *(const PG8_LAS f32x4*)(rope + 64 + dd0 + 4);
            const float lg = lg2gamma(head);
#pragma unroll
            for (int ai = 0; ai < 2; ++ai)
#pragma unroll
                for (int m = 0; m < 4; ++m) {
                    const int row = rowbase + ai * HALF + m * 16, b = row >> 12, s = row & 4095;
                    const float p = posf[ui * 256 + ai * HALF + wr * 64 + m * 16 + fr];
                    const float sc = rs[ai][m] * (sec ? __builtin_amdgcn_exp2f((float)(127 - (s & 127)) * lg) : 1.0f);
                    f32x4 o1[2], o2[2];
#pragma unroll
                    for (int n = 0; n < 2; ++n) { const f32x4 fh = n ? h1 : h0, fl = n ? l1 : l0;
#pragma unroll
                        for (int j = 0; j < 4; ++j) { const float ph = p * fh[j]; const float rev = (ph - __builtin_floorf(ph)) + p * fl[j];
                            const float cs = __builtin_amdgcn_cosf(rev), sn = __builtin_amdgcn_sinf(rev);
                            const float x1 = acc[ai][0][m][n][j] * sc, x2 = acc[ai][1][m][n][j] * sc;
                            o1[n][j] = x1 * cs - x2 * sn; o2[n][j] = x2 * cs + x1 * sn; } }
                    bf16_t* rp = dst + ((size_t)((b * NH_ + head) * SEQ_ + s)) * 128 + dd0;
                    st16<0>(rp, pack8(o1[0], o1[1])); st16<0>((rp + 64), pack8(o2[0], o2[1]));
                    asm volatile("" ::: "memory");
                }
        } else {
            const int sec = (u.pn - 4) >> 1;
            const int c0 = 256 * (u.pn & 1) + 32 * wc + 8 * fq;
#pragma unroll
            for (int ai = 0; ai < 2; ++ai)
#pragma unroll
                for (int m = 0; m < 4; ++m) {
                    const int row = rowbase + ai * HALF + m * 16, b = row >> 12, s = row & 4095; const float sc = rs[ai][m];
#pragma unroll
                    for (int bj = 0; bj < 2; ++bj) { const u32x4 w = pack8(acc[ai][bj][m][0] * sc, acc[ai][bj][m][1] * sc); const int c = c0 + 128 * bj;
                        if (sec == 2) st16<0>((uw + (size_t)row * 512 + c), w);
                        else { bf16_t* dst = sec ? g : v; st16<0>((dst + ((size_t)((b * NH_ + (c >> 7)) * SEQ_ + s)) * 128 + (c & 127)), w); } }
                }
        }
    }
    static constexpr int NH_ = 4, SEQ_ = 4096;
};

__device__ __forceinline__ void unpack8(const u32x4 w, f32x4& a, f32x4& b) {
    a[0] = __builtin_bit_cast(float, w.x << 16); a[1] = __builtin_bit_cast(float, w.x & 0xffff0000u); a[2] = __builtin_bit_cast(float, w.y << 16); a[3] = __builtin_bit_cast(float, w.y & 0xffff0000u);
    b[0] = __builtin_bit_cast(float, w.z << 16); b[1] = __builtin_bit_cast(float, w.z & 0xffff0000u); b[2] = __builtin_bit_cast(float, w.w << 16); b[3] = __builtin_bit_cast(float, w.w & 0xffff0000u);
}
struct EpiResid {
    static constexpr bool PERM = true, AFTER_DRAIN = false;
    const bf16_t* xin; bf16_t* xout; float* ssq_out;
    __device__ __forceinline__ void init(f32x4 (&acc)[2][2][4][2], const Unit& u, int wr, int wc, int fr, int fq) const {
        const int rowbase = u.pm * BM + wr * 64 + fr, col0 = u.pn * BM + 32 * wc + 8 * fq;
        u32x4 w[2][4][2];
#pragma unroll
        for (int ai = 0; ai < 2; ++ai)
#pragma unroll
            for (int m = 0; m < 4; ++m)
#pragma unroll
                for (int bj = 0; bj < 2; ++bj) w[ai][m][bj] = *(const u32x4*)(xin + (size_t)(rowbase + ai * HALF + m * 16) * 1024 + col0 + bj * HALF);
#pragma unroll
        for (int ai = 0; ai < 2; ++ai)
#pragma unroll
            for (int m = 0; m < 4; ++m)
#pragma unroll
                for (int bj = 0; bj < 2; ++bj) unpack8(w[ai][m][bj], acc[ai][bj][m][0], acc[ai][bj][m][1]);
    }
    __device__ __forceinline__ void operator()(const f32x4 (&acc)[2][2][4][2], const Unit& u, int wr, int wc, int fr, int fq, int) const {
        const int rowbase = u.pm * BM + wr * 64 + fr, col0 = u.pn * BM + 32 * wc + 8 * fq;
#pragma unroll
        for (int ai = 0; ai < 2; ++ai)
#pragma unroll
            for (int m = 0; m < 4; ++m) {
                const int row = rowbase + ai * HALF + m * 16; const size_t off = (size_t)row * 1024 + col0; float ss = 0.f;
#pragma unroll
                for (int bj = 0; bj < 2; ++bj) {
                    const f32x4 v0 = acc[ai][bj][m][0], v1 = acc[ai][bj][m][1];
                    st16<1>((xout + off + bj * HALF), pack8(v0, v1));
                    ss += (v0[0] * v0[0] + v0[1] * v0[1]) + (v0[2] * v0[2] + v0[3] * v0[3]) + (v1[0] * v1[0] + v1[1] * v1[1]) + (v1[2] * v1[2] + v1[3] * v1[3]); }
                ss = add_xor32(add_xor16(ss));
                if (fq == 0) ssq_out[(size_t)row * 16 + u.pn * 4 + wc] = ss;
            }
    }
};

struct EpiSwiGLU {
    static constexpr bool PERM = true, AFTER_DRAIN = false;
    const PG8_LAS float* side; bf16_t* h;
    __device__ __forceinline__ void init(f32x4 (&acc)[2][2][4][2], const Unit&, int, int, int, int) const {
#pragma unroll
        for (int a = 0; a < 2; ++a)
#pragma unroll
            for (int b = 0; b < 2; ++b)
#pragma unroll
                for (int m = 0; m < 4; ++m)
#pragma unroll
                    for (int n = 0; n < 2; ++n) acc[a][b][m][n] = (f32x4){0.f, 0.f, 0.f, 0.f};
    }
    __device__ __forceinline__ void operator()(const f32x4 (&acc)[2][2][4][2], const Unit& u, int wr, int wc, int fr, int fq, int ui) const {
        const int rowbase = u.pm * BM + wr * 64 + fr, col0 = u.pn * HALF + 32 * wc + 8 * fq;
        float rs[2][4]; load_rstd(side, ui, wr, fr, rs);
#pragma unroll
        for (int ai = 0; ai < 2; ++ai)
#pragma unroll
            for (int m = 0; m < 4; ++m) { const float sc = rs[ai][m], c1 = -1.4426950408889634f * sc, sc2 = sc * sc; f32x4 o[2];
#pragma unroll
                for (int n = 0; n < 2; ++n)
#pragma unroll
                    for (int jp = 0; jp < 2; ++jp) { const f32x2_t av = {acc[ai][0][m][n][2 * jp], acc[ai][0][m][n][2 * jp + 1]}, bv = {acc[ai][1][m][n][2 * jp], acc[ai][1][m][n][2 * jp + 1]};
                        const f32x2_t t = av * c1; f32x2_t ex; ex.x = __builtin_amdgcn_exp2f(t.x); ex.y = __builtin_amdgcn_exp2f(t.y);
                        const f32x2_t d = ex + 1.0f; f32x2_t r; r.x = __builtin_amdgcn_rcpf(d.x); r.y = __builtin_amdgcn_rcpf(d.y);
                        const f32x2_t ov = (av * bv) * (r * sc2); o[n][2 * jp] = ov.x; o[n][2 * jp + 1] = ov.y; }
                st16<2>((h + (size_t)(rowbase + ai * HALF + m * 16) * 2816 + col0), pack8(o[0], o[1])); }
    }
};

struct EpiPlain {
    static constexpr bool PERM = true, AFTER_DRAIN = false;
    bf16_t* O; int ldc;
    __device__ __forceinline__ void init(f32x4 (&acc)[2][2][4][2], const Unit&, int, int, int, int) const {
#pragma unroll
        for (int a = 0; a < 2; ++a)
#pragma unroll
            for (int b = 0; b < 2; ++b)
#pragma unroll
                for (int m = 0; m < 4; ++m)
#pragma unroll
                    for (int n = 0; n < 2; ++n) acc[a][b][m][n] = (f32x4){0.f, 0.f, 0.f, 0.f};
    }
    __device__ __forceinline__ void operator()(const f32x4 (&acc)[2][2][4][2], const Unit& u, int wr, int wc, int fr, int fq, int) const {
        const int rowbase = u.pm * BM + wr * 64 + fr, col0 = u.pn * BM + 32 * wc + 8 * fq;
#pragma unroll
        for (int ai = 0; ai < 2; ++ai)
#pragma unroll
            for (int m = 0; m < 4; ++m)
#pragma unroll
                for (int bj = 0; bj < 2; ++bj) st16<3>((O + (size_t)(rowbase + ai * HALF + m * 16) * ldc + col0 + bj * HALF), pack8(acc[ai][bj][m][0], acc[ai][bj][m][1]));
    }
};

struct EpiPle {
    static constexpr bool PERM = true, AFTER_DRAIN = false;
    const PG8_LAS float* side; const bf16_t* e; const bf16_t* xin; bf16_t* xout; float* ssq_out;
    __device__ __forceinline__ void init(f32x4 (&acc)[2][2][4][2], const Unit&, int, int, int, int) const {
#pragma unroll
        for (int a = 0; a < 2; ++a)
#pragma unroll
            for (int b = 0; b < 2; ++b)
#pragma unroll
                for (int m = 0; m < 4; ++m)
#pragma unroll
                    for (int n = 0; n < 2; ++n) acc[a][b][m][n] = (f32x4){0.f, 0.f, 0.f, 0.f};
    }
    __device__ __forceinline__ void operator()(const f32x4 (&acc)[2][2][4][2], const Unit& u, int wr, int wc, int fr, int fq, int ui) const {
        const int rowbase = u.pm * BM + wr * 64 + fr, col0 = u.pn * BM + 32 * wc + 8 * fq;
        float rs[2][4]; load_rstd(side, ui, wr, fr, rs);
#pragma unroll
        for (int ai = 0; ai < 2; ++ai)
#pragma unroll
            for (int m = 0; m < 4; ++m) {
                const int row = rowbase + ai * HALF + m * 16; const size_t off = (size_t)row * 1024 + col0; float ss = 0.f; const float sc = -1.4426950408889634f * rs[ai][m];
#pragma unroll
                for (int bj = 0; bj < 2; ++bj) {
                    f32x4 e0, e1, x0, x1; unpack8(*(const u32x4*)(e + off + bj * HALF), e0, e1); unpack8(*(const u32x4*)(xin + off + bj * HALF), x0, x1);
                    f32x4 v0, v1;
#pragma unroll
                    for (int j = 0; j < 4; ++j) {
                        v0[j] = x0[j] + __builtin_amdgcn_rcpf(1.0f + __builtin_amdgcn_exp2f(sc * acc[ai][bj][m][0][j])) * e0[j];
                        v1[j] = x1[j] + __builtin_amdgcn_rcpf(1.0f + __builtin_amdgcn_exp2f(sc * acc[ai][bj][m][1][j])) * e1[j]; }
                    st16<4>((xout + off + bj * HALF), pack8(v0, v1));
                    ss += (v0[0] * v0[0] + v0[1] * v0[1]) + (v0[2] * v0[2] + v0[3] * v0[3]) + (v1[0] * v1[0] + v1[1] * v1[1]) + (v1[2] * v1[2] + v1[3] * v1[3]); }
                ss = add_xor32(add_xor16(ss));
                if (fq == 0) ssq_out[(size_t)row * 16 + u.pn * 4 + wc] = ss;
            }
    }
};
}
#define XB_TMO      128
#define XB_XCNT(j)  (256  + 64 * (j))
#define XB_XSUB(j)  (1280 + 64 * (j))
#define XB_XGEN(j)  (2304 + 64 * (j))
#define XB_TOP      3328
#define XB_TOPGEN   3392
#define XCD_BAR_WORDS 3456
#define XB_SPIN_CAP (1u << 18)

__device__ __forceinline__ unsigned xb_ld(unsigned* p)              { return __hip_atomic_load(p, __ATOMIC_RELAXED, __HIP_MEMORY_SCOPE_AGENT); }
__device__ __forceinline__ unsigned xb_add(unsigned* p, unsigned v) { return __hip_atomic_fetch_add(p, v, __ATOMIC_RELAXED, __HIP_MEMORY_SCOPE_AGENT); }
__device__ __forceinline__ unsigned xb_xcc_id() { return (unsigned)__builtin_amdgcn_s_getreg((3 << 11) | 20) & 0xFu; }
#define XB_SPIN(cond, bar) do { unsigned _sp = 0; while (cond) { __builtin_amdgcn_s_sleep(1); \
    if ((++_sp & 255u) == 0u) { if (xb_ld(&(bar)[XB_TMO])) break; if (_sp > XB_SPIN_CAP) { atomicAdd(&(bar)[XB_TMO], 1u); break; } } } } while (0)

struct XcdBarrier {
    unsigned* bar; unsigned x;
    volatile LAS unsigned* st;
};

__device__ __forceinline__ XcdBarrier xcd_barrier_post(unsigned* bar, volatile LAS unsigned* st) {
    XcdBarrier b; b.bar = bar; b.x = xb_xcc_id(); b.st = st;
    if (threadIdx.x == 0) st[2] = xb_add(&bar[XB_XCNT(b.x)], 1u);
    return b;
}
__device__ __forceinline__ void xcd_barrier_complete(unsigned* bar, unsigned x, unsigned& nloc, unsigned& nx) {
    const unsigned G = gridDim.x * gridDim.y * gridDim.z;
    unsigned sum, cnt, mine, sp = 0u;
    for (;;) {
        sum = 0u; cnt = 0u; mine = 0u;
#pragma unroll
        for (unsigned j = 0; j < 16; ++j) { const unsigned c = xb_ld(&bar[XB_XCNT(j)]); sum += c; cnt += (c > 0u) ? 1u : 0u; mine = (j == x) ? c : mine; }
        if (sum == G) break;
        __builtin_amdgcn_s_sleep(1);
        if ((++sp & 255u) == 0u) { if (xb_ld(&bar[XB_TMO])) break; if (sp > XB_SPIN_CAP) { atomicAdd(&bar[XB_TMO], 1u); break; } }
    }
    nloc = mine > 0u ? mine : 1u; nx = cnt > 0u ? cnt : 1u;
}

__device__ __forceinline__ void xcd_barrier(const XcdBarrier& b) {
    asm volatile("s_waitcnt vmcnt(0)" ::: "memory");
    __syncthreads();
    if (threadIdx.x == 0) {
        unsigned* bar = b.bar; unsigned bx_ = b.x; asm volatile("" : "+s"(bar), "+s"(bx_));
        __builtin_amdgcn_s_waitcnt(0);
        unsigned nloc = b.st[0], nx = b.st[1];
        if (nloc == 0u) { xcd_barrier_complete(bar, bx_, nloc, nx); b.st[0] = nloc; b.st[1] = nx; }
        const unsigned old = xb_add(&bar[XB_XSUB(bx_)], 1u);
        const unsigned gen = old / nloc;
        if (old + 1u == (gen + 1u) * nloc) {
            __builtin_amdgcn_fence(__ATOMIC_RELEASE, "agent");
            asm volatile("s_waitcnt vmcnt(0)" ::: "memory");
            const unsigned og = xb_add(&bar[XB_TOP], 1u);
            const unsigned tg = og / nx;
            if (og + 1u == (tg + 1u) * nx) xb_add(&bar[XB_TOPGEN], 1u);
            else XB_SPIN(xb_ld(&bar[XB_TOPGEN]) == tg, bar);
            __builtin_amdgcn_fence(__ATOMIC_ACQUIRE, "agent");
            xb_add(&bar[XB_XGEN(bx_)], 1u);
            asm volatile("s_waitcnt vmcnt(0)" ::: "memory");
        } else {
            XB_SPIN(xb_ld(&bar[XB_XGEN(bx_)]) == gen, bar);
            __builtin_amdgcn_fence(__ATOMIC_ACQUIRE, "agent");
            asm volatile("s_waitcnt vmcnt(0)" ::: "memory");
        }
    }
    __syncthreads();
}

#define XB_LSUB(j)  (3456 + 64 * (j))
#define XB_LGEN(j)  (3456 + 1024 + 64 * (j))
#define XB_TICKET   (3456 + 2048)
__device__ __forceinline__ void xcd_local_barrier(const XcdBarrier& b) {
    asm volatile("s_waitcnt vmcnt(0)" ::: "memory");
    __syncthreads();
    if (threadIdx.x == 0) {
        unsigned* bar = b.bar; unsigned bx_ = b.x; asm volatile("" : "+s"(bar), "+s"(bx_));
        const unsigned nloc = b.st[0];
        const unsigned old = xb_add(&bar[XB_LSUB(bx_)], 1u);
        const unsigned gen = old / nloc;
        if (old + 1u == (gen + 1u) * nloc) xb_add(&bar[XB_LGEN(bx_)], 1u);
        else XB_SPIN(xb_ld(&bar[XB_LGEN(bx_)]) == gen, bar);
        __builtin_amdgcn_fence(__ATOMIC_ACQUIRE, "agent");
        asm volatile("s_waitcnt vmcnt(0)" ::: "memory");
    }
    __syncthreads();
}

#define XB_TEAM(x, c) (8192 + 512 * (x) + 64 * (c))
#define XB_HFREE(x)   (16384 + 64 * (x))
__device__ __forceinline__ void xcd_team_barrier(const XcdBarrier& b, unsigned team) {
    asm volatile("s_waitcnt vmcnt(0)" ::: "memory");
    __syncthreads();
    if (threadIdx.x == 0) {
        unsigned* bar = b.bar; unsigned bx_ = b.x; asm volatile("" : "+s"(bar), "+s"(bx_));
        unsigned* w = &bar[XB_TEAM(bx_, team)];
        const unsigned target = (xb_add(w, 1u) / 4u + 1u) * 4u;
        XB_SPIN(xb_ld(w) < target, bar);
        __builtin_amdgcn_fence(__ATOMIC_ACQUIRE, "agent");
        asm volatile("s_waitcnt vmcnt(0)" ::: "memory");
    }
    __syncthreads();
}
__device__ __forceinline__ void xcd_hfree_arrive(const XcdBarrier& b) {
    if (threadIdx.x == 0) { unsigned* bar = b.bar; unsigned bx_ = b.x; asm volatile("" : "+s"(bar), "+s"(bx_)); xb_add(&bar[XB_HFREE(bx_)], 1u); }
}
__device__ __forceinline__ void xcd_hfree_wait(const XcdBarrier& b, unsigned target) {
    if (threadIdx.x == 0) { unsigned* bar = b.bar; unsigned bx_ = b.x; asm volatile("" : "+s"(bar), "+s"(bx_)); XB_SPIN(xb_ld(&bar[XB_HFREE(bx_)]) < target, bar); }
    __syncthreads();
}

__device__ __forceinline__ float wave_sum(float v) {
    v += __builtin_bit_cast(float, __builtin_amdgcn_ds_swizzle(__builtin_bit_cast(int, v), 0x041F));
    v += __builtin_bit_cast(float, __builtin_amdgcn_ds_swizzle(__builtin_bit_cast(int, v), 0x081F));
    v += __builtin_bit_cast(float, __builtin_amdgcn_ds_swizzle(__builtin_bit_cast(int, v), 0x101F));
    v += __builtin_bit_cast(float, __builtin_amdgcn_ds_swizzle(__builtin_bit_cast(int, v), 0x201F));
    return add_xor32(add_xor16(v));
}
__device__ __forceinline__ unsigned off_b(unsigned row, unsigned ch) { return 256u * row + 16u * (ch ^ (((row & 3u) << 2) | ((row >> 2) & 3u))); }
__device__ __forceinline__ unsigned tr_addr_nat(unsigned lane, unsigned c, unsigned ks, unsigned t) {
    const unsigned h = lane >> 5, blk = (lane >> 4) & 1u, q = (lane & 15u) >> 2, p = lane & 3u;
    return off_b(16u * ks + 8u * h + 4u * t + q, 4u * c + 2u * blk + (p >> 1)) + 8u * (p & 1u);
}
__device__ __forceinline__ unsigned tr_addr_perm(unsigned lane, unsigned c, unsigned ks, unsigned t) {
    const unsigned h = lane >> 5, blk = (lane >> 4) & 1u, q = (lane & 15u) >> 2, p = lane & 3u;
    return off_b(16u * ks + 8u * t + 4u * h + q, 4u * c + 2u * blk + (p >> 1)) + 8u * (p & 1u);
}
__device__ __forceinline__ unsigned tr_addr16(unsigned lane, unsigned c, unsigned ks, unsigned t) {
    const unsigned g = lane >> 4, q = (lane & 15u) >> 2, p = lane & 3u;
    return off_b(32u * ks + 8u * g + 4u * t + q, 2u * c + (p >> 1)) + 8u * (p & 1u);
}
__device__ __forceinline__ void glds16(const void* gsrc, unsigned lds_dst) { unsigned keep;
    asm volatile("s_mov_b32 %0, m0\n\ts_mov_b32 m0, %2\n\ts_nop 0\n\tglobal_load_lds_dwordx4 %1, off\n\ts_mov_b32 m0, %0" : "=&s"(keep) : "v"(gsrc), "s"(lds_dst) : "memory"); }
typedef short v4i16_t __attribute__((ext_vector_type(4)));
__device__ __forceinline__ s16x4 tr_read(LAS unsigned char* p) { return __builtin_bit_cast(s16x4, __builtin_amdgcn_ds_read_tr16_b64_v4i16((LAS v4i16_t*)p)); }
__device__ __forceinline__ bf16x8 cat4(s16x4 a, s16x4 b) { return (bf16x8){a[0], a[1], a[2], a[3], b[0], b[1], b[2], b[3]}; }
__device__ __forceinline__ unsigned cvtpk(float lo, float hi) { return pg8::cvt_pk_bf16(lo, hi); }
__device__ __forceinline__ int crow(int r, int hi) { return (r & 3) + 8 * (r >> 2) + 4 * hi; }
__device__ __forceinline__ bf16x8 pack_acc(const f32x16& a, int s) {
    v4u w; w.x = cvtpk(a[8 * s + 0], a[8 * s + 1]); w.y = cvtpk(a[8 * s + 2], a[8 * s + 3]); w.z = cvtpk(a[8 * s + 4], a[8 * s + 5]); w.w = cvtpk(a[8 * s + 6], a[8 * s + 7]);
    return __builtin_bit_cast(bf16x8, w);
}

__device__ __forceinline__ void tr_item(const float* W, int ldw, int srccol0, int k0, const float* gain, float scal, bf16* WT, int K, int dstrow0, LAS float* scr, int lane) {
    float r[32], gv[32];
    const float* wp = W + (size_t)(k0 + (lane >> 5)) * ldw + srccol0 + (lane & 31);
#pragma unroll
    for (int i = 0; i < 32; ++i) r[i] = __builtin_nontemporal_load(wp + (size_t)(2 * i) * ldw);
    if (gain) {
#pragma unroll
        for (int i = 0; i < 32; ++i) gv[i] = gain[k0 + 2 * i + (lane >> 5)] * scal;
    } else {
#pragma unroll
        for (int i = 0; i < 32; ++i) gv[i] = scal;
    }
#pragma unroll
    for (int i = 0; i < 32; ++i) scr[(2 * i + (lane >> 5)) * 33 + (lane & 31)] = r[i] * gv[i];
    LDS_WAIT(); asm volatile("" ::: "memory");
    const int c = lane & 7;
#pragma unroll
    for (int j = 0; j < 4; ++j) { const int n = (lane >> 3) + 8 * j; const LAS float* s = scr + (8 * c) * 33 + n;
        v4u o; o.x = pk2(s[0 * 33], s[1 * 33]); o.y = pk2(s[2 * 33], s[3 * 33]); o.z = pk2(s[4 * 33], s[5 * 33]); o.w = pk2(s[6 * 33], s[7 * 33]);
        *(GAS v4u*)(WT + (size_t)(dstrow0 + n) * K + k0 + 8 * c) = o; }
    LDS_WAIT(); asm volatile("" ::: "memory");
}

struct Args { const float* x; const float* p; const int* pos; const float* g_mix; const float* w_in; const float* pool_w; const float* pool_scale; const float* w_out; const float* g_ffn;
              const float* w_gate; const float* w_up; const float* w_down; const float* g_ple; const float* w_ple_gate; const float* w_ple_proj; const float* g_final; float* out; unsigned char* ws; };

template <int W> __device__ __forceinline__ void pool_rows(const bf16* uw, bf16* mix, int b, int s0, int c0) {
    constexpr int NR = W - 1 + 16;
    v2u xr[NR];
#pragma unroll
    for (int i = 0; i < NR; ++i) { const int s = s0 - (W - 1) + i;
        xr[i] = (s >= 0) ? *(const GAS v2u*)(uw + (size_t)(b * SEQ + s) * 512 + c0) : (v2u){0u, 0u}; }
    float sum[4];
#pragma unroll
    for (int j = 0; j < 4; ++j) sum[j] = 0.f;
#pragma unroll
    for (int i = 0; i < W - 1; ++i)
#pragma unroll
        for (int j = 0; j < 2; ++j) { sum[2 * j] += bf_lo(xr[i][j]); sum[2 * j + 1] += bf_hi(xr[i][j]); }
#pragma unroll
    for (int i = 0; i < 16; ++i) {
        const int s = s0 + i; const float inv = 1.0f / (float)((s + 1 < W) ? (s + 1) : W);
        float o[4];
#pragma unroll
        for (int j = 0; j < 2; ++j) { const float a = bf_lo(xr[W - 1 + i][j]), c = bf_hi(xr[W - 1 + i][j]);
            sum[2 * j] += a; sum[2 * j + 1] += c; o[2 * j] = sum[2 * j] * inv - a; o[2 * j + 1] = sum[2 * j + 1] * inv - c;
            sum[2 * j] -= bf_lo(xr[i][j]); sum[2 * j + 1] -= bf_hi(xr[i][j]); }
        *(GAS v2u*)(mix + (size_t)(b * SEQ + s) * 1024 + 512 + c0) = (v2u){pk2(o[0], o[1]), pk2(o[2], o[3])};
    }
}

__global__ void __launch_bounds__(NWAVES * 64, 2) fwd(Args a_in) {
    extern __shared__ __attribute__((aligned(16))) unsigned char lds_raw[];
    LAS unsigned char* lds = (LAS unsigned char*)lds_raw;
    volatile LAS unsigned* MISC = (volatile LAS unsigned*)(lds + MISC_OFF);
    const int tid = threadIdx.x, lane = tid & 63, wave = __builtin_amdgcn_readfirstlane(tid >> 6);
    const int G = gridDim.x, bx = blockIdx.x;
    const int gw = bx * NWAVES + wave, NGW = G * NWAVES;
    typedef const __attribute__((address_space(4))) Args CArgs;
#define PHASE_ENVB(bi_) CArgs* ap_ = (CArgs*)__builtin_amdgcn_kernarg_segment_ptr(); asm volatile("" : "+s"(ap_)); CArgs& a = *ap_; \
    unsigned char* const ws = a.ws; float* const ssqA = (float*)(ws + WS_SSQA) + (size_t)(bi_) * SEQ * 16; float* const ssqB = (float*)(ws + WS_SSQB) + (size_t)(bi_) * SEQ * 16; \
    bf16* const xb = (bf16*)(ws + WS_XB) + (size_t)(bi_) * SEQ * D; bf16* const xb1 = (bf16*)(ws + WS_XB1) + (size_t)(bi_) * SEQ * D; bf16* const pb = (bf16*)(ws + WS_PB) + (size_t)(bi_) * SEQ * PLE; \
    unsigned char* const R = ws + WS_R + (size_t)(bi_) * R_BATCH; \
    bf16* const qb = (bf16*)(R + R_Q); bf16* const kb = (bf16*)(R + R_K); bf16* const vb = (bf16*)(R + R_V); bf16* const gb = (bf16*)(R + R_G); bf16* const uwb = (bf16*)(R + R_UW); \
    bf16* const kvb = (bf16*)(R + R_KV); bf16* const mix = (bf16*)(R + R_MIX); bf16* const hmid = (bf16*)(R + R_H); bf16* const eb = (bf16*)(R + R_E); float* const utmp = (float*)(ws + WS_R + R_UT); \
    (void)ssqA; (void)ssqB; (void)xb; (void)xb1; (void)pb; (void)qb; (void)kb; (void)vb; (void)gb; (void)uwb; (void)kvb; (void)mix; (void)hmid; (void)eb; (void)utmp
#define PHASE_ENV() PHASE_ENVB(batch)
    gu32* ctl = (gu32*)(a_in.ws + WS_CTL);
    for (int u = tid; u < (LDS_BYTES - LDSCTL_OFF) / 4; u += NWAVES * 64) ((LAS unsigned*)(lds + LDSCTL_OFF))[u] = 0u;
    __syncthreads();
    XcdBarrier bar = xcd_barrier_post((unsigned*)(ctl + CW_BAR), MISC + 8);

#ifndef PHMASK
#define PHMASK 0xFFFF
#endif
#define PH(n) ((PHMASK >> (n)) & 1)
#define FRESH_TID(name) int name = threadIdx.x; asm volatile("" : "+v"(name))
    if (PH(0)) { PHASE_ENVB(0);
    for (int task = gw; task < DEPTH * 4 * 2 * 128; task += NGW) {
        const int kb8 = task & 127, dh = (task >> 7) & 1, g = (task >> 8) & 3, L = task >> 10;
        const int d = dh * 64 + lane;
        const float* pw = a.pool_w + (size_t)((L * 4 + g) * 128) * 128 + d;
        const float* wi = a.w_in + (size_t)(L * 1024 + kb8 * 8) * INW + 2048 + g * 128;
        float acc[8];
#pragma unroll
        for (int i = 0; i < 8; ++i) acc[i] = 0.f;
#pragma unroll 4
        for (int c = 0; c < 128; ++c) { const float bv = pw[(size_t)c * 128];
#pragma unroll
            for (int i = 0; i < 8; ++i) acc[i] += wi[(size_t)i * INW + c] * bv; }
        const float sc = a.pool_scale[L * 512 + g * 128 + d];
#pragma unroll
        for (int i = 0; i < 8; ++i) utmp[(size_t)(L * 1024 + kb8 * 8 + i) * 512 + g * 128 + d] = acc[i] * sc;
    }
    }
    xcd_barrier(bar);
#ifndef NO_TEAMS
#define NO_TEAMS 0
#endif
#ifndef FORCE_FALLBACK
#define FORCE_FALLBACK 0
#endif
    if (threadIdx.x == 0) {
        unsigned* barw = (unsigned*)(ctl + CW_BAR);
        const unsigned nloc_ = MISC[8], nx_ = MISC[9], rk_ = MISC[10], myx_ = xb_xcc_id();
        unsigned mode_ = 0u, batch_ = 0u, rank_ = 0u, gsz_ = 1u;
        if (nx_ == 8u && !FORCE_FALLBACK) { mode_ = 1u; for (unsigned j = 0; j < 16; ++j) if (j < myx_ && xb_ld(&barw[XB_XCNT(j)]) > 0u) ++batch_; rank_ = rk_; gsz_ = nloc_; }
        else { const unsigned t_ = xb_add(&barw[XB_TICKET], 1u); batch_ = t_ % 8u; rank_ = t_ / 8u; gsz_ = (unsigned)G / 8u + ((batch_ < (unsigned)G % 8u) ? 1u : 0u); }
        MISC[11] = mode_; MISC[12] = batch_; MISC[13] = rank_; MISC[14] = gsz_;
    }
    __syncthreads();
    const int lmode = __builtin_amdgcn_readfirstlane((int)MISC[11]), batch = __builtin_amdgcn_readfirstlane((int)MISC[12]), rank = __builtin_amdgcn_readfirstlane((int)MISC[13]), gsz = __builtin_amdgcn_readfirstlane((int)MISC[14]);
#define LBAR() do { if (lmode) xcd_local_barrier(bar); else xcd_barrier(bar); } while (0)
    const bool tmode = lmode && gsz == 32 && !NO_TEAMS;
#define TBAR() do { if (tmode) xcd_team_barrier(bar, (unsigned)rank & 7u); else LBAR(); } while (0)

    if (PH(1)) { PHASE_ENVB(0);
        LAS float* scr = (LAS float*)(lds + wave * 16384);
        constexpr int I_IN = 16 * 80, I_OUT = 16 * 32, I_GU = 16 * 176, I_DN = 44 * 32, I_PG = 16 * 32, I_PP = 4 * 32, I_L = I_IN + I_OUT + I_GU + I_DN + I_PG + I_PP;
        for (int it = gw; it < DEPTH * I_L; it += NGW) {
            const int L = it / I_L; int r = it % I_L;
            unsigned char* wl = ws + WS_W + (size_t)L * W_LAYER;
            if (r < I_IN) { const int kbk = r / 80, nb = r % 80, n0 = 32 * nb, k0 = 64 * kbk; const float* gn = a.g_mix + L * 1024;
                if (n0 < 1024) { const int sec = n0 >> 9, w = n0 & 511, t = w >> 8, bj = (w >> 7) & 1, hh = (w >> 6) & 1, dd0 = w & 63;
                    tr_item(a.w_in + (size_t)L * 1024 * INW, INW, sec * 512 + (2 * t + hh) * 128 + bj * 64 + dd0, k0, gn, sec == 0 ? 0.08838834764831845f : 1.0f, (bf16*)(wl + WO_IN), 1024, n0, scr, lane); }
                else if (n0 < 2048) tr_item(a.w_in + (size_t)L * 1024 * INW, INW, n0, k0, gn, 1.0f, (bf16*)(wl + WO_IN), 1024, n0, scr, lane);
                else tr_item(utmp + (size_t)L * 1024 * 512, 512, n0 - 2048, k0, gn, 1.0f, (bf16*)(wl + WO_IN), 1024, n0, scr, lane);
                continue; } r -= I_IN;
            if (r < I_OUT) { const int kbk = r / 32, nb = r % 32; tr_item(a.w_out + (size_t)L * 1024 * 1024, 1024, 32 * nb, 64 * kbk, nullptr, 1.0f, (bf16*)(wl + WO_OUT), 1024, 32 * nb, scr, lane); continue; } r -= I_OUT;
            if (r < I_GU) { const int kbk = r / 176, nb = r % 176, n0 = 32 * nb, t = n0 >> 8, bj = (n0 >> 7) & 1, j0 = n0 & 127;
                tr_item((bj ? a.w_up : a.w_gate) + (size_t)L * 1024 * FF, FF, 128 * t + j0, 64 * kbk, a.g_ffn + L * 1024, 1.0f, (bf16*)(wl + WO_GU), 1024, n0, scr, lane); continue; } r -= I_GU;
            if (r < I_DN) { const int kbk = r / 32, nb = r % 32; tr_item(a.w_down + (size_t)L * FF * 1024, 1024, 32 * nb, 64 * kbk, nullptr, 1.0f, (bf16*)(wl + WO_DOWN), FF, 32 * nb, scr, lane); continue; } r -= I_DN;
            if (r < I_PG) { const int kbk = r / 32, nb = r % 32; tr_item(a.w_ple_gate + (size_t)L * 1024 * 1024, 1024, 32 * nb, 64 * kbk, a.g_ple + L * 1024, 1.0f, (bf16*)(wl + WO_PG), 1024, 32 * nb, scr, lane); continue; } r -= I_PG;
            { const int kbk = r / 32, nb = r % 32; tr_item(a.w_ple_proj + (size_t)L * PLE * 1024, 1024, 32 * nb, 64 * kbk, nullptr, 1.0f, (bf16*)(wl + WO_PP), PLE, 32 * nb, scr, lane); }
        }
        for (int m = 2 * gw; m < M; m += 2 * NGW) {
            const GAS f32x4* xr = (const GAS f32x4*)(a.x + (size_t)m * D) + lane; GAS v2u* o8 = (GAS v2u*)(xb1 + (size_t)m * D) + lane;
            f32x4 v[8];
#pragma unroll
            for (int j = 0; j < 8; ++j) v[j] = __builtin_nontemporal_load(xr + 64 * j);
            float ss0 = 0.f, ss1 = 0.f;
#pragma unroll
            for (int j = 0; j < 4; ++j) { ss0 += (v[j][0] * v[j][0] + v[j][1] * v[j][1]) + (v[j][2] * v[j][2] + v[j][3] * v[j][3]); o8[64 * j] = (v2u){pk2(v[j][0], v[j][1]), pk2(v[j][2], v[j][3])}; }
#pragma unroll
            for (int j = 4; j < 8; ++j) { ss1 += (v[j][0] * v[j][0] + v[j][1] * v[j][1]) + (v[j][2] * v[j][2] + v[j][3] * v[j][3]); o8[64 * j] = (v2u){pk2(v[j][0], v[j][1]), pk2(v[j][2], v[j][3])}; }
            ss0 = wave_sum(ss0); ss1 = wave_sum(ss1);
            if (lane < 32) ssqB[(size_t)m * 16 + lane] = (lane == 0) ? ss0 : (lane == 16) ? ss1 : 0.f;
        }
        for (size_t i = (size_t)bx * 512 + tid; i < (size_t)M * PLE / 8; i += (size_t)G * 512) {
            const f32x4 v0 = ((const GAS f32x4*)a.p)[2 * i], v1 = ((const GAS f32x4*)a.p)[2 * i + 1];
            ((GAS v4u*)pb)[i] = (v4u){pk2(v0[0], v0[1]), pk2(v0[2], v0[3]), pk2(v1[0], v1[1]), pk2(v1[2], v1[3])};
        }
    }
    xcd_barrier(bar);

    for (int L = 0; L < DEPTH; ++L) {
        if (tmode && L > 0) xcd_hfree_wait(bar, (unsigned)(gsz * L));

#ifndef REP_P1
#define REP_P1 1
#endif
#pragma unroll 1
        for (int rep_ = 0; rep_ < REP_P1; ++rep_) {
        if (PH(2)) {
            PHASE_ENV(); const unsigned char* wl = ws + WS_W + (size_t)L * W_LAYER; (void)wl; FRESH_TID(ptid); pg8::Gemm g{xb1, (const bf16*)(wl + WO_IN), SEQ, INW, D}; pg8::BatchOrder S; S.init(INW, gsz, rank);
            PG8_LAS float* side = (PG8_LAS float*)(lds + SIDE_OFF); const int npu = (S.nwg + gsz - 1) / gsz;     PG8_LAS float* posf = side + npu * 256; PG8_LAS float* rope = posf + npu * 256;
            pg8::fill_rstd(S, ssqB, side, a.pos + batch * SEQ, posf, ptid); if (ptid < 64) { rope[ptid] = ROPE_HI[ptid]; rope[64 + ptid] = ROPE_LO[ptid]; } __syncthreads();
            pg8::EpiInProj E{side, posf, rope, qb, kb, vb, gb, uwb};
            pg8::gemm_phase<pg8::EpiInProj, pg8::BatchOrder, true, true>(lds, g, S, E, ptid);
        }
        LBAR();


        }
#ifndef REP_RET
#define REP_RET 1
#endif
#pragma unroll 1
        for (int rep_ = 0; rep_ < REP_RET; ++rep_) {
        if (PH(3)) { PHASE_ENV();
            FRESH_TID(t_); const int tid = t_, lane = t_ & 63, wave = __builtin_amdgcn_readfirstlane(t_ >> 6); (void)tid; (void)lane; (void)wave;
            {
                const unsigned ldsb = (unsigned)__builtin_amdgcn_readfirstlane((int)(unsigned)(size_t)lds);
                unsigned soff[4];
#pragma unroll
                for (int p = 0; p < 4; ++p) { const unsigned row = 4u * (unsigned)(wave * 4 + p) + ((unsigned)lane >> 4), pc = (unsigned)lane & 15u; soff[p] = 256u * row + 16u * (pc ^ (((row & 3u) << 2) | ((row >> 2) & 3u))); }
#define P2_DMA(u_, buf_) do { const char* ks_ = (const char*)(kb + (size_t)(u_) * 16384); const char* vs_ = (const char*)(vb + (size_t)(u_) * 16384); \
                    _Pragma("unroll") for (int p_ = 0; p_ < 4; ++p_) { glds16(ks_ + soff[p_], ldsb + (unsigned)((buf_) * 65536 + (wave * 4 + p_) * 1024)); \
                        glds16(vs_ + soff[p_], ldsb + (unsigned)((buf_) * 65536 + 32768 + (wave * 4 + p_) * 1024)); } } while (0)
                int buf = 0;
                if (rank < NH * NCH) P2_DMA(rank, 0);
                asm volatile("s_waitcnt vmcnt(0)" ::: "memory");
                for (int u = rank; u < NH * NCH; u += gsz, buf ^= 1) {
                    asm volatile("s_waitcnt vmcnt(4)" ::: "memory"); __builtin_amdgcn_s_barrier(); asm volatile("" ::: "memory");
                    if (u + gsz < NH * NCH) P2_DMA(u + gsz, buf ^ 1);
                    LAS unsigned char* kl = lds + buf * 65536; LAS unsigned char* vl2 = kl + 32768;
                    const int dt = wave >> 1, et0 = (wave & 1) * 2;
                    f32x16 acc0, acc1;
#pragma unroll
                    for (int r = 0; r < 16; ++r) { acc0[r] = 0.f; acc1[r] = 0.f; }
#pragma unroll
                    for (int ks = 0; ks < 8; ++ks) {
                        const bf16x8 A = cat4(tr_read(kl + tr_addr_nat(lane, dt, ks, 0)), tr_read(kl + tr_addr_nat(lane, dt, ks, 1)));
                        const bf16x8 B0 = cat4(tr_read(vl2 + tr_addr_nat(lane, et0, ks, 0)), tr_read(vl2 + tr_addr_nat(lane, et0, ks, 1)));
                        const bf16x8 B1 = cat4(tr_read(vl2 + tr_addr_nat(lane, et0 + 1, ks, 0)), tr_read(vl2 + tr_addr_nat(lane, et0 + 1, ks, 1)));
                        acc0 = __builtin_amdgcn_mfma_f32_32x32x16_bf16(A, B0, acc0, 0, 0, 0);
                        acc1 = __builtin_amdgcn_mfma_f32_32x32x16_bf16(A, B1, acc1, 0, 0, 0);
                    }
                    bf16* kvt = kvb + (size_t)u * 16384;
#pragma unroll
                    for (int s = 0; s < 2; ++s) {
                        *(GAS bf16x8*)(kvt + ((dt * 4 + et0) * 2 + s) * 512 + lane * 8) = pack_acc(acc0, s);
                        *(GAS bf16x8*)(kvt + ((dt * 4 + et0 + 1) * 2 + s) * 512 + lane * 8) = pack_acc(acc1, s);
                    }
                }
                asm volatile("s_waitcnt vmcnt(0)" ::: "memory"); __syncthreads();
#undef P2_DMA
            }
            for (int it = rank; it < NCH; it += gsz) {
                const int b = it >> 5, n = it & 31, gi = wave & 3, half = wave >> 2;
#pragma unroll 1
                for (int ps = 0; ps < 2; ++ps) {
                    const int s0 = n * 128 + half * 64 + ps * 32 + (lane >> 5) * 16, c0 = gi * 128 + (lane & 31) * 4;
                    if (gi == 0) pool_rows<2>(uwb, mix, b, s0, c0); else if (gi == 1) pool_rows<4>(uwb, mix, b, s0, c0); else if (gi == 2) pool_rows<8>(uwb, mix, b, s0, c0); else pool_rows<16>(uwb, mix, b, s0, c0);
                }
            }
            if (L > 0) {
                const GAS f32x4* ps = (const GAS f32x4*)(a.p + ((size_t)L * M + (size_t)batch * SEQ) * PLE);
                for (size_t i = (size_t)rank * 512 + tid; i < (size_t)SEQ * PLE / 8; i += (size_t)gsz * 512) {
                    const f32x4 v0 = ps[2 * i], v1 = ps[2 * i + 1];
                    ((GAS v4u*)pb)[i] = (v4u){pk2(v0[0], v0[1]), pk2(v0[2], v0[3]), pk2(v1[0], v1[1]), pk2(v1[2], v1[3])};
                }
            }
        }
        LBAR();


        if (PH(4)) { PHASE_ENV(); FRESH_TID(t_); const int tid = t_, lane = t_ & 63, wave = __builtin_amdgcn_readfirstlane(t_ >> 6); (void)tid; (void)lane; (void)wave;
        for (int c = rank * 512 + tid; c < NH * 4096; c += gsz * 512) {
            const int bh = c >> 12; const float cd = __builtin_amdgcn_exp2f(128.0f * lg2gamma(bh & 3));
            GAS v2u* base = (GAS v2u*)(kvb + (size_t)bh * NCH * 16384) + (c & 4095);
            v2u t[NCH];
#pragma unroll
            for (int n = 0; n < NCH; ++n) t[n] = base[(size_t)n * 4096];
            float r0 = 0.f, r1 = 0.f, r2 = 0.f, r3 = 0.f;
#pragma unroll
            for (int n = 0; n < NCH; ++n) {
                const v2u in = t[n];
                base[(size_t)n * 4096] = (v2u){pk2(r0, r1), pk2(r2, r3)};
                r0 = cd * (r0 + bf_lo(in[0])); r1 = cd * (r1 + bf_hi(in[0])); r2 = cd * (r2 + bf_lo(in[1])); r3 = cd * (r3 + bf_hi(in[1]));
            }
        }
        }
        LBAR();

        if (PH(5)) { PHASE_ENV(); FRESH_TID(t_); const int tid = t_, lane = t_ & 63, wave = __builtin_amdgcn_readfirstlane(t_ >> 6);
        LAS float* red = (LAS float*)(lds + SIDE_OFF);
        const unsigned ldsb = (unsigned)__builtin_amdgcn_readfirstlane((int)(unsigned)(size_t)lds);
        unsigned soff[4];
#pragma unroll
        for (int p = 0; p < 4; ++p) { const unsigned row = 4u * (unsigned)(wave * 4 + p) + ((unsigned)lane >> 4), pc = (unsigned)lane & 15u; soff[p] = 256u * row + 16u * (pc ^ (((row & 3u) << 2) | ((row >> 2) & 3u))); }
        const int qt = (wave < 4) ? wave : 7 - wave, eh = wave >> 2;
        v4u sfr[16];
#define P4_TILE(src_, u_, reg_) do { const char* s_ = (const char*)((src_) + (size_t)(u_) * 16384); \
            _Pragma("unroll") for (int p_ = 0; p_ < 4; ++p_) glds16(s_ + soff[p_], ldsb + (unsigned)((reg_) * 32768 + (wave * 4 + p_) * 1024)); } while (0)
#define P4_SF(u_) do { const bf16* st_ = kvb + (size_t)(u_) * 16384 + lane * 8; \
            _Pragma("unroll") for (int k_ = 0; k_ < 16; ++k_) { const int ei_ = k_ >> 3, dt_ = (k_ >> 1) & 3, s_ = k_ & 1; \
                asm volatile("global_load_dwordx4 %0, %1, off" : "=v"(sfr[k_]) : "v"(st_ + ((dt_ * 4 + 2 * eh + ei_) * 2 + s_) * 512) : "memory"); } } while (0)
#define P4_WAIT_SF(n_) asm volatile("s_waitcnt vmcnt(" #n_ ")" : "+v"(sfr[0]), "+v"(sfr[1]), "+v"(sfr[2]), "+v"(sfr[3]), "+v"(sfr[4]), "+v"(sfr[5]), "+v"(sfr[6]), "+v"(sfr[7]), \
            "+v"(sfr[8]), "+v"(sfr[9]), "+v"(sfr[10]), "+v"(sfr[11]), "+v"(sfr[12]), "+v"(sfr[13]), "+v"(sfr[14]), "+v"(sfr[15]) :: "memory")
#define P4_BAR() do { asm volatile("s_waitcnt lgkmcnt(0)" ::: "memory"); __builtin_amdgcn_s_barrier(); asm volatile("" ::: "memory"); } while (0)
        { const int u0 = (rank < NH * NCH) ? rank : NH * NCH - 1;
          P4_TILE(kb, u0, 0); P4_TILE(qb, u0, 2); P4_SF(u0); P4_TILE(vb, u0, 1); }
        P4_WAIT_SF(0);
        for (int u = rank; u < NH * NCH; u += gsz) {
            const int bh = u >> 5, n = u & 31, h = bh & 3, b = bh >> 2;
            const bool has_next = (u + gsz < NH * NCH);
            P4_WAIT_SF(4); P4_BAR();
            P4_TILE(gb, u, 3);
            int ln = lane; asm volatile("" : "+v"(ln)); const int ql = ln & 31, hh = ln >> 5;
            LAS unsigned char* kzl = lds; LAS unsigned char* vl = lds + 32768; LAS unsigned char* qlds = lds + 65536; LAS unsigned char* glds = lds + 98304;
            bf16x8 qf[4][2];
            { const unsigned qrow = 32u * qt + (unsigned)ql;
#pragma unroll
              for (int dt = 0; dt < 4; ++dt)
#pragma unroll
                for (int s = 0; s < 2; ++s) { const v2u lo = *(const LAS v2u*)(qlds + off_b(qrow, 4 * dt + 2 * s) + 8 * hh), hi = *(const LAS v2u*)(qlds + off_b(qrow, 4 * dt + 2 * s + 1) + 8 * hh);
                    qf[dt][s] = __builtin_bit_cast(bf16x8, (v4u){lo[0], lo[1], hi[0], hi[1]}); } }
            bf16x8 pf[4][2];
#pragma unroll
            for (int kt = 0; kt < 4; ++kt) {
                if (kt <= qt) {
                    f32x16 sa;
#pragma unroll
                    for (int r = 0; r < 16; ++r) sa[r] = 0.f;
                    const unsigned krow = 32 * kt + ql;
#pragma unroll
                    for (int dt = 0; dt < 4; ++dt)
#pragma unroll
                        for (int s = 0; s < 2; ++s) {
                            const v2u lo = *(const LAS v2u*)(kzl + off_b(krow, 4 * dt + 2 * s) + 8 * hh), hi = *(const LAS v2u*)(kzl + off_b(krow, 4 * dt + 2 * s + 1) + 8 * hh);
                            sa = __builtin_amdgcn_mfma_f32_32x32x16_bf16(__builtin_bit_cast(bf16x8, (v4u){lo[0], lo[1], hi[0], hi[1]}), qf[dt][s], sa, 0, 0, 0); }
                    if (kt == qt) {
#pragma unroll
                        for (int r = 0; r < 16; ++r) sa[r] = (crow(r, hh) > ql) ? 0.f : sa[r];
                    }
                    pf[kt][0] = pack_acc(sa, 0); pf[kt][1] = pack_acc(sa, 1);
                } else { pf[kt][0] = (bf16x8){0, 0, 0, 0, 0, 0, 0, 0}; pf[kt][1] = (bf16x8){0, 0, 0, 0, 0, 0, 0, 0}; }
            }
            P4_BAR();
            if (has_next) { P4_TILE(kb, u + gsz, 0); P4_TILE(qb, u + gsz, 2); }
            f32x16 oacc[2]; int ln2 = lane; asm volatile("" : "+v"(ln2));
#pragma unroll
            for (int ei = 0; ei < 2; ++ei) {
                f32x16 o;
#pragma unroll
                for (int r = 0; r < 16; ++r) o[r] = 0.f;
#pragma unroll
                for (int dt = 0; dt < 4; ++dt)
#pragma unroll
                    for (int s = 0; s < 2; ++s) o = __builtin_amdgcn_mfma_f32_32x32x16_bf16(__builtin_bit_cast(bf16x8, sfr[ei * 8 + dt * 2 + s]), qf[dt][s], o, 0, 0, 0);
                oacc[ei] = o;
            }
#pragma unroll
            for (int ei = 0; ei < 2; ++ei) {
                const int et = 2 * eh + ei; f32x16 o = oacc[ei];
#pragma unroll
                for (int kt = 0; kt < 4; ++kt) {
                    if (kt <= qt) {
#pragma unroll
                        for (int s = 0; s < 2; ++s) {
                            const bf16x8 vf = cat4(tr_read(vl + tr_addr_perm(ln2, et, 2 * kt + s, 0)), tr_read(vl + tr_addr_perm(ln2, et, 2 * kt + s, 1)));
                            o = __builtin_amdgcn_mfma_f32_32x32x16_bf16(vf, pf[kt][s], o, 0, 0, 0); }
                    }
                }
                oacc[ei] = o;
            }
            const float rsc = __builtin_amdgcn_exp2f((float)(32 * qt + ql - 127) * lg2gamma(h));
            float ss = 0.f;
#pragma unroll
            for (int ei = 0; ei < 2; ++ei)
#pragma unroll
                for (int r = 0; r < 16; ++r) { const float y = oacc[ei][r] * rsc; oacc[ei][r] = y; ss += y * y; }
            ss = add_xor32(ss);
            if (hh == 0) red[eh * 128 + 32 * qt + ql] = ss;
            if (has_next) asm volatile("s_waitcnt vmcnt(8)" ::: "memory"); else asm volatile("s_waitcnt vmcnt(0)" ::: "memory");
            P4_BAR();
            if (has_next) { P4_SF(u + gsz); P4_TILE(vb, u + gsz, 1); }
            int ln3 = lane; asm volatile("" : "+v"(ln3)); const int ql3 = ln3 & 31, hh3 = ln3 >> 5;
            const float rn = rsqrtf((red[32 * qt + ql3] + red[128 + 32 * qt + ql3]) * (1.0f / 128.0f) + EPS);
            { const unsigned yrow = 32u * qt + (unsigned)ql3;
#pragma unroll
              for (int ei = 0; ei < 2; ++ei)
#pragma unroll
                for (int rg = 0; rg < 4; ++rg) {
                    const unsigned e0 = 32u * (2 * eh + ei) + 8u * rg + 4u * hh3, ch = e0 >> 3, sub = (e0 & 7u) * 2u;
                    const v2u gv = *(const LAS v2u*)(glds + off_b(yrow, ch) + sub);
                    float o[4];
#pragma unroll
                    for (int j = 0; j < 4; ++j) { const float gt = (j & 1) ? bf_hi(gv[j >> 1]) : bf_lo(gv[j >> 1]);
                        o[j] = gt * __builtin_amdgcn_rcpf(1.0f + __builtin_amdgcn_exp2f(-1.4426950408889634f * gt)) * (oacc[ei][4 * rg + j] * rn); }
                    *(LAS v2u*)(glds + off_b(yrow, ch) + sub) = (v2u){pk2(o[0], o[1]), pk2(o[2], o[3])};
                } }
            P4_BAR();
            { bf16* orow = mix + ((size_t)b * SEQ + n * 128) * 1024 + h * 128;
              int t4 = tid; asm volatile("" : "+v"(t4));
#pragma unroll
              for (int i = 0; i < 4; ++i) { const unsigned c = t4 + 512 * i, row = c >> 4, ch = c & 15; *(GAS v4u*)(orow + (size_t)row * 1024 + ch * 8) = *(const LAS v4u*)(glds + off_b(row, ch)); } }
        }
        asm volatile("s_waitcnt vmcnt(0)" ::: "memory"); __syncthreads();
#undef P4_TILE
#undef P4_SF
#undef P4_WAIT_SF
#undef P4_BAR
        }
        LBAR();

        }
        if (PH(6)) {
            PHASE_ENV(); const unsigned char* wl = ws + WS_W + (size_t)L * W_LAYER; (void)wl; FRESH_TID(ptid); pg8::Gemm g{mix, (const bf16*)(wl + WO_OUT), SEQ, D, D}; pg8::BatchOrder S; S.init(D, gsz, rank);
            pg8::EpiResid E{xb1, xb, ssqA};
            pg8::gemm_phase<pg8::EpiResid, pg8::BatchOrder, true, true>(lds, g, S, E, ptid);
        }
        TBAR();


#ifndef REP_P6
#define REP_P6 1
#endif
#pragma unroll 1
        for (int rep_ = 0; rep_ < REP_P6; ++rep_) {
        if (PH(7)) {
            PHASE_ENV(); const unsigned char* wl = ws + WS_W + (size_t)L * W_LAYER; (void)wl; FRESH_TID(ptid); pg8::Gemm g{xb, (const bf16*)(wl + WO_GU), SEQ, 2 * FF, D}; pg8::BatchOrder S; S.init(2 * FF, gsz, rank);
            PG8_LAS float* side = (PG8_LAS float*)(lds + SIDE_OFF); pg8::fill_rstd(S, ssqA, side, (const int*)nullptr, (PG8_LAS float*)nullptr, ptid); __syncthreads();
            pg8::EpiSwiGLU E{side, hmid};
            pg8::gemm_phase<pg8::EpiSwiGLU, pg8::BatchOrder, true, true>(lds, g, S, E, ptid);
        }
        TBAR();

        }
        if (PH(8)) {
            PHASE_ENV(); const unsigned char* wl = ws + WS_W + (size_t)L * W_LAYER; (void)wl; FRESH_TID(ptid); pg8::Gemm g{hmid, (const bf16*)(wl + WO_DOWN), SEQ, D, FF}; pg8::BatchOrder S; S.init(D, gsz, rank);
            pg8::EpiResid E{xb, xb, ssqA};
            pg8::gemm_phase<pg8::EpiResid, pg8::BatchOrder, true, true>(lds, g, S, E, ptid);
        }
#ifndef REP_PE
#define REP_PE 1
#endif
#pragma unroll 1
        for (int rep_ = 0; rep_ < REP_PE; ++rep_)
        if (PH(9)) {
            PHASE_ENV(); const unsigned char* wl = ws + WS_W + (size_t)L * W_LAYER; (void)wl; FRESH_TID(ptid); pg8::Gemm g{pb, (const bf16*)(wl + WO_PP), SEQ, D, PLE}; pg8::BatchOrder S; S.init(D, gsz, rank);
            pg8::EpiPlain E{eb, D};
            pg8::gemm_phase<pg8::EpiPlain, pg8::BatchOrder, true, true>(lds, g, S, E, ptid);
        }
        TBAR(); if (tmode) xcd_hfree_arrive(bar);

        if (PH(10)) {
            PHASE_ENV(); const unsigned char* wl = ws + WS_W + (size_t)L * W_LAYER; (void)wl; FRESH_TID(ptid); pg8::Gemm g{xb, (const bf16*)(wl + WO_PG), SEQ, D, D}; pg8::BatchOrder S; S.init(D, gsz, rank);
            PG8_LAS float* side = (PG8_LAS float*)(lds + SIDE_OFF); pg8::fill_rstd(S, ssqA, side, (const int*)nullptr, (PG8_LAS float*)nullptr, ptid); __syncthreads();
            pg8::EpiPle E{side, eb, xb, xb1, ssqB};
            pg8::gemm_phase<pg8::EpiPle, pg8::BatchOrder, true, true>(lds, g, S, E, ptid);
        }
        TBAR();
    }

    if (tmode) LBAR();
    if (PH(11)) { PHASE_ENV(); FRESH_TID(t_); const int lane = t_ & 63, gw = rank * NWAVES + __builtin_amdgcn_readfirstlane(t_ >> 6);
        const unsigned tmo = __hip_atomic_load((unsigned*)(ws + WS_CTL) + CW_BAR + XB_TMO, RLX_AGENT);
        for (int m = gw; m < SEQ; m += gsz * NWAVES) {
            float s = (lane < 16) ? ssqB[(size_t)m * 16 + lane] : 0.f; s = wave_sum(s);
            float rs = rsqrtf(s * (1.0f / 1024.0f) + EPS); if (tmo) rs = __builtin_nanf("");
#pragma unroll
            for (int j = 0; j < 2; ++j) { const v4u w = ((const GAS v4u*)(xb1 + (size_t)m * D))[lane + 64 * j]; const GAS f32x4* gp = (const GAS f32x4*)(a.g_final + (lane + 64 * j) * 8);
                f32x4 v0, v1; pg8::unpack8(w, v0, v1); GAS f32x4* op = (GAS f32x4*)(a.out + ((size_t)batch * SEQ + m) * D + (lane + 64 * j) * 8);
                op[0] = v0 * rs * gp[0]; op[1] = v1 * rs * gp[1]; }
        }
    }
}

extern "C" void kernel_launch(void* const* d_in, const int* in_sizes, int n_in, void* d_out, int out_size, void* d_ws, size_t ws_size, hipStream_t stream) {
    static int grid = 0;
    if (grid == 0) {
        if (n_in != 16 || in_sizes[0] != M * D || out_size != M * D || ws_size < WS_END) { fprintf(stderr, "kernel_launch: unexpected shapes (n_in %d, in0 %d, out %d, ws %zu < %zu)\n", n_in, n_in > 0 ? in_sizes[0] : -1, out_size, ws_size, (size_t)WS_END); grid = -1; return; }
        int dev = 0, cus = 0, per_cu = 0;
        if (hipGetDevice(&dev) != hipSuccess || hipDeviceGetAttribute(&cus, hipDeviceAttributeMultiprocessorCount, dev) != hipSuccess) { grid = -1; return; }
        if (hipFuncSetAttribute((const void*)fwd, hipFuncAttributeMaxDynamicSharedMemorySize, LDS_BYTES) != hipSuccess) { fprintf(stderr, "kernel_launch: hipFuncSetAttribute failed\n"); grid = -1; return; }
        if (hipOccupancyMaxActiveBlocksPerMultiprocessor(&per_cu, (const void*)fwd, NWAVES * 64, LDS_BYTES) != hipSuccess || per_cu < 1) fprintf(stderr, "kernel_launch: occupancy query reports %d\n", per_cu);
        (void)hipGetLastError();
        grid = cus;
    }
    if (grid < 0) return;
    if (hipMemsetAsync((char*)d_ws + WS_CTL, 0, CTL_ZERO_BYTES, stream) != hipSuccess) return;
    Args a{};
    a.x = (const float*)d_in[0]; a.p = (const float*)d_in[1]; a.pos = (const int*)d_in[2]; a.g_mix = (const float*)d_in[3]; a.w_in = (const float*)d_in[4]; a.pool_w = (const float*)d_in[5];
    a.pool_scale = (const float*)d_in[6]; a.w_out = (const float*)d_in[7]; a.g_ffn = (const float*)d_in[8]; a.w_gate = (const float*)d_in[9]; a.w_up = (const float*)d_in[10]; a.w_down = (const float*)d_in[11];
    a.g_ple = (const float*)d_in[12]; a.w_ple_gate = (const float*)d_in[13]; a.w_ple_proj = (const float*)d_in[14]; a.g_final = (const float*)d_in[15]; a.out = (float*)d_out; a.ws = (unsigned char*)d_ws;
    hipLaunchKernelGGL(fwd, dim3(grid), dim3(NWAVES * 64), LDS_BYTES, stream, a);
}
```

```cpp
#include <hip/hip_runtime.h>
#include <cstdio>
#include <cstdint>
namespace pg8 {
#define PG8_LAS __attribute__((address_space(3)))
typedef unsigned short bf16_t;
typedef short bf16x8 __attribute__((ext_vector_type(8)));
typedef float f32x4 __attribute__((ext_vector_type(4)));
typedef unsigned u32x4 __attribute__((ext_vector_type(4)));
constexpr int BM = 256, BK = 64, HALF = 128, HTB = HALF * BK * 2  , STAGE_BYTES = 8 * HTB, NXCD = 8, WGM = 8;

__host__ __device__ __forceinline__ int lds_byte(int r, int c) { const int st = (r >> 4) * 2 + (c >> 5), rr = r & 15, cc = c & 31, ob = rr * 64 + cc * 2; return st * 1024 + (ob ^ (((ob >> 9) & 1) << 5)); }
__host__ __device__ __forceinline__ void stage_rc(int b, int& R, int& C) { const int st = b / 1024, sb = b % 1024, swz = sb ^ (((sb >> 9) & 1) << 5); R = (st >> 1) * 16 + swz / 64; C = (st & 1) * 32 + (swz % 64) / 2; }
__host__ __device__ __forceinline__ int perm32(int rho) { const int n = rho >> 4, i = rho & 15; return 8 * (i >> 2) + 4 * n + (i & 3); }

struct Unit { int pm, pn; };
struct Gemm { const bf16_t* A; const bf16_t* Bt; int M, N, K; };

struct StaticOrder {
    int nM, nN, nwg, G, c;
    __host__ __device__ void init(int M, int N, int G_, int c_) { nM = M / BM; nN = N / BM; nwg = nM * nN; G = G_; c = c_; }
    __host__ __device__ bool next(int i, Unit& u) const {
        const long L = (long)i * G + c; if (L >= nwg) return false;
        int wgid = (int)L; { const int q = nwg / NXCD, r = nwg % NXCD, xcd = wgid % NXCD, off = wgid / NXCD; wgid = (xcd < r ? xcd * (q + 1) : r * (q + 1) + (xcd - r) * q) + off; }
        const int nig = WGM * nN, gid = wgid / nig, fm = gid * WGM, gsz = (nM - fm) < WGM ? (nM - fm) : WGM;
        u.pm = fm + ((wgid % nig) % gsz); u.pn = (wgid % nig) / gsz; return true;
    }
    __device__ __forceinline__ void a_ready(const Unit&) const {}
    __device__ __forceinline__ void done(const Unit&) const {}
};

typedef float f32x2_t __attribute__((ext_vector_type(2))); typedef __bf16 bf16x2_t __attribute__((ext_vector_type(2)));
__device__ __forceinline__ unsigned cvt_pk_bf16(float lo, float hi) { f32x2_t v = {lo, hi}; bf16x2_t b = __builtin_convertvector(v, bf16x2_t); return __builtin_bit_cast(unsigned, b); }
template <class Epi, class Sched, bool ALIGN_EPI = false, bool SP2 = false>
__device__ __forceinline__ void gemm_phase(PG8_LAS unsigned char* lds, const Gemm g, const Sched& S, const Epi& E, const int tid_in) {
    const int tid = tid_in, wid = __builtin_amdgcn_readfirstlane(tid >> 6), lane = tid & 63, wr = wid >> 2, wc = wid & 3, fr = lane & 15, fq = lane >> 4;
    const int K = g.K, nt = K / BK;
    unsigned voffA[2], voffB[2];
#pragma unroll
    for (int i = 0; i < 2; ++i) { int R, C; stage_rc(tid * 16 + i * 8192, R, C); const int Rb = Epi::PERM ? ((R & ~31) + perm32(R & 31)) : R;
        voffA[i] = (unsigned)(R * K + C) * 2u; voffB[i] = (unsigned)(Rb * K + C) * 2u; }
    const size_t kstep = (size_t)(BK * 2);
    const size_t hstep = (size_t)HALF * K * 2;
    const size_t tstep = 2 * hstep;
    const unsigned ldsw = (unsigned)wid * 1024u;
    const int aoff = lds_byte(wr * 64 + fr, fq * 8), boff = lds_byte(wc * 32 + fr, fq * 8);
#define PG8_SA(b, h) (((b) * 2 + (h)) * HTB)
#define PG8_SB(b, h) ((4 + (b) * 2 + (h)) * HTB)
#define PG8_STAGE(bufoff, gbase, voff) do { _Pragma("unroll") for (int _i = 0; _i < 2; ++_i) \
        __builtin_amdgcn_global_load_lds((const unsigned*)((const char*)(gbase) + (voff)[_i]), (PG8_LAS unsigned*)(lds + (bufoff) + ldsw + _i * 8192), 16, 0, 0); } while (0)
#define PG8_LDA(dst, b, h) do { _Pragma("unroll") for (int m = 0; m < 4; ++m) _Pragma("unroll") for (int k = 0; k < 2; ++k) dst[m][k] = *(const PG8_LAS bf16x8*)(lds + PG8_SA(b, h) + aoff + m * 2048 + k * 1024); } while (0)
#define PG8_LDB(dst, b, h) do { _Pragma("unroll") for (int n = 0; n < 2; ++n) _Pragma("unroll") for (int k = 0; k < 2; ++k) dst[n][k] = *(const PG8_LAS bf16x8*)(lds + PG8_SB(b, h) + boff + n * 2048 + k * 1024); } while (0)
#define PG8_MMA(ai, bj, At, Bt) do { __builtin_amdgcn_s_setprio(1); _Pragma("unroll") for (int m = 0; m < 4; ++m) _Pragma("unroll") for (int n = 0; n < 2; ++n) _Pragma("unroll") for (int k = 0; k < 2; ++k) \
        acc[ai][bj][m][n] = __builtin_amdgcn_mfma_f32_16x16x32_bf16(Bt[n][k], At[m][k], acc[ai][bj][m][n], 0, 0, 0); __builtin_amdgcn_s_setprio(0); } while (0)
#define PG8_WAIT_V(n) asm volatile("s_waitcnt vmcnt(" #n ")" ::: "memory")
#define PG8_WAIT_L(n) asm volatile("s_waitcnt lgkmcnt(" #n ")" ::: "memory")
#define PG8_BAR __builtin_amdgcn_s_barrier()
#define PG8_SCHED __builtin_amdgcn_sched_barrier(0)
    Unit cur, nxt; int ui = 0;
    if (!S.next(0, cur)) return;
    f32x4 acc[2][2][4][2];
    E.init(acc, cur, wr, wc, fr, fq);
    bf16x8 At[4][2], B0[2][2], B1[2][2];
    const char* cA = (const char*)g.A + (size_t)cur.pm * tstep; const char* cB = (const char*)g.Bt + (size_t)cur.pn * tstep;
    S.a_ready(cur);
    if constexpr (SP2) {
        PG8_STAGE(PG8_SB(0, 0), cB, voffB); PG8_STAGE(PG8_SB(0, 1), cB + hstep, voffB); PG8_STAGE(PG8_SA(0, 0), cA, voffA); PG8_STAGE(PG8_SA(0, 1), cA + hstep, voffA);
        if (wr == 1) PG8_BAR;
        PG8_WAIT_V(2); PG8_BAR;
        PG8_STAGE(PG8_SB(1, 0), cB + kstep, voffB); PG8_STAGE(PG8_SA(1, 0), cA + kstep, voffA); PG8_STAGE(PG8_SB(1, 1), cB + hstep + kstep, voffB);
        PG8_WAIT_V(6); PG8_BAR;
    } else {
        PG8_STAGE(PG8_SB(0, 0), cB, voffB); PG8_STAGE(PG8_SA(0, 0), cA, voffA); PG8_STAGE(PG8_SB(0, 1), cB + hstep, voffB); PG8_STAGE(PG8_SA(0, 1), cA + hstep, voffA);
        if (wr == 1) PG8_BAR;
        PG8_WAIT_V(4); PG8_BAR;
        PG8_STAGE(PG8_SB(1, 0), cB + kstep, voffB); PG8_STAGE(PG8_SA(1, 0), cA + kstep, voffA); PG8_STAGE(PG8_SB(1, 1), cB + hstep + kstep, voffB);
        PG8_WAIT_V(6); PG8_BAR;
    }
    for (;;) {
        const bool has_next = S.next(ui + 1, nxt);
        const char* nA = has_next ? (const char*)g.A + (size_t)nxt.pm * tstep : cA; const char* nB = has_next ? (const char*)g.Bt + (size_t)nxt.pn * tstep : cB;
#pragma unroll 1
        for (int t = 0; t < nt; t += 2) {
            const bool last = (t == nt - 2);
            const char* a1 = cA + (size_t)(t + 1) * kstep;
            const char* a2 = last ? nA : cA + (size_t)(t + 2) * kstep; const char* b2 = last ? nB : cB + (size_t)(t + 2) * kstep;
            const char* a3 = a2 + kstep; const char* b3 = b2 + kstep;
            if (last && has_next) S.a_ready(nxt);
            if constexpr (SP2) {
            PG8_LDB(B0, 0, 0); PG8_LDB(B1, 0, 1); PG8_SCHED; PG8_LDA(At, 0, 0); PG8_STAGE(PG8_SA(1, 1), a1 + hstep, voffA);
            PG8_WAIT_V(8); PG8_WAIT_L(0); PG8_BAR; PG8_MMA(0, 0, At, B0); PG8_MMA(0, 1, At, B1); PG8_BAR; PG8_SCHED;
            PG8_LDA(At, 0, 1); PG8_STAGE(PG8_SB(0, 0), b2, voffB); PG8_STAGE(PG8_SB(0, 1), b2 + hstep, voffB); PG8_STAGE(PG8_SA(0, 0), a2, voffA);
            PG8_WAIT_V(8); PG8_WAIT_L(0); PG8_BAR; PG8_MMA(1, 0, At, B0); PG8_MMA(1, 1, At, B1); PG8_BAR; PG8_SCHED;
            PG8_LDB(B0, 1, 0); PG8_LDB(B1, 1, 1); PG8_SCHED; PG8_LDA(At, 1, 0); PG8_STAGE(PG8_SA(0, 1), a2 + hstep, voffA);
            PG8_WAIT_V(8); PG8_WAIT_L(0); PG8_BAR; PG8_MMA(0, 0, At, B0); PG8_MMA(0, 1, At, B1); PG8_BAR; PG8_SCHED;
            PG8_LDA(At, 1, 1); PG8_STAGE(PG8_SB(1, 0), b3, voffB); PG8_STAGE(PG8_SB(1, 1), b3 + hstep, voffB); PG8_STAGE(PG8_SA(1, 0), a3, voffA);
            PG8_WAIT_V(8); PG8_WAIT_L(0); PG8_BAR; PG8_MMA(1, 0, At, B0); PG8_MMA(1, 1, At, B1); PG8_BAR; PG8_SCHED;
            } else {
            PG8_LDB(B0, 0, 0); PG8_SCHED; PG8_LDA(At, 0, 0); PG8_STAGE(PG8_SA(1, 1), a1 + hstep, voffA);
            PG8_WAIT_L(8); PG8_BAR; PG8_WAIT_L(0); PG8_MMA(0, 0, At, B0); PG8_BAR; PG8_SCHED;
            PG8_LDB(B1, 0, 1); PG8_STAGE(PG8_SB(0, 0), b2, voffB);
            PG8_BAR; PG8_WAIT_L(0); PG8_MMA(0, 1, At, B1); PG8_BAR;
            PG8_LDA(At, 0, 1); PG8_STAGE(PG8_SA(0, 0), a2, voffA);
            PG8_BAR; PG8_WAIT_L(0); PG8_MMA(1, 0, At, B0); PG8_BAR; PG8_SCHED;
            PG8_STAGE(PG8_SB(0, 1), b2 + hstep, voffB);
            PG8_WAIT_V(6); PG8_BAR; PG8_MMA(1, 1, At, B1); PG8_BAR;
            PG8_LDB(B0, 1, 0); PG8_SCHED; PG8_LDA(At, 1, 0); PG8_STAGE(PG8_SA(0, 1), a2 + hstep, voffA);
            PG8_WAIT_L(8); PG8_BAR; PG8_WAIT_L(0); PG8_MMA(0, 0, At, B0); PG8_BAR; PG8_SCHED;
            PG8_LDB(B1, 1, 1); PG8_STAGE(PG8_SB(1, 0), b3, voffB);
            PG8_BAR; PG8_WAIT_L(0); PG8_MMA(0, 1, At, B1); PG8_BAR;
            PG8_LDA(At, 1, 1); PG8_STAGE(PG8_SA(1, 0), a3, voffA);
            PG8_BAR; PG8_WAIT_L(0); PG8_MMA(1, 0, At, B0); PG8_BAR; PG8_SCHED;
            PG8_STAGE(PG8_SB(1, 1), b3 + hstep, voffB);
            PG8_WAIT_V(6); PG8_BAR; PG8_MMA(1, 1, At, B1); PG8_BAR;
            }
        }
        if constexpr (ALIGN_EPI) { if (wr == 0) PG8_BAR; }
        if constexpr (!Epi::AFTER_DRAIN) { E(acc, cur, wr, wc, fr, fq, ui); S.done(cur); }
        if (!has_next) break;
        E.init(acc, nxt, wr, wc, fr, fq);
        cur = nxt; cA = nA; cB = nB; ++ui;
        if constexpr (ALIGN_EPI) { if (wr == 1) PG8_BAR; }
    }
    PG8_WAIT_V(0);
    if constexpr (!ALIGN_EPI) { if (wr == 0) PG8_BAR; }
    PG8_BAR;
    if constexpr (Epi::AFTER_DRAIN) { E.fused(acc, cur, wr, wc, fr, fq, lds, wid, lane); S.done(cur); }
#undef PG8_SA
#undef PG8_SB
#undef PG8_STAGE
#undef PG8_LDA
#undef PG8_LDB
#undef PG8_MMA
#undef PG8_WAIT_V
#undef PG8_WAIT_L
#undef PG8_BAR
#undef PG8_SCHED
}
}

constexpr int BATCH = 8, SEQ = 4096, D = 1024, DEPTH = 4, M = BATCH * SEQ;
constexpr int NH = 4, DH = 128, RW = 512, CHUNK = 128, NCH = SEQ / CHUNK;
constexpr int INW = 2560, FF = 2816, PLE = 256;
constexpr float EPS = 1e-6f;
constexpr int NWAVES = 8;

constexpr size_t MiB = 1u << 20;
constexpr size_t WS_CTL = 0, CTL_ZERO_BYTES = 1 * MiB;
constexpr size_t WS_SSQA = 1 * MiB, WS_SSQB = 3 * MiB;
constexpr size_t WS_W = 8 * MiB, W_LAYER = 26 * MiB;
constexpr size_t WO_IN = 0, WO_OUT = 5 * MiB, WO_GU = 7 * MiB, WO_DOWN = 18 * MiB, WO_PG = 18 * MiB + 5632 * 1024, WO_PP = WO_PG + 2 * MiB;
static_assert(WO_PP + 512 * 1024 == W_LAYER, "weight map");
constexpr size_t WS_XB = 112 * MiB;
constexpr size_t WS_PB = 176 * MiB;
constexpr size_t WS_R = 192 * MiB;
constexpr size_t R_BATCH = 32 * MiB;
constexpr size_t R_Q = 0, R_K = 4 * MiB, R_V = 8 * MiB, R_G = 12 * MiB, R_UW = 16 * MiB, R_KV = 20 * MiB, R_MIX = 24 * MiB;
constexpr size_t R_H = 0, R_E = 24 * MiB, R_UT = 0;
constexpr size_t WS_XB1 = WS_R + 256 * MiB;
constexpr size_t WS_END = WS_XB1 + 64 * MiB;
static_assert((size_t)SEQ * FF * 2 <= R_MIX && R_MIX + (size_t)SEQ * D * 2 == R_BATCH, "per-batch scratch map");
constexpr int CW_BAR = 4096;

constexpr int RING_BYTES = 131072;
constexpr int LDSCTL_OFF = RING_BYTES, MISC_OFF = LDSCTL_OFF + 320;
constexpr int SIDE_OFF = LDSCTL_OFF + 1024;
constexpr int LDS_BYTES = 147456;

#define GAS __attribute__((address_space(1)))
#define LAS __attribute__((address_space(3)))
typedef unsigned short bf16;
typedef unsigned v4u __attribute__((ext_vector_type(4)));
typedef unsigned v2u __attribute__((ext_vector_type(2)));
typedef float f32x4 __attribute__((ext_vector_type(4)));
typedef float f32x16 __attribute__((ext_vector_type(16)));
typedef short bf16x8 __attribute__((ext_vector_type(8)));
typedef short s16x4 __attribute__((ext_vector_type(4)));
typedef GAS unsigned gu32;
#define RLX_AGENT __ATOMIC_RELAXED, __HIP_MEMORY_SCOPE_AGENT
#define LDS_WAIT() asm volatile("s_waitcnt lgkmcnt(0)" ::: "memory")
#define VM_WAIT() asm volatile("s_waitcnt vmcnt(0)" ::: "memory")
__device__ __forceinline__ unsigned f2bf(float f) { unsigned u = __builtin_bit_cast(unsigned, f); return (u + 0x7fffu + ((u >> 16) & 1u)) >> 16; }
__device__ __forceinline__ unsigned pk2(float lo, float hi) { return f2bf(lo) | (f2bf(hi) << 16); }
__device__ __forceinline__ float bf_lo(unsigned w) { return __builtin_bit_cast(float, w << 16); }
__device__ __forceinline__ float bf_hi(unsigned w) { return __builtin_bit_cast(float, w & 0xffff0000u); }

__device__ const float ROPE_HI[64] = {1.591186523e-01f, 1.378173828e-01f, 1.193237305e-01f, 1.033325195e-01f, 8.947753906e-02f, 7.748413086e-02f, 6.710815430e-02f, 5.810546875e-02f, 5.032348633e-02f, 4.357910156e-02f, 3.773498535e-02f, 3.266906738e-02f, 2.829742432e-02f, 2.450561523e-02f, 2.121734619e-02f, 1.837158203e-02f, 1.591491699e-02f, 1.377868652e-02f, 1.193237305e-02f, 1.033401489e-02f, 8.949279785e-03f, 7.749557495e-03f, 6.710052490e-03f, 5.811691284e-03f, 5.031585693e-03f, 4.358291626e-03f, 3.773689270e-03f, 3.268241882e-03f, 2.829551697e-03f, 2.449989319e-03f, 2.121925354e-03f, 1.837730408e-03f, 1.591205597e-03f, 1.378059387e-03f, 1.193046570e-03f, 1.033306122e-03f, 8.947849274e-04f, 7.748603821e-04f, 6.711483002e-04f, 5.810260773e-04f, 5.030632019e-04f, 4.358291626e-04f, 3.772974014e-04f, 3.267526627e-04f, 2.830028534e-04f, 2.449750900e-04f, 2.121925354e-04f, 1.837611198e-04f, 1.591444016e-04f, 1.378059387e-04f, 1.193284988e-04f, 1.033246517e-04f, 8.949637413e-05f, 7.748603821e-05f, 6.711483002e-05f, 5.811452866e-05f, 5.032122135e-05f, 4.357099533e-05f, 3.772974014e-05f, 3.267824650e-05f, 2.829730511e-05f, 2.450495958e-05f, 2.121925354e-05f, 1.837313175e-05f};
__device__ const float ROPE_LO[64] = {3.629074854e-05f, 5.119791695e-06f, 2.563974340e-05f, 1.977708780e-05f, 2.186254642e-05f, 1.915789653e-05f, 6.928708444e-06f, 1.379869173e-05f, 5.725776191e-06f, 4.200542662e-06f, 6.599365861e-06f, 1.379848982e-05f, 4.771514341e-06f, 3.076627763e-06f, 6.306573596e-06f, 7.344074220e-06f, 5.773169960e-07f, 3.563736982e-06f, 2.563974249e-06f, 1.214769213e-06f, 6.603757470e-07f, 7.713804280e-07f, 1.455810320e-06f, 2.354600070e-07f, 1.335517140e-06f, 3.858455244e-08f, 4.692017228e-07f, 4.470491177e-08f, 6.678862974e-07f, 8.798673434e-07f, 4.399224736e-07f, 1.622028520e-07f, 3.438339888e-07f, 1.656388378e-07f, 4.471322939e-07f, 2.168443558e-07f, 2.090887250e-07f, 1.725054801e-07f, 2.529881415e-09f, 1.665971467e-07f, 2.289191343e-07f, 3.858455333e-09f, 1.184457474e-07f, 7.599606278e-08f, 1.910491321e-08f, 1.118285908e-07f, 4.399224807e-08f, 2.814121380e-08f, 1.054154186e-08f, 1.656388271e-08f, 2.087137041e-08f, 2.764489970e-08f, 3.027478712e-09f, 1.725054766e-08f, 2.529881304e-10f, 4.738785808e-09f, 7.990752948e-09f, 1.230677427e-08f, 1.184457421e-08f, 4.619374216e-09f, 4.890723382e-09f, 3.732278930e-09f, 4.399224540e-09f, 5.794353886e-09f};
__device__ __forceinline__ float lg2gamma(int h) { return h == 0 ? -0.04580368961312479f : h == 1 ? -0.02272007650008353f : h == 2 ? -0.011315313227834146f : -0.005646563141142063f; }

__device__ __forceinline__ float add_xor16(float v) { return v + __builtin_bit_cast(float, __builtin_amdgcn_ds_swizzle(__builtin_bit_cast(int, v), 0x401F)); }
__device__ __forceinline__ float add_xor32(float v) { float a_ = v, b_ = v; asm volatile("s_nop 1\n\tv_permlane32_swap_b32 %0, %1" : "+v"(a_), "+v"(b_)); return a_ + b_; }
namespace pg8 {
#ifndef BO_GRP
#define BO_GRP 8
#endif
struct BatchOrder {
    int nN, gsize, rank, nwg;
    __device__ __forceinline__ void init(int N, int gsize_, int rank_) { nN = N / BM; gsize = gsize_; rank = rank_; nwg = 16 * nN; }
    __device__ __forceinline__ bool next(int i, Unit& u) const {
        const int L = i * gsize + rank; if (L >= nwg) return false;
#if defined(BO_ORDER) && BO_ORDER == 1
        const int nb = nN >> 2;
        if (L < nb * 64) { const int q = L >> 6, r = L & 63, g = r >> 5, w = r & 31; u.pm = 8 * g + (w & 7); u.pn = 4 * q + (w >> 3); }
        else { const int Lt = L - nb * 64, rem = nN - 4 * nb, g = Lt / (8 * rem), w = Lt - g * 8 * rem; u.pm = 8 * g + (w & 7); u.pn = 4 * nb + (w >> 3); }
        return true;
#else
        const int grp = L / (BO_GRP * nN), r = L - grp * BO_GRP * nN; u.pm = BO_GRP * grp + (r % BO_GRP); u.pn = r / BO_GRP; return true;
#endif
    }
    __device__ __forceinline__ void a_ready(const Unit&) const {}
    __device__ __forceinline__ void done(const Unit&) const {}
};
__device__ __forceinline__ void load_rstd(const PG8_LAS float* side, int ui, int wr, int fr, float (&rs)[2][4]) {
#pragma unroll
    for (int ai = 0; ai < 2; ++ai)
#pragma unroll
        for (int m = 0; m < 4; ++m) rs[ai][m] = side[ui * 256 + ai * HALF + wr * 64 + m * 16 + fr];
}
template <class Sched> __device__ __forceinline__ void fill_rstd(const Sched& S, const float* ssq, PG8_LAS float* side, const int* pos, PG8_LAS float* posf, int tid) {
    Unit u;
    for (int i = 0; S.next(i, u); ++i) {
        const int row = u.pm * BM + (tid >> 1), hf = tid & 1;
        const f32x4 a = *(const f32x4*)(ssq + (size_t)row * 16 + 8 * hf), b = *(const f32x4*)(ssq + (size_t)row * 16 + 8 * hf + 4);
        float s = ((a[0] + a[1]) + (a[2] + a[3])) + ((b[0] + b[1]) + (b[2] + b[3]));
        s += __builtin_bit_cast(float, __builtin_amdgcn_ds_swizzle(__builtin_bit_cast(int, s), 0x041F));
        if (hf == 0) { side[i * 256 + (tid >> 1)] = rsqrtf(s * (1.0f / 1024.0f) + 1e-6f); if (pos) posf[i * 256 + (tid >> 1)] = (float)pos[row]; }
    }
}
#ifndef WTM
#define WTM 0
#endif
template <int BIT> __device__ __forceinline__ void st16(void* p, const u32x4 v) {
    if constexpr ((WTM >> BIT) & 1) asm volatile("global_store_dwordx4 %0, %1, off sc1\n\ts_nop 0" :: "v"(p), "v"(v) : "memory");
    else *(u32x4*)p = v;
}
__device__ __forceinline__ u32x4 pack8(const f32x4 a, const f32x4 b) { u32x4 w; w.x = cvt_pk_bf16(a[0], a[1]); w.y = cvt_pk_bf16(a[2], a[3]); w.z = cvt_pk_bf16(b[0], b[1]); w.w = cvt_pk_bf16(b[2], b[3]); return w; }

struct EpiInProj {
    static constexpr bool PERM = true, AFTER_DRAIN = false;
    const PG8_LAS float* side; const PG8_LAS float* posf; const PG8_LAS float* rope; bf16_t *q, *k, *v, *g, *uw;
    __device__ __forceinline__ void init(f32x4 (&acc)[2][2][4][2], const Unit&, int, int, int, int) const {
#pragma unroll
        for (int a = 0; a < 2; ++a)
#pragma unroll
            for (int b = 0; b < 2; ++b)
#pragma unroll
                for (int m = 0; m < 4; ++m)
#pragma unroll
                    for (int n = 0; n < 2; ++n) acc[a][b][m][n] = (f32x4){0.f, 0.f, 0.f, 0.f};
    }
    __device__ __forceinline__ void operator()(const f32x4 (&acc)[2][2][4][2], const Unit& u, int wr, int wc, int fr, int fq, int ui) const {
        const int rowbase = u.pm * BM + wr * 64 + fr;
        float rs[2][4]; load_rstd(side, ui, wr, fr, rs);
        if (u.pn < 4) {
            const int sec = u.pn >> 1, head = 2 * (u.pn & 1) + (wc >> 1), dd0 = 32 * (wc & 1) + 8 * fq;
            bf16_t* dst = sec ? k : q;
            const f32x4 h0 = *(const PG8_LAS f32x4*)(rope + dd0), h1 = *(const PG8_LAS f32x4*)(rope + dd0 + 4), l0 = *(const PG8_LAS f32x4*)(rope + 64 + dd0), l1 = *(const PG8_LAS f32x4*)(rope + 64 + dd0 + 4);
            const float lg = lg2gamma(head);
#pragma unroll
            for (int ai = 0; ai < 2; ++ai)
#pragma unroll
                for (int m = 0; m < 4; ++m) {
                    const int row = rowbase + ai * HALF + m * 16, b = row >> 12, s = row & 4095;
                    const float p = posf[ui * 256 + ai * HALF + wr * 64 + m * 16 + fr];
                    const float sc = rs[ai][m] * (sec ? __builtin_amdgcn_exp2f((float)(127 - (s & 127)) * lg) : 1.0f);
                    f32x4 o1[2], o2[2];
#pragma unroll
                    for (int n = 0; n < 2; ++n) { const f32x4 fh = n ? h1 : h0, fl = n ? l1 : l0;
#pragma unroll
                        for (int j = 0; j < 4; ++j) { const float ph = p * fh[j]; const float rev = (ph - __builtin_floorf(ph)) + p * fl[j];
                            const float cs = __builtin_amdgcn_cosf(rev), sn = __builtin_amdgcn_sinf(rev);
                            const float x1 = acc[ai][0][m][n][j] * sc, x2 = acc[ai][1][m][n][j] * sc;
                            o1[n][j] = x1 * cs - x2 * sn; o2[n][j] = x2 * cs + x1 * sn; } }
                    bf16_t* rp = dst + ((size_t)((b * NH_ + head) * SEQ_ + s)) * 128 + dd0;
                    st16<0>(rp, pack8(o1[0], o1[1])); st16<0>((rp + 64), pack8(o2[0], o2[1]));
                    asm volatile("" ::: "memory");
                }
        } else {
            const int sec = (u.pn - 4) >> 1;
            const int c0 = 256 * (u.pn & 1) + 32 * wc + 8 * fq;
#pragma unroll
            for (int ai = 0; ai < 2; ++ai)
#pragma unroll
                for (int m = 0; m < 4; ++m) {
                    const int row = rowbase + ai * HALF + m * 16, b = row >> 12, s = row & 4095; const float sc = rs[ai][m];
#pragma unroll
                    for (int bj = 0; bj < 2; ++bj) { const u32x4 w = pack8(acc[ai][bj][m][0] * sc, acc[ai][bj][m][1] * sc); const int c = c0 + 128 * bj;
                        if (sec == 2) st16<0>((uw + (size_t)row * 512 + c), w);
                        else { bf16_t* dst = sec ? g : v; st16<0>((dst + ((size_t)((b * NH_ + (c >> 7)) * SEQ_ + s)) * 128 + (c & 127)), w); } }
                }
        }
    }
    static constexpr int NH_ = 4, SEQ_ = 4096;
};

__device__ __forceinline__ void unpack8(const u32x4 w, f32x4& a, f32x4& b) {
    a[0] = __builtin_bit_cast(float, w.x << 16); a[1] = __builtin_bit_cast(float, w.x & 0xffff0000u); a[2] = __builtin_bit_cast(float, w.y << 16); a[3] = __builtin_bit_cast(float, w.y & 0xffff0000u);
    b[0] = __builtin_bit_cast(float, w.z << 16); b[1] = __builtin_bit_cast(float, w.z & 0xffff0000u); b[2] = __builtin_bit_cast(float, w.w << 16); b[3] = __builtin_bit_cast(float, w.w & 0xffff0000u);
}
struct EpiResid {
    static constexpr bool PERM = true, AFTER_DRAIN = false;
    const bf16_t* xin; bf16_t* xout; float* ssq_out;
    __device__ __forceinline__ void init(f32x4 (&acc)[2][2][4][2], const Unit& u, int wr, int wc, int fr, int fq) const {
        const int rowbase = u.pm * BM + wr * 64 + fr, col0 = u.pn * BM + 32 * wc + 8 * fq;
        u32x4 w[2][4][2];
#pragma unroll
        for (int ai = 0; ai < 2; ++ai)
#pragma unroll
            for (int m = 0; m < 4; ++m)
#pragma unroll
                for (int bj = 0; bj < 2; ++bj) w[ai][m][bj] = *(const u32x4*)(xin + (size_t)(rowbase + ai * HALF + m * 16) * 1024 + col0 + bj * HALF);
#pragma unroll
        for (int ai = 0; ai < 2; ++ai)
#pragma unroll
            for (int m = 0; m < 4; ++m)
#pragma unroll
                for (int bj = 0; bj < 2; ++bj) unpack8(w[ai][m][bj], acc[ai][bj][m][0], acc[ai][bj][m][1]);
    }
    __device__ __forceinline__ void operator()(const f32x4 (&acc)[2][2][4][2], const Unit& u, int wr, int wc, int fr, int fq, int) const {
        const int rowbase = u.pm * BM + wr * 64 + fr, col0 = u.pn * BM + 32 * wc + 8 * fq;
#pragma unroll
        for (int ai = 0; ai < 2; ++ai)
#pragma unroll
            for (int m = 0; m < 4; ++m) {
                const int row = rowbase + ai * HALF + m * 16; const size_t off = (size_t)row * 1024 + col0; float ss = 0.f;
#pragma unroll
                for (int bj = 0; bj < 2; ++bj) {
                    const f32x4 v0 = acc[ai][bj][m][0], v1 = acc[ai][bj][m][1];
                    st16<1>((xout + off + bj * HALF), pack8(v0, v1));
                    ss += (v0[0] * v0[0] + v0[1] * v0[1]) + (v0[2] * v0[2] + v0[3] * v0[3]) + (v1[0] * v1[0] + v1[1] * v1[1]) + (v1[2] * v1[2] + v1[3] * v1[3]); }
                ss = add_xor32(add_xor16(ss));
                if (fq == 0) ssq_out[(size_t)row * 16 + u.pn * 4 + wc] = ss;
            }
    }
};

struct EpiSwiGLU {
    static constexpr bool PERM = true, AFTER_DRAIN = false;
    const PG8_LAS float* side; bf16_t* h;
    __device__ __forceinline__ void init(f32x4 (&acc)[2][2][4][2], const Unit&, int, int, int, int) const {
#pragma unroll
        for (int a = 0; a < 2; ++a)
#pragma unroll
            for (int b = 0; b < 2; ++b)
#pragma unroll
                for (int m = 0; m < 4; ++m)
#pragma unroll
                    for (int n = 0; n < 2; ++n) acc[a][b][m][n] = (f32x4){0.f, 0.f, 0.f, 0.f};
    }
    __device__ __forceinline__ void operator()(const f32x4 (&acc)[2][2][4][2], const Unit& u, int wr, int wc, int fr, int fq, int ui) const {
        const int rowbase = u.pm * BM + wr * 64 + fr, col0 = u.pn * HALF + 32 * wc + 8 * fq;
        float rs[2][4]; load_rstd(side, ui, wr, fr, rs);
#pragma unroll
        for (int ai = 0; ai < 2; ++ai)
#pragma unroll
            for (int m = 0; m < 4; ++m) { const float sc = rs[ai][m], c1 = -1.4426950408889634f * sc, sc2 = sc * sc; f32x4 o[2];
#pragma unroll
                for (int n = 0; n < 2; ++n)
#pragma unroll
                    for (int jp = 0; jp < 2; ++jp) { const f32x2_t av = {acc[ai][0][m][n][2 * jp], acc[ai][0][m][n][2 * jp + 1]}, bv = {acc[ai][1][m][n][2 * jp], acc[ai][1][m][n][2 * jp + 1]};
                        const f32x2_t t = av * c1; f32x2_t ex; ex.x = __builtin_amdgcn_exp2f(t.x); ex.y = __builtin_amdgcn_exp2f(t.y);
                        const f32x2_t d = ex + 1.0f; f32x2_t r; r.x = __builtin_amdgcn_rcpf(d.x); r.y = __builtin_amdgcn_rcpf(d.y);
                        const f32x2_t ov = (av * bv) * (r * sc2); o[n][2 * jp] = ov.x; o[n][2 * jp + 1] = ov.y; }
                st16<2>((h + (size_t)(rowbase + ai * HALF + m * 16) * 2816 + col0), pack8(o[0], o[1])); }
    }
};

struct EpiPlain {
    static constexpr bool PERM = true, AFTER_DRAIN = false;
    bf16_t* O; int ldc;
    __device__ __forceinline__ void init(f32x4 (&acc)[2][2][4][2], const Unit&, int, int, int, int) const {
#pragma unroll
        for (int a = 0; a < 2; ++a)
#pragma unroll
            for (int b = 0; b < 2; ++b)
#pragma unroll
                for (int m = 0; m < 4; ++m)
#pragma unroll
                    for (int n = 0; n < 2; ++n) acc[a][b][m][n] = (f32x4){0.f, 0.f, 0.f, 0.f};
    }
    __device__ __forceinline__ void operator()(const f32x4 (&acc)[2][2][4][2], const Unit& u, int wr, int wc, int fr, int fq, int) const {
        const int rowbase = u.pm * BM + wr * 64 + fr, col0 = u.pn * BM + 32 * wc + 8 * fq;
#pragma unroll
        for (int ai = 0; ai < 2; ++ai)
#pragma unroll
            for (int m = 0; m < 4; ++m)
#pragma unroll
                for (int bj = 0; bj < 2; ++bj) st16<3>((O + (size_t)(rowbase + ai * HALF + m * 16) * ldc + col0 + bj * HALF), pack8(acc[ai][bj][m][0], acc[ai][bj][m][1]));
    }
};

struct EpiPle {
    static constexpr bool PERM = true, AFTER_DRAIN = false;
    const PG8_LAS float* side; const bf16_t* e; const bf16_t* xin; bf16_t* xout; float* ssq_out;
    __device__ __forceinline__ void init(f32x4 (&acc)[2][2][4][2], const Unit&, int, int, int, int) const {
#pragma unroll
        for (int a = 0; a < 2; ++a)
#pragma unroll
            for (int b = 0; b < 2; ++b)
#pragma unroll
                for (int m = 0; m < 4; ++m)
#pragma unroll
                    for (int n = 0; n < 2; ++n) acc[a][b][m][n] = (f32x4){0.f, 0.f, 0.f, 0.f};
    }
    __device__ __forceinline__ void operator()(const f32x4 (&acc)[2][2][4][2], const Unit& u, int wr, int wc, int fr, int fq, int ui) const {
        const int rowbase = u.pm * BM + wr * 64 + fr, col0 = u.pn * BM + 32 * wc + 8 * fq;
        float rs[2][4]; load_rstd(side, ui, wr, fr, rs);
#pragma unroll
        for (int ai = 0; ai < 2; ++ai)
#pragma unroll
            for (int m = 0; m < 4; ++m) {
                const int row = rowbase + ai * HALF + m * 16; const size_t off = (size_t)row * 1024 + col0; float ss = 0.f; const float sc = -1.4426950408889634f * rs[ai][m];
#pragma unroll
                for (int bj = 0; bj < 2; ++bj) {
                    f32x4 e0, e1, x0, x1; unpack8(*(const u32x4*)(e + off + bj * HALF), e0, e1); unpack8(*(const u32x4*)(xin + off + bj * HALF), x0, x1);
                    f32x4 v0, v1;
#pragma unroll
                    for (int j = 0; j < 4; ++j) {
                        v0[j] = x0[j] + __builtin_amdgcn_rcpf(1.0f + __builtin_amdgcn_exp2f(sc * acc[ai][bj][m][0][j])) * e0[j];
                        v1[j] = x1[j] + __builtin_amdgcn_rcpf(1.0f + __builtin_amdgcn_exp2f(sc * acc[ai][bj][m][1][j])) * e1[j]; }
                    st16<4>((xout + off + bj * HALF), pack8(v0, v1));
                    ss += (v0[0] * v0[0] + v0[1] * v0[1]) + (v0[2] * v0[2] + v0[3] * v0[3]) + (v1[0] * v1[0] + v1[1] * v1[1]) + (v1[2] * v1[2] + v1[3] * v1[3]); }
                ss = add_xor32(add_xor16(ss));
                if (fq == 0) ssq_out[(size_t)row * 16 + u.pn * 4 + wc] = ss;
            }
    }
};
}
#define XB_TMO      128
#define XB_XCNT(j)  (256  + 64 * (j))
#define XB_XSUB(j)  (1280 + 64 * (j))
#define XB_XGEN(j)  (2304 + 64 * (j))
#define XB_TOP      3328
#define XB_TOPGEN   3392
#define XCD_BAR_WORDS 3456
#define XB_SPIN_CAP (1u << 18)

__device__ __forceinline__ unsigned xb_ld(unsigned* p)              { return __hip_atomic_load(p, __ATOMIC_RELAXED, __HIP_MEMORY_SCOPE_AGENT); }
__device__ __forceinline__ unsigned xb_add(unsigned* p, unsigned v) { return __hip_atomic_fetch_add(p, v, __ATOMIC_RELAXED, __HIP_MEMORY_SCOPE_AGENT); }
__device__ __forceinline__ unsigned xb_xcc_id() { return (unsigned)__builtin_amdgcn_s_getreg((3 << 11) | 20) & 0xFu; }
#define XB_SPIN(cond, bar) do { unsigned _sp = 0; while (cond) { __builtin_amdgcn_s_sleep(1); \
    if ((++_sp & 255u) == 0u) { if (xb_ld(&(bar)[XB_TMO])) break; if (_sp > XB_SPIN_CAP) { atomicAdd(&(bar)[XB_TMO], 1u); break; } } } } while (0)

struct XcdBarrier {
    unsigned* bar; unsigned x;
    volatile LAS unsigned* st;
};

__device__ __forceinline__ XcdBarrier xcd_barrier_post(unsigned* bar, volatile LAS unsigned* st) {
    XcdBarrier b; b.bar = bar; b.x = xb_xcc_id(); b.st = st;
    if (threadIdx.x == 0) st[2] = xb_add(&bar[XB_XCNT(b.x)], 1u);
    return b;
}
__device__ __forceinline__ void xcd_barrier_complete(unsigned* bar, unsigned x, unsigned& nloc, unsigned& nx) {
    const unsigned G = gridDim.x * gridDim.y * gridDim.z;
    unsigned sum, cnt, mine, sp = 0u;
    for (;;) {
        sum = 0u; cnt = 0u; mine = 0u;
#pragma unroll
        for (unsigned j = 0; j < 16; ++j) { const unsigned c = xb_ld(&bar[XB_XCNT(j)]); sum += c; cnt += (c > 0u) ? 1u : 0u; mine = (j == x) ? c : mine; }
        if (sum == G) break;
        __builtin_amdgcn_s_sleep(1);
        if ((++sp & 255u) == 0u) { if (xb_ld(&bar[XB_TMO])) break; if (sp > XB_SPIN_CAP) { atomicAdd(&bar[XB_TMO], 1u); break; } }
    }
    nloc = mine > 0u ? mine : 1u; nx = cnt > 0u ? cnt : 1u;
}

__device__ __forceinline__ void xcd_barrier(const XcdBarrier& b) {
    asm volatile("s_waitcnt vmcnt(0)" ::: "memory");
    __syncthreads();
    if (threadIdx.x == 0) {
        unsigned* bar = b.bar; unsigned bx_ = b.x; asm volatile("" : "+s"(bar), "+s"(bx_));
        __builtin_amdgcn_s_waitcnt(0);
        unsigned nloc = b.st[0], nx = b.st[1];
        if (nloc == 0u) { xcd_barrier_complete(bar, bx_, nloc, nx); b.st[0] = nloc; b.st[1] = nx; }
        const unsigned old = xb_add(&bar[XB_XSUB(bx_)], 1u);
        const unsigned gen = old / nloc;
        if (old + 1u == (gen + 1u) * nloc) {
            __builtin_amdgcn_fence(__ATOMIC_RELEASE, "agent");
            asm volatile("s_waitcnt vmcnt(0)" ::: "memory");
            const unsigned og = xb_add(&bar[XB_TOP], 1u);
            const unsigned tg = og / nx;
            if (og + 1u == (tg + 1u) * nx) xb_add(&bar[XB_TOPGEN], 1u);
            else XB_SPIN(xb_ld(&bar[XB_TOPGEN]) == tg, bar);
            __builtin_amdgcn_fence(__ATOMIC_ACQUIRE, "agent");
            xb_add(&bar[XB_XGEN(bx_)], 1u);
            asm volatile("s_waitcnt vmcnt(0)" ::: "memory");
        } else {
            XB_SPIN(xb_ld(&bar[XB_XGEN(bx_)]) == gen, bar);
            __builtin_amdgcn_fence(__ATOMIC_ACQUIRE, "agent");
            asm volatile("s_waitcnt vmcnt(0)" ::: "memory");
        }
    }
    __syncthreads();
}

#define XB_LSUB(j)  (3456 + 64 * (j))
#define XB_LGEN(j)  (3456 + 1024 + 64 * (j))
#define XB_TICKET   (3456 + 2048)
__device__ __forceinline__ void xcd_local_barrier(const XcdBarrier& b) {
    asm volatile("s_waitcnt vmcnt(0)" ::: "memory");
    __syncthreads();
    if (threadIdx.x == 0) {
        unsigned* bar = b.bar; unsigned bx_ = b.x; asm volatile("" : "+s"(bar), "+s"(bx_));
        const unsigned nloc = b.st[0];
        const unsigned old = xb_add(&bar[XB_LSUB(bx_)], 1u);
        const unsigned gen = old / nloc;
        if (old + 1u == (gen + 1u) * nloc) xb_add(&bar[XB_LGEN(bx_)], 1u);
        else XB_SPIN(xb_ld(&bar[XB_LGEN(bx_)]) == gen, bar);
        __builtin_amdgcn_fence(__ATOMIC_ACQUIRE, "agent");
        asm volatile("s_waitcnt vmcnt(0)" ::: "memory");
    }
    __syncthreads();
}

#define XB_TEAM(x, c) (8192 + 512 * (x) + 64 * (c))
#define XB_HFREE(x)   (16384 + 64 * (x))
__device__ __forceinline__ void xcd_team_barrier(const XcdBarrier& b, unsigned team) {
    asm volatile("s_waitcnt vmcnt(0)" ::: "memory");
    __syncthreads();
    if (threadIdx.x == 0) {
        unsigned* bar = b.bar; unsigned bx_ = b.x; asm volatile("" : "+s"(bar), "+s"(bx_));
        unsigned* w = &bar[XB_TEAM(bx_, team)];
        const unsigned target = (xb_add(w, 1u) / 4u + 1u) * 4u;
        XB_SPIN(xb_ld(w) < target, bar);
        __builtin_amdgcn_fence(__ATOMIC_ACQUIRE, "agent");
        asm volatile("s_waitcnt vmcnt(0)" ::: "memory");
    }
    __syncthreads();
}
#define XB_P4DONE(x)  (17408 + 64 * (x))
__device__ __forceinline__ void xcd_cnt_arrive(const XcdBarrier& b, unsigned word0) {
    if (threadIdx.x == 0) { unsigned* bar = b.bar; unsigned bx_ = b.x; asm volatile("" : "+s"(bar), "+s"(bx_)); xb_add(&bar[word0 + 64u * bx_], 1u); }
}
__device__ __forceinline__ void xcd_cnt_wait(const XcdBarrier& b, unsigned word0, unsigned target) {
    if (threadIdx.x == 0) { unsigned* bar = b.bar; unsigned bx_ = b.x; asm volatile("" : "+s"(bar), "+s"(bx_)); XB_SPIN(xb_ld(&bar[word0 + 64u * bx_]) < target, bar); }
    __syncthreads();
}

__device__ __forceinline__ float wave_sum(float v) {
    v += __builtin_bit_cast(float, __builtin_amdgcn_ds_swizzle(__builtin_bit_cast(int, v), 0x041F));
    v += __builtin_bit_cast(float, __builtin_amdgcn_ds_swizzle(__builtin_bit_cast(int, v), 0x081F));
    v += __builtin_bit_cast(float, __builtin_amdgcn_ds_swizzle(__builtin_bit_cast(int, v), 0x101F));
    v += __builtin_bit_cast(float, __builtin_amdgcn_ds_swizzle(__builtin_bit_cast(int, v), 0x201F));
    return add_xor32(add_xor16(v));
}
__device__ __forceinline__ unsigned off_b(unsigned row, unsigned ch) { return 256u * row + 16u * (ch ^ (((row & 3u) << 2) | ((row >> 2) & 3u))); }
__device__ __forceinline__ unsigned tr_addr_nat(unsigned lane, unsigned c, unsigned ks, unsigned t) {
    const unsigned h = lane >> 5, blk = (lane >> 4) & 1u, q = (lane & 15u) >> 2, p = lane & 3u;
    return off_b(16u * ks + 8u * h + 4u * t + q, 4u * c + 2u * blk + (p >> 1)) + 8u * (p & 1u);
}
__device__ __forceinline__ unsigned tr_addr_perm(unsigned lane, unsigned c, unsigned ks, unsigned t) {
    const unsigned h = lane >> 5, blk = (lane >> 4) & 1u, q = (lane & 15u) >> 2, p = lane & 3u;
    return off_b(16u * ks + 8u * t + 4u * h + q, 4u * c + 2u * blk + (p >> 1)) + 8u * (p & 1u);
}
__device__ __forceinline__ unsigned tr_addr16(unsigned lane, unsigned c, unsigned ks, unsigned t) {
    const unsigned g = lane >> 4, q = (lane & 15u) >> 2, p = lane & 3u;
    return off_b(32u * ks + 8u * g + 4u * t + q, 2u * c + (p >> 1)) + 8u * (p & 1u);
}
__device__ __forceinline__ void glds16(const void* gsrc, unsigned lds_dst) { unsigned keep;
    asm volatile("s_mov_b32 %0, m0\n\ts_mov_b32 m0, %2\n\ts_nop 0\n\tglobal_load_lds_dwordx4 %1, off\n\ts_mov_b32 m0, %0" : "=&s"(keep) : "v"(gsrc), "s"(lds_dst) : "memory"); }
typedef short v4i16_t __attribute__((ext_vector_type(4)));
__device__ __forceinline__ s16x4 tr_read(LAS unsigned char* p) { return __builtin_bit_cast(s16x4, __builtin_amdgcn_ds_read_tr16_b64_v4i16((LAS v4i16_t*)p)); }
__device__ __forceinline__ bf16x8 cat4(s16x4 a, s16x4 b) { return (bf16x8){a[0], a[1], a[2], a[3], b[0], b[1], b[2], b[3]}; }
__device__ __forceinline__ unsigned cvtpk(float lo, float hi) { return pg8::cvt_pk_bf16(lo, hi); }
__device__ __forceinline__ int crow(int r, int hi) { return (r & 3) + 8 * (r >> 2) + 4 * hi; }
__device__ __forceinline__ bf16x8 pack_acc(const f32x16& a, int s) {
    v4u w; w.x = cvtpk(a[8 * s + 0], a[8 * s + 1]); w.y = cvtpk(a[8 * s + 2], a[8 * s + 3]); w.z = cvtpk(a[8 * s + 4], a[8 * s + 5]); w.w = cvtpk(a[8 * s + 6], a[8 * s + 7]);
    return __builtin_bit_cast(bf16x8, w);
}

__device__ __forceinline__ void tr_item(const float* W, int ldw, int srccol0, int k0, const float* gain, float scal, bf16* WT, int K, int dstrow0, LAS float* scr, int lane) {
    float r[32], gv[32];
    const float* wp = W + (size_t)(k0 + (lane >> 5)) * ldw + srccol0 + (lane & 31);
#pragma unroll
    for (int i = 0; i < 32; ++i) r[i] = __builtin_nontemporal_load(wp + (size_t)(2 * i) * ldw);
    if (gain) {
#pragma unroll
        for (int i = 0; i < 32; ++i) gv[i] = gain[k0 + 2 * i + (lane >> 5)] * scal;
    } else {
#pragma unroll
        for (int i = 0; i < 32; ++i) gv[i] = scal;
    }
#pragma unroll
    for (int i = 0; i < 32; ++i) scr[(2 * i + (lane >> 5)) * 33 + (lane & 31)] = r[i] * gv[i];
    LDS_WAIT(); asm volatile("" ::: "memory");
    const int c = lane & 7;
#pragma unroll
    for (int j = 0; j < 4; ++j) { const int n = (lane >> 3) + 8 * j; const LAS float* s = scr + (8 * c) * 33 + n;
        v4u o; o.x = pk2(s[0 * 33], s[1 * 33]); o.y = pk2(s[2 * 33], s[3 * 33]); o.z = pk2(s[4 * 33], s[5 * 33]); o.w = pk2(s[6 * 33], s[7 * 33]);
        *(GAS v4u*)(WT + (size_t)(dstrow0 + n) * K + k0 + 8 * c) = o; }
    LDS_WAIT(); asm volatile("" ::: "memory");
}

struct Args { const float* x; const float* p; const int* pos; const float* g_mix; const float* w_in; const float* pool_w; const float* pool_scale; const float* w_out; const float* g_ffn;
              const float* w_gate; const float* w_up; const float* w_down; const float* g_ple; const float* w_ple_gate; const float* w_ple_proj; const float* g_final; float* out; unsigned char* ws; };

template <int W> __device__ __forceinline__ void pool_rows(const bf16* uw, bf16* mix, int b, int s0, int c0) {
    constexpr int NR = W - 1 + 16;
    v2u xr[NR];
#pragma unroll
    for (int i = 0; i < NR; ++i) { const int s = s0 - (W - 1) + i;
        xr[i] = (s >= 0) ? *(const GAS v2u*)(uw + (size_t)(b * SEQ + s) * 512 + c0) : (v2u){0u, 0u}; }
    float sum[4];
#pragma unroll
    for (int j = 0; j < 4; ++j) sum[j] = 0.f;
#pragma unroll
    for (int i = 0; i < W - 1; ++i)
#pragma unroll
        for (int j = 0; j < 2; ++j) { sum[2 * j] += bf_lo(xr[i][j]); sum[2 * j + 1] += bf_hi(xr[i][j]); }
#pragma unroll
    for (int i = 0; i < 16; ++i) {
        const int s = s0 + i; const float inv = 1.0f / (float)((s + 1 < W) ? (s + 1) : W);
        float o[4];
#pragma unroll
        for (int j = 0; j < 2; ++j) { const float a = bf_lo(xr[W - 1 + i][j]), c = bf_hi(xr[W - 1 + i][j]);
            sum[2 * j] += a; sum[2 * j + 1] += c; o[2 * j] = sum[2 * j] * inv - a; o[2 * j + 1] = sum[2 * j + 1] * inv - c;
            sum[2 * j] -= bf_lo(xr[i][j]); sum[2 * j + 1] -= bf_hi(xr[i][j]); }
        *(GAS v2u*)(mix + (size_t)(b * SEQ + s) * 1024 + 512 + c0) = (v2u){pk2(o[0], o[1]), pk2(o[2], o[3])};
    }
}

__global__ void __launch_bounds__(NWAVES * 64, 2) fwd(Args a_in) {
    extern __shared__ __attribute__((aligned(16))) unsigned char lds_raw[];
    LAS unsigned char* lds = (LAS unsigned char*)lds_raw;
    volatile LAS unsigned* MISC = (volatile LAS unsigned*)(lds + MISC_OFF);
    const int tid = threadIdx.x, lane = tid & 63, wave = __builtin_amdgcn_readfirstlane(tid >> 6);
    const int G = gridDim.x, bx = blockIdx.x;
    const int gw = bx * NWAVES + wave, NGW = G * NWAVES;
    typedef const __attribute__((address_space(4))) Args CArgs;
#define PHASE_ENVB(bi_) CArgs* ap_ = (CArgs*)__builtin_amdgcn_kernarg_segment_ptr(); asm volatile("" : "+s"(ap_)); CArgs& a = *ap_; \
    unsigned char* const ws = a.ws; float* const ssqA = (float*)(ws + WS_SSQA) + (size_t)(bi_) * SEQ * 16; float* const ssqB = (float*)(ws + WS_SSQB) + (size_t)(bi_) * SEQ * 16; \
    bf16* const xb = (bf16*)(ws + WS_XB) + (size_t)(bi_) * SEQ * D; bf16* const xb1 = (bf16*)(ws + WS_XB1) + (size_t)(bi_) * SEQ * D; bf16* const pb = (bf16*)(ws + WS_PB) + (size_t)(bi_) * SEQ * PLE; \
    unsigned char* const R = ws + WS_R + (size_t)(bi_) * R_BATCH; \
    bf16* const qb = (bf16*)(R + R_Q); bf16* const kb = (bf16*)(R + R_K); bf16* const vb = (bf16*)(R + R_V); bf16* const gb = (bf16*)(R + R_G); bf16* const uwb = (bf16*)(R + R_UW); \
    bf16* const kvb = (bf16*)(R + R_KV); bf16* const mix = (bf16*)(R + R_MIX); bf16* const hmid = (bf16*)(R + R_H); bf16* const eb = (bf16*)(R + R_E); float* const utmp = (float*)(ws + WS_R + R_UT); \
    (void)ssqA; (void)ssqB; (void)xb; (void)xb1; (void)pb; (void)qb; (void)kb; (void)vb; (void)gb; (void)uwb; (void)kvb; (void)mix; (void)hmid; (void)eb; (void)utmp
#define PHASE_ENV() PHASE_ENVB(batch)
    gu32* ctl = (gu32*)(a_in.ws + WS_CTL);
    for (int u = tid; u < (LDS_BYTES - LDSCTL_OFF) / 4; u += NWAVES * 64) ((LAS unsigned*)(lds + LDSCTL_OFF))[u] = 0u;
    __syncthreads();
    XcdBarrier bar = xcd_barrier_post((unsigned*)(ctl + CW_BAR), MISC + 8);

#ifndef PHMASK
#define PHMASK 0xFFFF
#endif
#define PH(n) ((PHMASK >> (n)) & 1)
#define FRESH_TID(name) int name = threadIdx.x; asm volatile("" : "+v"(name))
    if (PH(0)) { PHASE_ENVB(0);
    for (int task = gw; task < DEPTH * 4 * 2 * 128; task += NGW) {
        const int kb8 = task & 127, dh = (task >> 7) & 1, g = (task >> 8) & 3, L = task >> 10;
        const int d = dh * 64 + lane;
        const float* pw = a.pool_w + (size_t)((L * 4 + g) * 128) * 128 + d;
        const float* wi = a.w_in + (size_t)(L * 1024 + kb8 * 8) * INW + 2048 + g * 128;
        float acc[8];
#pragma unroll
        for (int i = 0; i < 8; ++i) acc[i] = 0.f;
#pragma unroll 4
        for (int c = 0; c < 128; ++c) { const float bv = pw[(size_t)c * 128];
#pragma unroll
            for (int i = 0; i < 8; ++i) acc[i] += wi[(size_t)i * INW + c] * bv; }
        const float sc = a.pool_scale[L * 512 + g * 128 + d];
#pragma unroll
        for (int i = 0; i < 8; ++i) utmp[(size_t)(L * 1024 + kb8 * 8 + i) * 512 + g * 128 + d] = acc[i] * sc;
    }
    }
    xcd_barrier(bar);
#ifndef NO_TEAMS
#define NO_TEAMS 0
#endif
#ifndef FORCE_FALLBACK
#define FORCE_FALLBACK 0
#endif
    if (threadIdx.x == 0) {
        unsigned* barw = (unsigned*)(ctl + CW_BAR);
        const unsigned nloc_ = MISC[8], nx_ = MISC[9], rk_ = MISC[10], myx_ = xb_xcc_id();
        unsigned mode_ = 0u, batch_ = 0u, rank_ = 0u, gsz_ = 1u;
        if (nx_ == 8u && !FORCE_FALLBACK) { mode_ = 1u; for (unsigned j = 0; j < 16; ++j) if (j < myx_ && xb_ld(&barw[XB_XCNT(j)]) > 0u) ++batch_; rank_ = rk_; gsz_ = nloc_; }
        else { const unsigned t_ = xb_add(&barw[XB_TICKET], 1u); batch_ = t_ % 8u; rank_ = t_ / 8u; gsz_ = (unsigned)G / 8u + ((batch_ < (unsigned)G % 8u) ? 1u : 0u); }
        MISC[11] = mode_; MISC[12] = batch_; MISC[13] = rank_; MISC[14] = gsz_;
    }
    __syncthreads();
    const int lmode = __builtin_amdgcn_readfirstlane((int)MISC[11]), batch = __builtin_amdgcn_readfirstlane((int)MISC[12]), rank = __builtin_amdgcn_readfirstlane((int)MISC[13]), gsz = __builtin_amdgcn_readfirstlane((int)MISC[14]);
#define LBAR() do { if (lmode) xcd_local_barrier(bar); else xcd_barrier(bar); } while (0)
    const bool tmode = lmode && gsz == 32 && !NO_TEAMS;
#define TBAR() do { if (tmode) xcd_team_barrier(bar, (unsigned)rank & 7u); else LBAR(); } while (0)
#define RET_UNIT(i_) (tmode ? ((i_) < 4 ? (rank >> 3) * 32 + 2 * ((rank & 7) + 8 * ((i_) >> 1)) + ((i_) & 1) : -1) : (rank + (i_) * gsz < NH * NCH ? rank + (i_) * gsz : -1))
#define POOL_ITEM(i_) (tmode ? ((i_) < 1 ? 2 * ((rank & 7) + 8 * (rank >> 4)) + ((rank >> 3) & 1) : -1) : (rank + (i_) * gsz < NCH ? rank + (i_) * gsz : -1))

    if (PH(1)) { PHASE_ENVB(0);
        LAS float* scr = (LAS float*)(lds + wave * 16384);
        constexpr int I_IN = 16 * 80, I_OUT = 16 * 32, I_GU = 16 * 176, I_DN = 44 * 32, I_PG = 16 * 32, I_PP = 4 * 32, I_L = I_IN + I_OUT + I_GU + I_DN + I_PG + I_PP;
        for (int it = gw; it < DEPTH * I_L; it += NGW) {
            const int L = it / I_L; int r = it % I_L;
            unsigned char* wl = ws + WS_W + (size_t)L * W_LAYER;
            if (r < I_IN) { const int kbk = r / 80, nb = r % 80, n0 = 32 * nb, k0 = 64 * kbk; const float* gn = a.g_mix + L * 1024;
                if (n0 < 1024) { const int sec = n0 >> 9, w = n0 & 511, t = w >> 8, bj = (w >> 7) & 1, hh = (w >> 6) & 1, dd0 = w & 63;
                    tr_item(a.w_in + (size_t)L * 1024 * INW, INW, sec * 512 + (2 * t + hh) * 128 + bj * 64 + dd0, k0, gn, sec == 0 ? 0.08838834764831845f : 1.0f, (bf16*)(wl + WO_IN), 1024, n0, scr, lane); }
                else if (n0 < 2048) tr_item(a.w_in + (size_t)L * 1024 * INW, INW, n0, k0, gn, 1.0f, (bf16*)(wl + WO_IN), 1024, n0, scr, lane);
                else tr_item(utmp + (size_t)L * 1024 * 512, 512, n0 - 2048, k0, gn, 1.0f, (bf16*)(wl + WO_IN), 1024, n0, scr, lane);
                continue; } r -= I_IN;
            if (r < I_OUT) { const int kbk = r / 32, nb = r % 32; tr_item(a.w_out + (size_t)L * 1024 * 1024, 1024, 32 * nb, 64 * kbk, nullptr, 1.0f, (bf16*)(wl + WO_OUT), 1024, 32 * nb, scr, lane); continue; } r -= I_OUT;
            if (r < I_GU) { const int kbk = r / 176, nb = r % 176, n0 = 32 * nb, t = n0 >> 8, bj = (n0 >> 7) & 1, j0 = n0 & 127;
                tr_item((bj ? a.w_up : a.w_gate) + (size_t)L * 1024 * FF, FF, 128 * t + j0, 64 * kbk, a.g_ffn + L * 1024, 1.0f, (bf16*)(wl + WO_GU), 1024, n0, scr, lane); continue; } r -= I_GU;
            if (r < I_DN) { const int kbk = r / 32, nb = r % 32; tr_item(a.w_down + (size_t)L * FF * 1024, 1024, 32 * nb, 64 * kbk, nullptr, 1.0f, (bf16*)(wl + WO_DOWN), FF, 32 * nb, scr, lane); continue; } r -= I_DN;
            if (r < I_PG) { const int kbk = r / 32, nb = r % 32; tr_item(a.w_ple_gate + (size_t)L * 1024 * 1024, 1024, 32 * nb, 64 * kbk, a.g_ple + L * 1024, 1.0f, (bf16*)(wl + WO_PG), 1024, 32 * nb, scr, lane); continue; } r -= I_PG;
            { const int kbk = r / 32, nb = r % 32; tr_item(a.w_ple_proj + (size_t)L * PLE * 1024, 1024, 32 * nb, 64 * kbk, nullptr, 1.0f, (bf16*)(wl + WO_PP), PLE, 32 * nb, scr, lane); }
        }
        for (int m = 2 * gw; m < M; m += 2 * NGW) {
            const GAS f32x4* xr = (const GAS f32x4*)(a.x + (size_t)m * D) + lane; GAS v2u* o8 = (GAS v2u*)(xb1 + (size_t)m * D) + lane;
            f32x4 v[8];
#pragma unroll
            for (int j = 0; j < 8; ++j) v[j] = __builtin_nontemporal_load(xr + 64 * j);
            float ss0 = 0.f, ss1 = 0.f;
#pragma unroll
            for (int j = 0; j < 4; ++j) { ss0 += (v[j][0] * v[j][0] + v[j][1] * v[j][1]) + (v[j][2] * v[j][2] + v[j][3] * v[j][3]); o8[64 * j] = (v2u){pk2(v[j][0], v[j][1]), pk2(v[j][2], v[j][3])}; }
#pragma unroll
            for (int j = 4; j < 8; ++j) { ss1 += (v[j][0] * v[j][0] + v[j][1] * v[j][1]) + (v[j][2] * v[j][2] + v[j][3] * v[j][3]); o8[64 * j] = (v2u){pk2(v[j][0], v[j][1]), pk2(v[j][2], v[j][3])}; }
            ss0 = wave_sum(ss0); ss1 = wave_sum(ss1);
            if (lane < 32) ssqB[(size_t)m * 16 + lane] = (lane == 0) ? ss0 : (lane == 16) ? ss1 : 0.f;
        }
        for (size_t i = (size_t)bx * 512 + tid; i < (size_t)M * PLE / 8; i += (size_t)G * 512) {
            const f32x4 v0 = ((const GAS f32x4*)a.p)[2 * i], v1 = ((const GAS f32x4*)a.p)[2 * i + 1];
            ((GAS v4u*)pb)[i] = (v4u){pk2(v0[0], v0[1]), pk2(v0[2], v0[3]), pk2(v1[0], v1[1]), pk2(v1[2], v1[3])};
        }
    }
    xcd_barrier(bar);

    for (int L = 0; L < DEPTH; ++L) {
        if (tmode && L > 0) xcd_cnt_wait(bar, XB_HFREE(0), (unsigned)(gsz * L));

#ifndef REP_P1
#define REP_P1 1
#endif
#pragma unroll 1
        for (int rep_ = 0; rep_ < REP_P1; ++rep_) {
        if (PH(2)) {
            PHASE_ENV(); const unsigned char* wl = ws + WS_W + (size_t)L * W_LAYER; (void)wl; FRESH_TID(ptid); pg8::Gemm g{xb1, (const bf16*)(wl + WO_IN), SEQ, INW, D}; pg8::BatchOrder S; S.init(INW, gsz, rank);
            PG8_LAS float* side = (PG8_LAS float*)(lds + SIDE_OFF); const int npu = (S.nwg + gsz - 1) / gsz;     PG8_LAS float* posf = side + npu * 256; PG8_LAS float* rope = posf + npu * 256;
            pg8::fill_rstd(S, ssqB, side, a.pos + batch * SEQ, posf, ptid); if (ptid < 64) { rope[ptid] = ROPE_HI[ptid]; rope[64 + ptid] = ROPE_LO[ptid]; } __syncthreads();
            pg8::EpiInProj E{side, posf, rope, qb, kb, vb, gb, uwb};
            pg8::gemm_phase<pg8::EpiInProj, pg8::BatchOrder, true, true>(lds, g, S, E, ptid);
        }
        TBAR();


        }
#ifndef REP_RET
#define REP_RET 1
#endif
#pragma unroll 1
        for (int rep_ = 0; rep_ < REP_RET; ++rep_) {
        if (PH(3)) { PHASE_ENV();
            FRESH_TID(t_); const int tid = t_, lane = t_ & 63, wave = __builtin_amdgcn_readfirstlane(t_ >> 6); (void)tid; (void)lane; (void)wave;
            {
                const unsigned ldsb = (unsigned)__builtin_amdgcn_readfirstlane((int)(unsigned)(size_t)lds);
                unsigned soff[4];
#pragma unroll
                for (int p = 0; p < 4; ++p) { const unsigned row = 4u * (unsigned)(wave * 4 + p) + ((unsigned)lane >> 4), pc = (unsigned)lane & 15u; soff[p] = 256u * row + 16u * (pc ^ (((row & 3u) << 2) | ((row >> 2) & 3u))); }
#define P2_DMA(u_, buf_) do { const char* ks_ = (const char*)(kb + (size_t)(u_) * 16384); const char* vs_ = (const char*)(vb + (size_t)(u_) * 16384); \
                    _Pragma("unroll") for (int p_ = 0; p_ < 4; ++p_) { glds16(ks_ + soff[p_], ldsb + (unsigned)((buf_) * 65536 + (wave * 4 + p_) * 1024)); \
                        glds16(vs_ + soff[p_], ldsb + (unsigned)((buf_) * 65536 + 32768 + (wave * 4 + p_) * 1024)); } } while (0)
                int buf = 0;
                if (RET_UNIT(0) >= 0) P2_DMA(RET_UNIT(0), 0);
                asm volatile("s_waitcnt vmcnt(0)" ::: "memory");
                for (int ui = 0; RET_UNIT(ui) >= 0; ++ui, buf ^= 1) {
                    const int u = RET_UNIT(ui), un = RET_UNIT(ui + 1);
                    asm volatile("s_waitcnt vmcnt(4)" ::: "memory"); __builtin_amdgcn_s_barrier(); asm volatile("" ::: "memory");
                    if (un >= 0) P2_DMA(un, buf ^ 1);
                    LAS unsigned char* kl = lds + buf * 65536; LAS unsigned char* vl2 = kl + 32768;
                    const int dt = wave >> 1, et0 = (wave & 1) * 2;
                    f32x16 acc0, acc1;
#pragma unroll
                    for (int r = 0; r < 16; ++r) { acc0[r] = 0.f; acc1[r] = 0.f; }
#pragma unroll
                    for (int ks = 0; ks < 8; ++ks) {
                        const bf16x8 A = cat4(tr_read(kl + tr_addr_nat(lane, dt, ks, 0)), tr_read(kl + tr_addr_nat(lane, dt, ks, 1)));
                        const bf16x8 B0 = cat4(tr_read(vl2 + tr_addr_nat(lane, et0, ks, 0)), tr_read(vl2 + tr_addr_nat(lane, et0, ks, 1)));
                        const bf16x8 B1 = cat4(tr_read(vl2 + tr_addr_nat(lane, et0 + 1, ks, 0)), tr_read(vl2 + tr_addr_nat(lane, et0 + 1, ks, 1)));
                        acc0 = __builtin_amdgcn_mfma_f32_32x32x16_bf16(A, B0, acc0, 0, 0, 0);
                        acc1 = __builtin_amdgcn_mfma_f32_32x32x16_bf16(A, B1, acc1, 0, 0, 0);
                    }
                    bf16* kvt = kvb + (size_t)u * 16384;
#pragma unroll
                    for (int s = 0; s < 2; ++s) {
                        *(GAS bf16x8*)(kvt + ((dt * 4 + et0) * 2 + s) * 512 + lane * 8) = pack_acc(acc0, s);
                        *(GAS bf16x8*)(kvt + ((dt * 4 + et0 + 1) * 2 + s) * 512 + lane * 8) = pack_acc(acc1, s);
                    }
                }
                asm volatile("s_waitcnt vmcnt(0)" ::: "memory"); __syncthreads();
#undef P2_DMA
            }
        }
        LBAR();


        if (PH(4)) { PHASE_ENV(); FRESH_TID(t_); const int tid = t_, lane = t_ & 63, wave = __builtin_amdgcn_readfirstlane(t_ >> 6); (void)tid; (void)lane; (void)wave;
        for (int c = rank * 512 + tid; c < NH * 4096; c += gsz * 512) {
            const int bh = c >> 12; const float cd = __builtin_amdgcn_exp2f(128.0f * lg2gamma(bh & 3));
            GAS v2u* base = (GAS v2u*)(kvb + (size_t)bh * NCH * 16384) + (c & 4095);
            v2u t[NCH];
#pragma unroll
            for (int n = 0; n < NCH; ++n) t[n] = base[(size_t)n * 4096];
            float r0 = 0.f, r1 = 0.f, r2 = 0.f, r3 = 0.f;
#pragma unroll
            for (int n = 0; n < NCH; ++n) {
                const v2u in = t[n];
                base[(size_t)n * 4096] = (v2u){pk2(r0, r1), pk2(r2, r3)};
                r0 = cd * (r0 + bf_lo(in[0])); r1 = cd * (r1 + bf_hi(in[0])); r2 = cd * (r2 + bf_lo(in[1])); r3 = cd * (r3 + bf_hi(in[1]));
            }
        }
            for (int pi = 0; POOL_ITEM(pi) >= 0; ++pi) { const int it = POOL_ITEM(pi);
                const int b = it >> 5, n = it & 31, gi = wave & 3, half = wave >> 2;
#pragma unroll 1
                for (int ps = 0; ps < 2; ++ps) {
                    const int s0 = n * 128 + half * 64 + ps * 32 + (lane >> 5) * 16, c0 = gi * 128 + (lane & 31) * 4;
                    if (gi == 0) pool_rows<2>(uwb, mix, b, s0, c0); else if (gi == 1) pool_rows<4>(uwb, mix, b, s0, c0); else if (gi == 2) pool_rows<8>(uwb, mix, b, s0, c0); else pool_rows<16>(uwb, mix, b, s0, c0);
                }
            }
            if (L > 0) {
                const GAS f32x4* ps = (const GAS f32x4*)(a.p + ((size_t)L * M + (size_t)batch * SEQ) * PLE);
                for (size_t i = (size_t)rank * 512 + tid; i < (size_t)SEQ * PLE / 8; i += (size_t)gsz * 512) {
                    const f32x4 v0 = ps[2 * i], v1 = ps[2 * i + 1];
                    ((GAS v4u*)pb)[i] = (v4u){pk2(v0[0], v0[1]), pk2(v0[2], v0[3]), pk2(v1[0], v1[1]), pk2(v1[2], v1[3])};
                }
            }
        }
        LBAR();

        if (PH(5)) { PHASE_ENV(); FRESH_TID(t_); const int tid = t_, lane = t_ & 63, wave = __builtin_amdgcn_readfirstlane(t_ >> 6);
        LAS float* red = (LAS float*)(lds + SIDE_OFF);
        const unsigned ldsb = (unsigned)__builtin_amdgcn_readfirstlane((int)(unsigned)(size_t)lds);
        unsigned soff[4];
#pragma unroll
        for (int p = 0; p < 4; ++p) { const unsigned row = 4u * (unsigned)(wave * 4 + p) + ((unsigned)lane >> 4), pc = (unsigned)lane & 15u; soff[p] = 256u * row + 16u * (pc ^ (((row & 3u) << 2) | ((row >> 2) & 3u))); }
        const int qt = (wave < 4) ? wave : 7 - wave, eh = wave >> 2;
        v4u sfr[16];
#define P4_TILE(src_, u_, reg_) do { const char* s_ = (const char*)((src_) + (size_t)(u_) * 16384); \
            _Pragma("unroll") for (int p_ = 0; p_ < 4; ++p_) glds16(s_ + soff[p_], ldsb + (unsigned)((reg_) * 32768 + (wave * 4 + p_) * 1024)); } while (0)
#define P4_SF(u_) do { const bf16* st_ = kvb + (size_t)(u_) * 16384 + lane * 8; \
            _Pragma("unroll") for (int k_ = 0; k_ < 16; ++k_) { const int ei_ = k_ >> 3, dt_ = (k_ >> 1) & 3, s_ = k_ & 1; \
                asm volatile("global_load_dwordx4 %0, %1, off" : "=v"(sfr[k_]) : "v"(st_ + ((dt_ * 4 + 2 * eh + ei_) * 2 + s_) * 512) : "memory"); } } while (0)
#define P4_WAIT_SF(n_) asm volatile("s_waitcnt vmcnt(" #n_ ")" : "+v"(sfr[0]), "+v"(sfr[1]), "+v"(sfr[2]), "+v"(sfr[3]), "+v"(sfr[4]), "+v"(sfr[5]), "+v"(sfr[6]), "+v"(sfr[7]), \
            "+v"(sfr[8]), "+v"(sfr[9]), "+v"(sfr[10]), "+v"(sfr[11]), "+v"(sfr[12]), "+v"(sfr[13]), "+v"(sfr[14]), "+v"(sfr[15]) :: "memory")
#define P4_BAR() do { asm volatile("s_waitcnt lgkmcnt(0)" ::: "memory"); __builtin_amdgcn_s_barrier(); asm volatile("" ::: "memory"); } while (0)
        { const int u0 = (RET_UNIT(0) >= 0) ? RET_UNIT(0) : NH * NCH - 1;
          P4_TILE(kb, u0, 0); P4_TILE(qb, u0, 2); P4_SF(u0); P4_TILE(vb, u0, 1); }
        P4_WAIT_SF(0);
        for (int ui = 0; RET_UNIT(ui) >= 0; ++ui) {
            const int u = RET_UNIT(ui), un = RET_UNIT(ui + 1);
            const int bh = u >> 5, n = u & 31, h = bh & 3, b = bh >> 2;
            const bool has_next = (un >= 0);
            P4_WAIT_SF(4); P4_BAR();
            P4_TILE(gb, u, 3);
            int ln = lane; asm volatile("" : "+v"(ln)); const int ql = ln & 31, hh = ln >> 5;
            LAS unsigned char* kzl = lds; LAS unsigned char* vl = lds + 32768; LAS unsigned char* qlds = lds + 65536; LAS unsigned char* glds = lds + 98304;
            bf16x8 qf[4][2];
            { const unsigned qrow = 32u * qt + (unsigned)ql;
#pragma unroll
              for (int dt = 0; dt < 4; ++dt)
#pragma unroll
                for (int s = 0; s < 2; ++s) { const v2u lo = *(const LAS v2u*)(qlds + off_b(qrow, 4 * dt + 2 * s) + 8 * hh), hi = *(const LAS v2u*)(qlds + off_b(qrow, 4 * dt + 2 * s + 1) + 8 * hh);
                    qf[dt][s] = __builtin_bit_cast(bf16x8, (v4u){lo[0], lo[1], hi[0], hi[1]}); } }
            bf16x8 pf[4][2];
#pragma unroll
            for (int kt = 0; kt < 4; ++kt) {
                if (kt <= qt) {
                    f32x16 sa;
#pragma unroll
                    for (int r = 0; r < 16; ++r) sa[r] = 0.f;
                    const unsigned krow = 32 * kt + ql;
#pragma unroll
                    for (int dt = 0; dt < 4; ++dt)
#pragma unroll
                        for (int s = 0; s < 2; ++s) {
                            const v2u lo = *(const LAS v2u*)(kzl + off_b(krow, 4 * dt + 2 * s) + 8 * hh), hi = *(const LAS v2u*)(kzl + off_b(krow, 4 * dt + 2 * s + 1) + 8 * hh);
                            sa = __builtin_amdgcn_mfma_f32_32x32x16_bf16(__builtin_bit_cast(bf16x8, (v4u){lo[0], lo[1], hi[0], hi[1]}), qf[dt][s], sa, 0, 0, 0); }
                    if (kt == qt) {
#pragma unroll
                        for (int r = 0; r < 16; ++r) sa[r] = (crow(r, hh) > ql) ? 0.f : sa[r];
                    }
                    pf[kt][0] = pack_acc(sa, 0); pf[kt][1] = pack_acc(sa, 1);
                } else { pf[kt][0] = (bf16x8){0, 0, 0, 0, 0, 0, 0, 0}; pf[kt][1] = (bf16x8){0, 0, 0, 0, 0, 0, 0, 0}; }
            }
            P4_BAR();
            if (has_next) { P4_TILE(kb, un, 0); P4_TILE(qb, un, 2); }
            f32x16 oacc[2]; int ln2 = lane; asm volatile("" : "+v"(ln2));
#pragma unroll
            for (int ei = 0; ei < 2; ++ei) {
                f32x16 o;
#pragma unroll
                for (int r = 0; r < 16; ++r) o[r] = 0.f;
#pragma unroll
                for (int dt = 0; dt < 4; ++dt)
#pragma unroll
                    for (int s = 0; s < 2; ++s) o = __builtin_amdgcn_mfma_f32_32x32x16_bf16(__builtin_bit_cast(bf16x8, sfr[ei * 8 + dt * 2 + s]), qf[dt][s], o, 0, 0, 0);
                oacc[ei] = o;
            }
#pragma unroll
            for (int ei = 0; ei < 2; ++ei) {
                const int et = 2 * eh + ei; f32x16 o = oacc[ei];
#pragma unroll
                for (int kt = 0; kt < 4; ++kt) {
                    if (kt <= qt) {
#pragma unroll
                        for (int s = 0; s < 2; ++s) {
                            const bf16x8 vf = cat4(tr_read(vl + tr_addr_perm(ln2, et, 2 * kt + s, 0)), tr_read(vl + tr_addr_perm(ln2, et, 2 * kt + s, 1)));
                            o = __builtin_amdgcn_mfma_f32_32x32x16_bf16(vf, pf[kt][s], o, 0, 0, 0); }
                    }
                }
                oacc[ei] = o;
            }
            const float rsc = __builtin_amdgcn_exp2f((float)(32 * qt + ql - 127) * lg2gamma(h));
            float ss = 0.f;
#pragma unroll
            for (int ei = 0; ei < 2; ++ei)
#pragma unroll
                for (int r = 0; r < 16; ++r) { const float y = oacc[ei][r] * rsc; oacc[ei][r] = y; ss += y * y; }
            ss = add_xor32(ss);
            if (hh == 0) red[eh * 128 + 32 * qt + ql] = ss;
            if (has_next) asm volatile("s_waitcnt vmcnt(8)" ::: "memory"); else asm volatile("s_waitcnt vmcnt(0)" ::: "memory");
            P4_BAR();
            if (has_next) { P4_SF(un); P4_TILE(vb, un, 1); }
            int ln3 = lane; asm volatile("" : "+v"(ln3)); const int ql3 = ln3 & 31, hh3 = ln3 >> 5;
            const float rn = rsqrtf((red[32 * qt + ql3] + red[128 + 32 * qt + ql3]) * (1.0f / 128.0f) + EPS);
            { const unsigned yrow = 32u * qt + (unsigned)ql3;
#pragma unroll
              for (int ei = 0; ei < 2; ++ei)
#pragma unroll
                for (int rg = 0; rg < 4; ++rg) {
                    const unsigned e0 = 32u * (2 * eh + ei) + 8u * rg + 4u * hh3, ch = e0 >> 3, sub = (e0 & 7u) * 2u;
                    const v2u gv = *(const LAS v2u*)(glds + off_b(yrow, ch) + sub);
                    float o[4];
#pragma unroll
                    for (int j = 0; j < 4; ++j) { const float gt = (j & 1) ? bf_hi(gv[j >> 1]) : bf_lo(gv[j >> 1]);
                        o[j] = gt * __builtin_amdgcn_rcpf(1.0f + __builtin_amdgcn_exp2f(-1.4426950408889634f * gt)) * (oacc[ei][4 * rg + j] * rn); }
                    *(LAS v2u*)(glds + off_b(yrow, ch) + sub) = (v2u){pk2(o[0], o[1]), pk2(o[2], o[3])};
                } }
            P4_BAR();
            { bf16* orow = mix + ((size_t)b * SEQ + n * 128) * 1024 + h * 128;
              int t4 = tid; asm volatile("" : "+v"(t4));
#pragma unroll
              for (int i = 0; i < 4; ++i) { const unsigned c = t4 + 512 * i, row = c >> 4, ch = c & 15; *(GAS v4u*)(orow + (size_t)row * 1024 + ch * 8) = *(const LAS v4u*)(glds + off_b(row, ch)); } }
        }
        asm volatile("s_waitcnt vmcnt(0)" ::: "memory"); __syncthreads();
#undef P4_TILE
#undef P4_SF
#undef P4_WAIT_SF
#undef P4_BAR
        }
        TBAR(); if (tmode) xcd_cnt_arrive(bar, XB_P4DONE(0));

        }
        if (PH(6)) {
            PHASE_ENV(); const unsigned char* wl = ws + WS_W + (size_t)L * W_LAYER; (void)wl; FRESH_TID(ptid); pg8::Gemm g{mix, (const bf16*)(wl + WO_OUT), SEQ, D, D}; pg8::BatchOrder S; S.init(D, gsz, rank);
            pg8::EpiResid E{xb1, xb, ssqA};
            pg8::gemm_phase<pg8::EpiResid, pg8::BatchOrder, true, true>(lds, g, S, E, ptid);
        }
        TBAR();


#ifndef REP_P6
#define REP_P6 1
#endif
#pragma unroll 1
        for (int rep_ = 0; rep_ < REP_P6; ++rep_) {
        if (tmode) xcd_cnt_wait(bar, XB_P4DONE(0), (unsigned)(gsz * (L + 1)));
        if (PH(7)) {
            PHASE_ENV(); const unsigned char* wl = ws + WS_W + (size_t)L * W_LAYER; (void)wl; FRESH_TID(ptid); pg8::Gemm g{xb, (const bf16*)(wl + WO_GU), SEQ, 2 * FF, D}; pg8::BatchOrder S; S.init(2 * FF, gsz, rank);
            PG8_LAS float* side = (PG8_LAS float*)(lds + SIDE_OFF); pg8::fill_rstd(S, ssqA, side, (const int*)nullptr, (PG8_LAS float*)nullptr, ptid); __syncthreads();
            pg8::EpiSwiGLU E{side, hmid};
            pg8::gemm_phase<pg8::EpiSwiGLU, pg8::BatchOrder, true, true>(lds, g, S, E, ptid);
        }
        TBAR();

        }
        if (PH(8)) {
            PHASE_ENV(); const unsigned char* wl = ws + WS_W + (size_t)L * W_LAYER; (void)wl; FRESH_TID(ptid); pg8::Gemm g{hmid, (const bf16*)(wl + WO_DOWN), SEQ, D, FF}; pg8::BatchOrder S; S.init(D, gsz, rank);
            pg8::EpiResid E{xb, xb, ssqA};
            pg8::gemm_phase<pg8::EpiResid, pg8::BatchOrder, true, true>(lds, g, S, E, ptid);
        }
#ifndef REP_PE
#define REP_PE 1
#endif
#pragma unroll 1
        for (int rep_ = 0; rep_ < REP_PE; ++rep_)
        if (PH(9)) {
            PHASE_ENV(); const unsigned char* wl = ws + WS_W + (size_t)L * W_LAYER; (void)wl; FRESH_TID(ptid); pg8::Gemm g{pb, (const bf16*)(wl + WO_PP), SEQ, D, PLE}; pg8::BatchOrder S; S.init(D, gsz, rank);
            pg8::EpiPlain E{eb, D};
            pg8::gemm_phase<pg8::EpiPlain, pg8::BatchOrder, true, true>(lds, g, S, E, ptid);
        }
        TBAR(); if (tmode) xcd_cnt_arrive(bar, XB_HFREE(0));

        if (PH(10)) {
            PHASE_ENV(); const unsigned char* wl = ws + WS_W + (size_t)L * W_LAYER; (void)wl; FRESH_TID(ptid); pg8::Gemm g{xb, (const bf16*)(wl + WO_PG), SEQ, D, D}; pg8::BatchOrder S; S.init(D, gsz, rank);
            PG8_LAS float* side = (PG8_LAS float*)(lds + SIDE_OFF); pg8::fill_rstd(S, ssqA, side, (const int*)nullptr, (PG8_LAS float*)nullptr, ptid); __syncthreads();
            pg8::EpiPle E{side, eb, xb, xb1, ssqB};
            pg8::gemm_phase<pg8::EpiPle, pg8::BatchOrder, true, true>(lds, g, S, E, ptid);
        }
        TBAR();
    }

    if (tmode) LBAR();
    if (PH(11)) { PHASE_ENV(); FRESH_TID(t_); const int lane = t_ & 63, gw = rank * NWAVES + __builtin_amdgcn_readfirstlane(t_ >> 6);
        const unsigned tmo = __hip_atomic_load((unsigned*)(ws + WS_CTL) + CW_BAR + XB_TMO, RLX_AGENT);
        for (int m = gw; m < SEQ; m += gsz * NWAVES) {
            float s = (lane < 16) ? ssqB[(size_t)m * 16 + lane] : 0.f; s = wave_sum(s);
            float rs = rsqrtf(s * (1.0f / 1024.0f) + EPS); if (tmo) rs = __builtin_nanf("");
#pragma unroll
            for (int j = 0; j < 2; ++j) { const v4u w = ((const GAS v4u*)(xb1 + (size_t)m * D))[lane + 64 * j]; const GAS f32x4* gp = (const GAS f32x4*)(a.g_final + (lane + 64 * j) * 8);
                f32x4 v0, v1; pg8::unpack8(w, v0, v1); GAS f32x4* op = (GAS f32x4*)(a.out + ((size_t)batch * SEQ + m) * D + (lane + 64 * j) * 8);
                op[0] = v0 * rs * gp[0]; op[1] = v1 * rs * gp[1]; }
        }
    }
}

extern "C" void kernel_launch(void* const* d_in, const int* in_sizes, int n_in, void* d_out, int out_size, void* d_ws, size_t ws_size, hipStream_t stream) {
    static int grid = 0;
    if (grid == 0) {
        if (n_in != 16 || in_sizes[0] != M * D || out_size != M * D || ws_size < WS_END) { fprintf(stderr, "kernel_launch: unexpected shapes (n_in %d, in0 %d, out %d, ws %zu < %zu)\n", n_in, n_in > 0 ? in_sizes[0] : -1, out_size, ws_size, (size_t)WS_END); grid = -1; return; }
        int dev = 0, cus = 0, per_cu = 0;
        if (hipGetDevice(&dev) != hipSuccess || hipDeviceGetAttribute(&cus, hipDeviceAttributeMultiprocessorCount, dev) != hipSuccess) { grid = -1; return; }
        if (hipFuncSetAttribute((const void*)fwd, hipFuncAttributeMaxDynamicSharedMemorySize, LDS_BYTES) != hipSuccess) { fprintf(stderr, "kernel_launch: hipFuncSetAttribute failed\n"); grid = -1; return; }
        if (hipOccupancyMaxActiveBlocksPerMultiprocessor(&per_cu, (const void*)fwd, NWAVES * 64, LDS_BYTES) != hipSuccess || per_cu < 1) fprintf(stderr, "kernel_launch: occupancy query reports %d\n", per_cu);
        (void)hipGetLastError();
        grid = cus;
    }
    if (grid < 0) return;
    if (hipMemsetAsync((char*)d_ws + WS_CTL, 0, CTL_ZERO_BYTES, stream) != hipSuccess) return;
    Args a{};
    a.x = (const float*)d_in[0]; a.p = (const float*)d_in[1]; a.pos = (const int*)d_in[2]; a.g_mix = (const float*)d_in[3]; a.w_in = (const float*)d_in[4]; a.pool_w = (const float*)d_in[5];
    a.pool_scale = (const float*)d_in[6]; a.w_out = (const float*)d_in[7]; a.g_ffn = (const float*)d_in[8]; a.w_gate = (const float*)d_in[9]; a.w_up = (const float*)d_in[10]; a.w_down = (const float*)d_in[11];
    a.g_ple = (const float*)d_in[12]; a.w_ple_gate = (const float*)d_in[13]; a.w_ple_proj = (const float*)d_in[14]; a.g_final = (const float*)d_in[15]; a.out = (float*)d_out; a.ws = (unsigned char*)d_ws;
    hipLaunchKernelGGL(fwd, dim3(grid), dim3(NWAVES * 64), LDS_BYTES, stream, a);
}
```

```cpp
#include <hip/hip_runtime.h>
#include <cstdio>
#include <cstdint>
namespace pg8 {
#define PG8_LAS __attribute__((address_space(3)))
typedef unsigned short bf16_t;
typedef short bf16x8 __attribute__((ext_vector_type(8)));
typedef float f32x4 __attribute__((ext_vector_type(4)));
typedef unsigned u32x4 __attribute__((ext_vector_type(4)));
constexpr int BM = 256, BK = 64, HALF = 128, HTB = HALF * BK * 2  , STAGE_BYTES = 8 * HTB, NXCD = 8, WGM = 8;

__host__ __device__ __forceinline__ int lds_byte(int r, int c) { const int st = (r >> 4) * 2 + (c >> 5), rr = r & 15, cc = c & 31, ob = rr * 64 + cc * 2; return st * 1024 + (ob ^ (((ob >> 9) & 1) << 5)); }
__host__ __device__ __forceinline__ void stage_rc(int b, int& R, int& C) { const int st = b / 1024, sb = b % 1024, swz = sb ^ (((sb >> 9) & 1) << 5); R = (st >> 1) * 16 + swz / 64; C = (st & 1) * 32 + (swz % 64) / 2; }
__host__ __device__ __forceinline__ int perm32(int rho) { const int n = rho >> 4, i = rho & 15; return 8 * (i >> 2) + 4 * n + (i & 3); }

struct Unit { int pm, pn; };
struct Gemm { const bf16_t* A; const bf16_t* Bt; int M, N, K; };

struct StaticOrder {
    int nM, nN, nwg, G, c;
    __host__ __device__ void init(int M, int N, int G_, int c_) { nM = M / BM; nN = N / BM; nwg = nM * nN; G = G_; c = c_; }
    __host__ __device__ bool next(int i, Unit& u) const {
        const long L = (long)i * G + c; if (L >= nwg) return false;
        int wgid = (int)L; { const int q = nwg / NXCD, r = nwg % NXCD, xcd = wgid % NXCD, off = wgid / NXCD; wgid = (xcd < r ? xcd * (q + 1) : r * (q + 1) + (xcd - r) * q) + off; }
        const int nig = WGM * nN, gid = wgid / nig, fm = gid * WGM, gsz = (nM - fm) < WGM ? (nM - fm) : WGM;
        u.pm = fm + ((wgid % nig) % gsz); u.pn = (wgid % nig) / gsz; return true;
    }
    __device__ __forceinline__ void a_ready(const Unit&) const {}
    __device__ __forceinline__ void done(const Unit&) const {}
};

typedef float f32x2_t __attribute__((ext_vector_type(2))); typedef __bf16 bf16x2_t __attribute__((ext_vector_type(2)));
__device__ __forceinline__ unsigned cvt_pk_bf16(float lo, float hi) { f32x2_t v = {lo, hi}; bf16x2_t b = __builtin_convertvector(v, bf16x2_t); return __builtin_bit_cast(unsigned, b); }
template <class Epi, class Sched, bool ALIGN_EPI = false, bool SP2 = false>
__device__ __forceinline__ void gemm_phase(PG8_LAS unsigned char* lds, const Gemm g, const Sched& S, const Epi& E, const int tid_in) {
    const int tid = tid_in, wid = __builtin_amdgcn_readfirstlane(tid >> 6), lane = tid & 63, wr = wid >> 2, wc = wid & 3, fr = lane & 15, fq = lane >> 4;
    const int K = g.K, nt = K / BK;
    unsigned voffA[2], voffB[2];
#pragma unroll
    for (int i = 0; i < 2; ++i) { int R, C; stage_rc(tid * 16 + i * 8192, R, C); const int Rb = Epi::PERM ? ((R & ~31) + perm32(R & 31)) : R;
        voffA[i] = (unsigned)(R * K + C) * 2u; voffB[i] = (unsigned)(Rb * K + C) * 2u; }
    const size_t kstep = (size_t)(BK * 2);
    const size_t hstep = (size_t)HALF * K * 2;
    const size_t tstep = 2 * hstep;
    const unsigned ldsw = (unsigned)wid * 1024u;
    const int aoff = lds_byte(wr * 64 + fr, fq * 8), boff = lds_byte(wc * 32 + fr, fq * 8);
#define PG8_SA(b, h) (((b) * 2 + (h)) * HTB)
#define PG8_SB(b, h) ((4 + (b) * 2 + (h)) * HTB)
#define PG8_STAGE(bufoff, gbase, voff) do { _Pragma("unroll") for (int _i = 0; _i < 2; ++_i) \
        __builtin_amdgcn_global_load_lds((const unsigned*)((const char*)(gbase) + (voff)[_i]), (PG8_LAS unsigned*)(lds + (bufoff) + ldsw + _i * 8192), 16, 0, 0); } while (0)
#define PG8_LDA(dst, b, h) do { _Pragma("unroll") for (int m = 0; m < 4; ++m) _Pragma("unroll") for (int k = 0; k < 2; ++k) dst[m][k] = *(const PG8_LAS bf16x8*)(lds + PG8_SA(b, h) + aoff + m * 2048 + k * 1024); } while (0)
#define PG8_LDB(dst, b, h) do { _Pragma("unroll") for (int n = 0; n < 2; ++n) _Pragma("unroll") for (int k = 0; k < 2; ++k) dst[n][k] = *(const PG8_LAS bf16x8*)(lds + PG8_SB(b, h) + boff + n * 2048 + k * 1024); } while (0)
#define PG8_MMA(ai, bj, At, Bt) do { __builtin_amdgcn_s_setprio(1); _Pragma("unroll") for (int m = 0; m < 4; ++m) _Pragma("unroll") for (int n = 0; n < 2; ++n) _Pragma("unroll") for (int k = 0; k < 2; ++k) \
        acc[ai][bj][m][n] = __builtin_amdgcn_mfma_f32_16x16x32_bf16(Bt[n][k], At[m][k], acc[ai][bj][m][n], 0, 0, 0); __builtin_amdgcn_s_setprio(0); } while (0)
#define PG8_WAIT_V(n) asm volatile("s_waitcnt vmcnt(" #n ")" ::: "memory")
#define PG8_WAIT_L(n) asm volatile("s_waitcnt lgkmcnt(" #n ")" ::: "memory")
#define PG8_BAR __builtin_amdgcn_s_barrier()
#define PG8_SCHED __builtin_amdgcn_sched_barrier(0)
    Unit cur, nxt; int ui = 0;
    if (!S.next(0, cur)) return;
    f32x4 acc[2][2][4][2];
    E.init(acc, cur, wr, wc, fr, fq);
    bf16x8 At[4][2], B0[2][2], B1[2][2];
    const char* cA = (const char*)g.A + (size_t)cur.pm * tstep; const char* cB = (const char*)g.Bt + (size_t)cur.pn * tstep;
    S.a_ready(cur);
    if constexpr (SP2) {
        PG8_STAGE(PG8_SB(0, 0), cB, voffB); PG8_STAGE(PG8_SB(0, 1), cB + hstep, voffB); PG8_STAGE(PG8_SA(0, 0), cA, voffA); PG8_STAGE(PG8_SA(0, 1), cA + hstep, voffA);
        if (wr == 1) PG8_BAR;
        PG8_WAIT_V(2); PG8_BAR;
        PG8_STAGE(PG8_SB(1, 0), cB + kstep, voffB); PG8_STAGE(PG8_SA(1, 0), cA + kstep, voffA); PG8_STAGE(PG8_SB(1, 1), cB + hstep + kstep, voffB);
        PG8_WAIT_V(6); PG8_BAR;
    } else {
        PG8_STAGE(PG8_SB(0, 0), cB, voffB); PG8_STAGE(PG8_SA(0, 0), cA, voffA); PG8_STAGE(PG8_SB(0, 1), cB + hstep, voffB); PG8_STAGE(PG8_SA(0, 1), cA + hstep, voffA);
        if (wr == 1) PG8_BAR;
        PG8_WAIT_V(4); PG8_BAR;
        PG8_STAGE(PG8_SB(1, 0), cB + kstep, voffB); PG8_STAGE(PG8_SA(1, 0), cA + kstep, voffA); PG8_STAGE(PG8_SB(1, 1), cB + hstep + kstep, voffB);
        PG8_WAIT_V(6); PG8_BAR;
    }
    for (;;) {
        const bool has_next = S.next(ui + 1, nxt);
        const char* nA = has_next ? (const char*)g.A + (size_t)nxt.pm * tstep : cA; const char* nB = has_next ? (const char*)g.Bt + (size_t)nxt.pn * tstep : cB;
#pragma unroll 1
        for (int t = 0; t < nt; t += 2) {
            const bool last = (t == nt - 2);
            const char* a1 = cA + (size_t)(t + 1) * kstep;
            const char* a2 = last ? nA : cA + (size_t)(t + 2) * kstep; const char* b2 = last ? nB : cB + (size_t)(t + 2) * kstep;
            const char* a3 = a2 + kstep; const char* b3 = b2 + kstep;
            if (last && has_next) S.a_ready(nxt);
            if constexpr (SP2) {
            PG8_LDB(B0, 0, 0); PG8_LDB(B1, 0, 1); PG8_SCHED; PG8_LDA(At, 0, 0); PG8_STAGE(PG8_SA(1, 1), a1 + hstep, voffA);
            PG8_WAIT_V(8); PG8_WAIT_L(0); PG8_BAR; PG8_MMA(0, 0, At, B0); PG8_MMA(0, 1, At, B1); PG8_BAR; PG8_SCHED;
            PG8_LDA(At, 0, 1); PG8_STAGE(PG8_SB(0, 0), b2, voffB); PG8_STAGE(PG8_SB(0, 1), b2 + hstep, voffB); PG8_STAGE(PG8_SA(0, 0), a2, voffA);
            PG8_WAIT_V(8); PG8_WAIT_L(0); PG8_BAR; PG8_MMA(1, 0, At, B0); PG8_MMA(1, 1, At, B1); PG8_BAR; PG8_SCHED;
            PG8_LDB(B0, 1, 0); PG8_LDB(B1, 1, 1); PG8_SCHED; PG8_LDA(At, 1, 0); PG8_STAGE(PG8_SA(0, 1), a2 + hstep, voffA);
            PG8_WAIT_V(8); PG8_WAIT_L(0); PG8_BAR; PG8_MMA(0, 0, At, B0); PG8_MMA(0, 1, At, B1); PG8_BAR; PG8_SCHED;
            PG8_LDA(At, 1, 1); PG8_STAGE(PG8_SB(1, 0), b3, voffB); PG8_STAGE(PG8_SB(1, 1), b3 + hstep, voffB); PG8_STAGE(PG8_SA(1, 0), a3, voffA);
            PG8_WAIT_V(8); PG8_WAIT_L(0); PG8_BAR; PG8_MMA(1, 0, At, B0); PG8_MMA(1, 1, At, B1); PG8_BAR; PG8_SCHED;
            } else {
            PG8_LDB(B0, 0, 0); PG8_SCHED; PG8_LDA(At, 0, 0); PG8_STAGE(PG8_SA(1, 1), a1 + hstep, voffA);
            PG8_WAIT_L(8); PG8_BAR; PG8_WAIT_L(0); PG8_MMA(0, 0, At, B0); PG8_BAR; PG8_SCHED;
            PG8_LDB(B1, 0, 1); PG8_STAGE(PG8_SB(0, 0), b2, voffB);
            PG8_BAR; PG8_WAIT_L(0); PG8_MMA(0, 1, At, B1); PG8_BAR;
            PG8_LDA(At, 0, 1); PG8_STAGE(PG8_SA(0, 0), a2, voffA);
            PG8_BAR; PG8_WAIT_L(0); PG8_MMA(1, 0, At, B0); PG8_BAR; PG8_SCHED;
            PG8_STAGE(PG8_SB(0, 1), b2 + hstep, voffB);
            PG8_WAIT_V(6); PG8_BAR; PG8_MMA(1, 1, At, B1); PG8_BAR;
            PG8_LDB(B0, 1, 0); PG8_SCHED; PG8_LDA(At, 1, 0); PG8_STAGE(PG8_SA(0, 1), a2 + hstep, voffA);
            PG8_WAIT_L(8); PG8_BAR; PG8_WAIT_L(0); PG8_MMA(0, 0, At, B0); PG8_BAR; PG8_SCHED;
            PG8_LDB(B1, 1, 1); PG8_STAGE(PG8_SB(1, 0), b3, voffB);
            PG8_BAR; PG8_WAIT_L(0); PG8_MMA(0, 1, At, B1); PG8_BAR;
            PG8_LDA(At, 1, 1); PG8_STAGE(PG8_SA(1, 0), a3, voffA);
            PG8_BAR; PG8_WAIT_L(0); PG8_MMA(1, 0, At, B0); PG8_BAR; PG8_SCHED;
            PG8_STAGE(PG8_SB(1, 1), b3 + hstep, voffB);
            PG8_WAIT_V(6); PG8_BAR; PG8_MMA(1, 1, At, B1); PG8_BAR;
            }
        }
        if constexpr (ALIGN_EPI) { if (wr == 0) PG8_BAR; }
        if constexpr (!Epi::AFTER_DRAIN) { E(acc, cur, wr, wc, fr, fq, ui); S.done(cur); }
        if (!has_next) break;
        E.init(acc, nxt, wr, wc, fr, fq);
        cur = nxt; cA = nA; cB = nB; ++ui;
        if constexpr (ALIGN_EPI) { if (wr == 1) PG8_BAR; }
    }
    PG8_WAIT_V(0);
    if constexpr (!ALIGN_EPI) { if (wr == 0) PG8_BAR; }
    PG8_BAR;
    if constexpr (Epi::AFTER_DRAIN) { E.fused(acc, cur, wr, wc, fr, fq, lds, wid, lane); S.done(cur); }
#undef PG8_SA
#undef PG8_SB
#undef PG8_STAGE
#undef PG8_LDA
#undef PG8_LDB
#undef PG8_MMA
#undef PG8_WAIT_V
#undef PG8_WAIT_L
#undef PG8_BAR
#undef PG8_SCHED
}
}

constexpr int BATCH = 8, SEQ = 4096, D = 1024, DEPTH = 4, M = BATCH * SEQ;
constexpr int NH = 4, DH = 128, RW = 512, CHUNK = 128, NCH = SEQ / CHUNK;
constexpr int INW = 2560, FF = 2816, PLE = 256;
constexpr float EPS = 1e-6f;
constexpr int NWAVES = 8;

constexpr size_t MiB = 1u << 20;
constexpr size_t WS_CTL = 0, CTL_ZERO_BYTES = 1 * MiB;
constexpr size_t WS_SSQA = 1 * MiB, WS_SSQB = 3 * MiB;
constexpr size_t WS_W = 8 * MiB, W_LAYER = 26 * MiB;
constexpr size_t WO_IN = 0, WO_OUT = 5 * MiB, WO_GU = 7 * MiB, WO_DOWN = 18 * MiB, WO_PG = 18 * MiB + 5632 * 1024, WO_PP = WO_PG + 2 * MiB;
static_assert(WO_PP + 512 * 1024 == W_LAYER, "weight map");
constexpr size_t WS_XB = 112 * MiB;
constexpr size_t WS_PB = 176 * MiB;
constexpr size_t WS_R = 192 * MiB;
constexpr size_t R_BATCH = 32 * MiB;
constexpr size_t R_Q = 0, R_K = 4 * MiB, R_V = 8 * MiB, R_G = 12 * MiB, R_UW = 16 * MiB, R_KV = 20 * MiB, R_MIX = 24 * MiB;
constexpr size_t R_H = 0, R_E = 24 * MiB, R_UT = 0;
constexpr size_t WS_XB1 = WS_R + 256 * MiB;
constexpr size_t WS_END = WS_XB1 + 64 * MiB;
static_assert((size_t)SEQ * FF * 2 <= R_MIX && R_MIX + (size_t)SEQ * D * 2 == R_BATCH, "per-batch scratch map");
constexpr int CW_BAR = 4096;

constexpr int RING_BYTES = 131072;
constexpr int LDSCTL_OFF = RING_BYTES, MISC_OFF = LDSCTL_OFF + 320;
constexpr int SIDE_OFF = LDSCTL_OFF + 1024;
constexpr int LDS_BYTES = 147456;

#define GAS __attribute__((address_space(1)))
#define LAS __attribute__((address_space(3)))
typedef unsigned short bf16;
typedef unsigned v4u __attribute__((ext_vector_type(4)));
typedef unsigned v2u __attribute__((ext_vector_type(2)));
typedef float f32x4 __attribute__((ext_vector_type(4)));
typedef float f32x16 __attribute__((ext_vector_type(16)));
typedef short bf16x8 __attribute__((ext_vector_type(8)));
typedef short s16x4 __attribute__((ext_vector_type(4)));
typedef GAS unsigned gu32;
#define RLX_AGENT __ATOMIC_RELAXED, __HIP_MEMORY_SCOPE_AGENT
#define LDS_WAIT() asm volatile("s_waitcnt lgkmcnt(0)" ::: "memory")
#define VM_WAIT() asm volatile("s_waitcnt vmcnt(0)" ::: "memory")
__device__ __forceinline__ unsigned f2bf(float f) { unsigned u = __builtin_bit_cast(unsigned, f); return (u + 0x7fffu + ((u >> 16) & 1u)) >> 16; }
__device__ __forceinline__ unsigned pk2(float lo, float hi) { return f2bf(lo) | (f2bf(hi) << 16); }
__device__ __forceinline__ float bf_lo(unsigned w) { return __builtin_bit_cast(float, w << 16); }
__device__ __forceinline__ float bf_hi(unsigned w) { return __builtin_bit_cast(float, w & 0xffff0000u); }

__device__ const float ROPE_HI[64] = {1.591186523e-01f, 1.378173828e-01f, 1.193237305e-01f, 1.033325195e-01f, 8.947753906e-02f, 7.748413086e-02f, 6.710815430e-02f, 5.810546875e-02f, 5.032348633e-02f, 4.357910156e-02f, 3.773498535e-02f, 3.266906738e-02f, 2.829742432e-02f, 2.450561523e-02f, 2.121734619e-02f, 1.837158203e-02f, 1.591491699e-02f, 1.377868652e-02f, 1.193237305e-02f, 1.033401489e-02f, 8.949279785e-03f, 7.749557495e-03f, 6.710052490e-03f, 5.811691284e-03f, 5.031585693e-03f, 4.358291626e-03f, 3.773689270e-03f, 3.268241882e-03f, 2.829551697e-03f, 2.449989319e-03f, 2.121925354e-03f, 1.837730408e-03f, 1.591205597e-03f, 1.378059387e-03f, 1.193046570e-03f, 1.033306122e-03f, 8.947849274e-04f, 7.748603821e-04f, 6.711483002e-04f, 5.810260773e-04f, 5.030632019e-04f, 4.358291626e-04f, 3.772974014e-04f, 3.267526627e-04f, 2.830028534e-04f, 2.449750900e-04f, 2.121925354e-04f, 1.837611198e-04f, 1.591444016e-04f, 1.378059387e-04f, 1.193284988e-04f, 1.033246517e-04f, 8.949637413e-05f, 7.748603821e-05f, 6.711483002e-05f, 5.811452866e-05f, 5.032122135e-05f, 4.357099533e-05f, 3.772974014e-05f, 3.267824650e-05f, 2.829730511e-05f, 2.450495958e-05f, 2.121925354e-05f, 1.837313175e-05f};
__device__ const float ROPE_LO[64] = {3.629074854e-05f, 5.119791695e-06f, 2.563974340e-05f, 1.977708780e-05f, 2.186254642e-05f, 1.915789653e-05f, 6.928708444e-06f, 1.379869173e-05f, 5.725776191e-06f, 4.200542662e-06f, 6.599365861e-06f, 1.379848982e-05f, 4.771514341e-06f, 3.076627763e-06f, 6.306573596e-06f, 7.344074220e-06f, 5.773169960e-07f, 3.563736982e-06f, 2.563974249e-06f, 1.214769213e-06f, 6.603757470e-07f, 7.713804280e-07f, 1.455810320e-06f, 2.354600070e-07f, 1.335517140e-06f, 3.858455244e-08f, 4.692017228e-07f, 4.470491177e-08f, 6.678862974e-07f, 8.798673434e-07f, 4.399224736e-07f, 1.622028520e-07f, 3.438339888e-07f, 1.656388378e-07f, 4.471322939e-07f, 2.168443558e-07f, 2.090887250e-07f, 1.725054801e-07f, 2.529881415e-09f, 1.665971467e-07f, 2.289191343e-07f, 3.858455333e-09f, 1.184457474e-07f, 7.599606278e-08f, 1.910491321e-08f, 1.118285908e-07f, 4.399224807e-08f, 2.814121380e-08f, 1.054154186e-08f, 1.656388271e-08f, 2.087137041e-08f, 2.764489970e-08f, 3.027478712e-09f, 1.725054766e-08f, 2.529881304e-10f, 4.738785808e-09f, 7.990752948e-09f, 1.230677427e-08f, 1.184457421e-08f, 4.619374216e-09f, 4.890723382e-09f, 3.732278930e-09f, 4.399224540e-09f, 5.794353886e-09f};
__device__ __forceinline__ float lg2gamma(int h) { return h == 0 ? -0.04580368961312479f : h == 1 ? -0.02272007650008353f : h == 2 ? -0.011315313227834146f : -0.005646563141142063f; }

__device__ __forceinline__ float add_xor16(float v) { return v + __builtin_bit_cast(float, __builtin_amdgcn_ds_swizzle(__builtin_bit_cast(int, v), 0x401F)); }
__device__ __forceinline__ float add_xor32(float v) { float a_ = v, b_ = v; asm volatile("s_nop 1\n\tv_permlane32_swap_b32 %0, %1" : "+v"(a_), "+v"(b_)); return a_ + b_; }
namespace pg8 {
#ifndef BO_GRP
#define BO_GRP 8
#endif
struct BatchOrder {
    int nN, gsize, rank, nwg;
    __device__ __forceinline__ void init(int N, int gsize_, int rank_) { nN = N / BM; gsize = gsize_; rank = rank_; nwg = 16 * nN; }
    __device__ __forceinline__ bool next(int i, Unit& u) const {
        const int L = i * gsize + rank; if (L >= nwg) return false;
#if defined(BO_ORDER) && BO_ORDER == 1
        const int nb = nN >> 2;
        if (L < nb * 64) { const int q = L >> 6, r = L & 63, g = r >> 5, w = r & 31; u.pm = 8 * g + (w & 7); u.pn = 4 * q + (w >> 3); }
        else { const int Lt = L - nb * 64, rem = nN - 4 * nb, g = Lt / (8 * rem), w = Lt - g * 8 * rem; u.pm = 8 * g + (w & 7); u.pn = 4 * nb + (w >> 3); }
        return true;
#else
        const int grp = L / (BO_GRP * nN), r = L - grp * BO_GRP * nN; u.pm = BO_GRP * grp + (r % BO_GRP); u.pn = r / BO_GRP; return true;
#endif
    }
    __device__ __forceinline__ void a_ready(const Unit&) const {}
    __device__ __forceinline__ void done(const Unit&) const {}
};
__device__ __forceinline__ void load_rstd(const PG8_LAS float* side, int ui, int wr, int fr, float (&rs)[2][4]) {
#pragma unroll
    for (int ai = 0; ai < 2; ++ai)
#pragma unroll
        for (int m = 0; m < 4; ++m) rs[ai][m] = side[ui * 256 + ai * HALF + wr * 64 + m * 16 + fr];
}
template <class Sched> __device__ __forceinline__ void fill_rstd(const Sched& S, const float* ssq, PG8_LAS float* side, const int* pos, PG8_LAS float* posf, int tid) {
    Unit u;
    for (int i = 0; S.next(i, u); ++i) {
        const int row = u.pm * BM + (tid >> 1), hf = tid & 1;
        const f32x4 a = *(const f32x4*)(ssq + (size_t)row * 16 + 8 * hf), b = *(const f32x4*)(ssq + (size_t)row * 16 + 8 * hf + 4);
        float s = ((a[0] + a[1]) + (a[2] + a[3])) + ((b[0] + b[1]) + (b[2] + b[3]));
        s += __builtin_bit_cast(float, __builtin_amdgcn_ds_swizzle(__builtin_bit_cast(int, s), 0x041F));
        if (hf == 0) { side[i * 256 + (tid >> 1)] = rsqrtf(s * (1.0f / 1024.0f) + 1e-6f); if (pos) posf[i * 256 + (tid >> 1)] = (float)pos[row]; }
    }
}
#ifndef WTM
#define WTM 0
#endif
template <int BIT> __device__ __forceinline__ void st16(void* p, const u32x4 v) {
    if constexpr ((WTM >> BIT) & 1) asm volatile("global_store_dwordx4 %0, %1, off sc1\n\ts_nop 0" :: "v"(p), "v"(v) : "memory");
    else *(u32x4*)p = v;
}
__device__ __forceinline__ u32x4 pack8(const f32x4 a, const f32x4 b) { u32x4 w; w.x = cvt_pk_bf16(a[0], a[1]); w.y = cvt_pk_bf16(a[2], a[3]); w.z = cvt_pk_bf16(b[0], b[1]); w.w = cvt_pk_bf16(b[2], b[3]); return w; }

struct EpiInProj {
    static constexpr bool PERM = true, AFTER_DRAIN = false;
    const PG8_LAS float* side; const PG8_LAS float* posf; const PG8_LAS float* rope; bf16_t *q, *k, *v, *g, *uw;
    __device__ __forceinline__ void init(f32x4 (&acc)[2][2][4][2], const Unit&, int, int, int, int) const {
#pragma unroll
        for (int a = 0; a < 2; ++a)
#pragma unroll
            for (int b = 0; b < 2; ++b)
#pragma unroll
                for (int m = 0; m < 4; ++m)
#pragma unroll
                    for (int n = 0; n < 2; ++n) acc[a][b][m][n] = (f32x4){0.f, 0.f, 0.f, 0.f};
    }
    __device__ __forceinline__ void operator()(const f32x4 (&acc)[2][2][4][2], const Unit& u, int wr, int wc, int fr, int fq, int ui) const {
        const int rowbase = u.pm * BM + wr * 64 + fr;
        float rs[2][4]; load_rstd(side, ui, wr, fr, rs);
        if (u.pn < 4) {
            const int sec = u.pn >> 1, head = 2 * (u.pn & 1) + (wc >> 1), dd0 = 32 * (wc & 1) + 8 * fq;
            bf16_t* dst = sec ? k : q;
            const f32x4 h0 = *(const PG8_LAS f32x4*)(rope + dd0), h1 = *(const PG8_LAS f32x4*)(rope + dd0 + 4), l0 = *(const PG8_LAS f32x4*)(rope + 64 + dd0), l1 = *(const PG8_LAS f32x4*)(rope + 64 + dd0 + 4);
            const float lg = lg2gamma(head);
#pragma unroll
            for (int ai = 0; ai < 2; ++ai)
#pragma unroll
                for (int m = 0; m < 4; ++m) {
                    const int row = rowbase + ai * HALF + m * 16, b = row >> 12, s = row & 4095;
                    const float p = posf[ui * 256 + ai * HALF + wr * 64 + m * 16 + fr];
                    const float sc = rs[ai][m] * (sec ? __builtin_amdgcn_exp2f((float)(127 - (s & 127)) * lg) : 1.0f);
                    f32x4 o1[2], o2[2];
#pragma unroll
                    for (int n = 0; n < 2; ++n) { const f32x4 fh = n ? h1 : h0, fl = n ? l1 : l0;
#pragma unroll
                        for (int j = 0; j < 4; ++j) { const float ph = p * fh[j]; const float rev = (ph - __builtin_floorf(ph)) + p * fl[j];
                            const float cs = __builtin_amdgcn_cosf(rev), sn = __builtin_amdgcn_sinf(rev);
                            const float x1 = acc[ai][0][m][n][j] * sc, x2 = acc[ai][1][m][n][j] * sc;
                            o1[n][j] = x1 * cs - x2 * sn; o2[n][j] = x2 * cs + x1 * sn; } }
                    bf16_t* rp = dst + ((size_t)((b * NH_ + head) * SEQ_ + s)) * 128 + dd0;
                    st16<0>(rp, pack8(o1[0], o1[1])); st16<0>((rp + 64), pack8(o2[0], o2[1]));
                    asm volatile("" ::: "memory");
                }
        } else {
            const int sec = (u.pn - 4) >> 1;
            const int c0 = 256 * (u.pn & 1) + 32 * wc + 8 * fq;
#pragma unroll
            for (int ai = 0; ai < 2; ++ai)
#pragma unroll
                for (int m = 0; m < 4; ++m) {
                    const int row = rowbase + ai * HALF + m * 16, b = row >> 12, s = row & 4095; const float sc = rs[ai][m];
#pragma unroll
                    for (int bj = 0; bj < 2; ++bj) { const u32x4 w = pack8(acc[ai][bj][m][0] * sc, acc[ai][bj][m][1] * sc); const int c = c0 + 128 * bj;
                        if (sec == 2) st16<0>((uw + (size_t)row * 512 + c), w);
                        else { bf16_t* dst = sec ? g : v; st16<0>((dst + ((size_t)((b * NH_ + (c >> 7)) * SEQ_ + s)) * 128 + (c & 127)), w); } }
                }
        }
    }
    static constexpr int NH_ = 4, SEQ_ = 4096;
};

__device__ __forceinline__ void unpack8(const u32x4 w, f32x4& a, f32x4& b) {
    a[0] = __builtin_bit_cast(float, w.x << 16); a[1] = __builtin_bit_cast(float, w.x & 0xffff0000u); a[2] = __builtin_bit_cast(float, w.y << 16); a[3] = __builtin_bit_cast(float, w.y & 0xffff0000u);
    b[0] = __builtin_bit_cast(float, w.z << 16); b[1] = __builtin_bit_cast(float, w.z & 0xffff0000u); b[2] = __builtin_bit_cast(float, w.w << 16); b[3] = __builtin_bit_cast(float, w.w & 0xffff0000u);
}
struct EpiResid {
    static constexpr bool PERM = true, AFTER_DRAIN = false;
    const bf16_t* xin; bf16_t* xout; float* ssq_out;
    __device__ __forceinline__ void init(f32x4 (&acc)[2][2][4][2], const Unit& u, int wr, int wc, int fr, int fq) const {
        const int rowbase = u.pm * BM + wr * 64 + fr, col0 = u.pn * BM + 32 * wc + 8 * fq;
        u32x4 w[2][4][2];
#pragma unroll
        for (int ai = 0; ai < 2; ++ai)
#pragma unroll
            for (int m = 0; m < 4; ++m)
#pragma unroll
                for (int bj = 0; bj < 2; ++bj) w[ai][m][bj] = *(const u32x4*)(xin + (size_t)(rowbase + ai * HALF + m * 16) * 1024 + col0 + bj * HALF);
#pragma unroll
        for (int ai = 0; ai < 2; ++ai)
#pragma unroll
            for (int m = 0; m < 4; ++m)
#pragma unroll
                for (int bj = 0; bj < 2; ++bj) unpack8(w[ai][m][bj], acc[ai][bj][m][0], acc[ai][bj][m][1]);
    }
    __device__ __forceinline__ void operator()(const f32x4 (&acc)[2][2][4][2], const Unit& u, int wr, int wc, int fr, int fq, int) const {
        const int rowbase = u.pm * BM + wr * 64 + fr, col0 = u.pn * BM + 32 * wc + 8 * fq;
#pragma unroll
        for (int ai = 0; ai < 2; ++ai)
#pragma unroll
            for (int m = 0; m < 4; ++m) {
                const int row = rowbase + ai * HALF + m * 16; const size_t off = (size_t)row * 1024 + col0; float ss = 0.f;
#pragma unroll
                for (int bj = 0; bj < 2; ++bj) {
                    const f32x4 v0 = acc[ai][bj][m][0], v1 = acc[ai][bj][m][1];
                    st16<1>((xout + off + bj * HALF), pack8(v0, v1));
                    ss += (v0[0] * v0[0] + v0[1] * v0[1]) + (v0[2] * v0[2] + v0[3] * v0[3]) + (v1[0] * v1[0] + v1[1] * v1[1]) + (v1[2] * v1[2] + v1[3] * v1[3]); }
                ss = add_xor32(add_xor16(ss));
                if (fq == 0) ssq_out[(size_t)row * 16 + u.pn * 4 + wc] = ss;
            }
    }
};

struct EpiSwiGLU {
    static constexpr bool PERM = true, AFTER_DRAIN = false;
    const PG8_LAS float* side; bf16_t* h;
    __device__ __forceinline__ void init(f32x4 (&acc)[2][2][4][2], const Unit&, int, int, int, int) const {
#pragma unroll
        for (int a = 0; a < 2; ++a)
#pragma unroll
            for (int b = 0; b < 2; ++b)
#pragma unroll
                for (int m = 0; m < 4; ++m)
#pragma unroll
                    for (int n = 0; n < 2; ++n) acc[a][b][m][n] = (f32x4){0.f, 0.f, 0.f, 0.f};
    }
    __device__ __forceinline__ void operator()(const f32x4 (&acc)[2][2][4][2], const Unit& u, int wr, int wc, int fr, int fq, int ui) const {
        const int rowbase = u.pm * BM + wr * 64 + fr, col0 = u.pn * HALF + 32 * wc + 8 * fq;
        float rs[2][4]; load_rstd(side, ui, wr, fr, rs);
#pragma unroll
        for (int ai = 0; ai < 2; ++ai)
#pragma unroll
            for (int m = 0; m < 4; ++m) { const float sc = rs[ai][m], c1 = -1.4426950408889634f * sc, sc2 = sc * sc; f32x4 o[2];
#pragma unroll
                for (int n = 0; n < 2; ++n)
#pragma unroll
                    for (int jp = 0; jp < 2; ++jp) { const f32x2_t av = {acc[ai][0][m][n][2 * jp], acc[ai][0][m][n][2 * jp + 1]}, bv = {acc[ai][1][m][n][2 * jp], acc[ai][1][m][n][2 * jp + 1]};
                        const f32x2_t t = av * c1; f32x2_t ex; ex.x = __builtin_amdgcn_exp2f(t.x); ex.y = __builtin_amdgcn_exp2f(t.y);
                        const f32x2_t d = ex + 1.0f; f32x2_t r; r.x = __builtin_amdgcn_rcpf(d.x); r.y = __builtin_amdgcn_rcpf(d.y);
                        const f32x2_t ov = (av * bv) * (r * sc2); o[n][2 * jp] = ov.x; o[n][2 * jp + 1] = ov.y; }
                st16<2>((h + (size_t)(rowbase + ai * HALF + m * 16) * 2816 + col0), pack8(o[0], o[1])); }
    }
};

struct EpiPlain {
    static constexpr bool PERM = true, AFTER_DRAIN = false;
    bf16_t* O; int ldc;
    __device__ __forceinline__ void init(f32x4 (&acc)[2][2][4][2], const Unit&, int, int, int, int) const {
#pragma unroll
        for (int a = 0; a < 2; ++a)
#pragma unroll
            for (int b = 0; b < 2; ++b)
#pragma unroll
                for (int m = 0; m < 4; ++m)
#pragma unroll
                    for (int n = 0; n < 2; ++n) acc[a][b][m][n] = (f32x4){0.f, 0.f, 0.f, 0.f};
    }
    __device__ __forceinline__ void operator()(const f32x4 (&acc)[2][2][4][2], const Unit& u, int wr, int wc, int fr, int fq, int) const {
        const int rowbase = u.pm * BM + wr * 64 + fr, col0 = u.pn * BM + 32 * wc + 8 * fq;
#pragma unroll
        for (int ai = 0; ai < 2; ++ai)
#pragma unroll
            for (int m = 0; m < 4; ++m)
#pragma unroll
                for (int bj = 0; bj < 2; ++bj) st16<3>((O + (size_t)(rowbase + ai * HALF + m * 16) * ldc + col0 + bj * HALF), pack8(acc[ai][bj][m][0], acc[ai][bj][m][1]));
    }
};

struct EpiPle {
    static constexpr bool PERM = true, AFTER_DRAIN = false;
    const PG8_LAS float* side; const bf16_t* e; const bf16_t* xin; bf16_t* xout; float* ssq_out;
    __device__ __forceinline__ void init(f32x4 (&acc)[2][2][4][2], const Unit&, int, int, int, int) const {
#pragma unroll
        for (int a = 0; a < 2; ++a)
#pragma unroll
            for (int b = 0; b < 2; ++b)
#pragma unroll
                for (int m = 0; m < 4; ++m)
#pragma unroll
                    for (int n = 0; n < 2; ++n) acc[a][b][m][n] = (f32x4){0.f, 0.f, 0.f, 0.f};
    }
    __device__ __forceinline__ void operator()(const f32x4 (&acc)[2][2][4][2], const Unit& u, int wr, int wc, int fr, int fq, int ui) const {
        const int rowbase = u.pm * BM + wr * 64 + fr, col0 = u.pn * BM + 32 * wc + 8 * fq;
        float rs[2][4]; load_rstd(side, ui, wr, fr, rs);
#pragma unroll
        for (int ai = 0; ai < 2; ++ai)
#pragma unroll
            for (int m = 0; m < 4; ++m) {
                const int row = rowbase + ai * HALF + m * 16; const size_t off = (size_t)row * 1024 + col0; float ss = 0.f; const float sc = -1.4426950408889634f * rs[ai][m];
#pragma unroll
                for (int bj = 0; bj < 2; ++bj) {
                    f32x4 e0, e1, x0, x1; unpack8(*(const u32x4*)(e + off + bj * HALF), e0, e1); unpack8(*(const u32x4*)(xin + off + bj * HALF), x0, x1);
                    f32x4 v0, v1;
#pragma unroll
                    for (int j = 0; j < 4; ++j) {
                        v0[j] = x0[j] + __builtin_amdgcn_rcpf(1.0f + __builtin_amdgcn_exp2f(sc * acc[ai][bj][m][0][j])) * e0[j];
                        v1[j] = x1[j] + __builtin_amdgcn_rcpf(1.0f + __builtin_amdgcn_exp2f(sc * acc[ai][bj][m][1][j])) * e1[j]; }
                    st16<4>((xout + off + bj * HALF), pack8(v0, v1));
                    ss += (v0[0] * v0[0] + v0[1] * v0[1]) + (v0[2] * v0[2] + v0[3] * v0[3]) + (v1[0] * v1[0] + v1[1] * v1[1]) + (v1[2] * v1[2] + v1[3] * v1[3]); }
                ss = add_xor32(add_xor16(ss));
                if (fq == 0) ssq_out[(size_t)row * 16 + u.pn * 4 + wc] = ss;
            }
    }
};
}
#define XB_TMO      128
#define XB_XCNT(j)  (256  + 64 * (j))
#define XB_XSUB(j)  (1280 + 64 * (j))
#define XB_XGEN(j)  (2304 + 64 * (j))
#define XB_TOP      3328
#define XB_TOPGEN   3392
#define XCD_BAR_WORDS 3456
#define XB_SPIN_CAP (1u << 18)

__device__ __forceinline__ unsigned xb_ld(unsigned* p)              { return __hip_atomic_load(p, __ATOMIC_RELAXED, __HIP_MEMORY_SCOPE_AGENT); }
__device__ __forceinline__ unsigned xb_add(unsigned* p, unsigned v) { return __hip_atomic_fetch_add(p, v, __ATOMIC_RELAXED, __HIP_MEMORY_SCOPE_AGENT); }
__device__ __forceinline__ unsigned xb_xcc_id() { return (unsigned)__builtin_amdgcn_s_getreg((3 << 11) | 20) & 0xFu; }
#define XB_SPIN(cond, bar) do { unsigned _sp = 0; while (cond) { __builtin_amdgcn_s_sleep(1); \
    if ((++_sp & 255u) == 0u) { if (xb_ld(&(bar)[XB_TMO])) break; if (_sp > XB_SPIN_CAP) { atomicAdd(&(bar)[XB_TMO], 1u); break; } } } } while (0)

struct XcdBarrier {
    unsigned* bar; unsigned x;
    volatile LAS unsigned* st;
};

__device__ __forceinline__ XcdBarrier xcd_barrier_post(unsigned* bar, volatile LAS unsigned* st) {
    XcdBarrier b; b.bar = bar; b.x = xb_xcc_id(); b.st = st;
    if (threadIdx.x == 0) st[2] = xb_add(&bar[XB_XCNT(b.x)], 1u);
    return b;
}
__device__ __forceinline__ void xcd_barrier_complete(unsigned* bar, unsigned x, unsigned& nloc, unsigned& nx) {
    const unsigned G = gridDim.x * gridDim.y * gridDim.z;
    unsigned sum, cnt, mine, sp = 0u;
    for (;;) {
        sum = 0u; cnt = 0u; mine = 0u;
#pragma unroll
        for (unsigned j = 0; j < 16; ++j) { const unsigned c = xb_ld(&bar[XB_XCNT(j)]); sum += c; cnt += (c > 0u) ? 1u : 0u; mine = (j == x) ? c : mine; }
        if (sum == G) break;
        __builtin_amdgcn_s_sleep(1);
        if ((++sp & 255u) == 0u) { if (xb_ld(&bar[XB_TMO])) break; if (sp > XB_SPIN_CAP) { atomicAdd(&bar[XB_TMO], 1u); break; } }
    }
    nloc = mine > 0u ? mine : 1u; nx = cnt > 0u ? cnt : 1u;
}

__device__ __forceinline__ void xcd_barrier(const XcdBarrier& b) {
    asm volatile("s_waitcnt vmcnt(0)" ::: "memory");
    __syncthreads();
    if (threadIdx.x == 0) {
        unsigned* bar = b.bar; unsigned bx_ = b.x; asm volatile("" : "+s"(bar), "+s"(bx_));
        __builtin_amdgcn_s_waitcnt(0);
        unsigned nloc = b.st[0], nx = b.st[1];
        if (nloc == 0u) { xcd_barrier_complete(bar, bx_, nloc, nx); b.st[0] = nloc; b.st[1] = nx; }
        const unsigned old = xb_add(&bar[XB_XSUB(bx_)], 1u);
        const unsigned gen = old / nloc;
        if (old + 1u == (gen + 1u) * nloc) {
            __builtin_amdgcn_fence(__ATOMIC_RELEASE, "agent");
            asm volatile("s_waitcnt vmcnt(0)" ::: "memory");
            const unsigned og = xb_add(&bar[XB_TOP], 1u);
            const unsigned tg = og / nx;
            if (og + 1u == (tg + 1u) * nx) xb_add(&bar[XB_TOPGEN], 1u);
            else XB_SPIN(xb_ld(&bar[XB_TOPGEN]) == tg, bar);
            __builtin_amdgcn_fence(__ATOMIC_ACQUIRE, "agent");
            xb_add(&bar[XB_XGEN(bx_)], 1u);
            asm volatile("s_waitcnt vmcnt(0)" ::: "memory");
        } else {
            XB_SPIN(xb_ld(&bar[XB_XGEN(bx_)]) == gen, bar);
            __builtin_amdgcn_fence(__ATOMIC_ACQUIRE, "agent");
            asm volatile("s_waitcnt vmcnt(0)" ::: "memory");
        }
    }
    __syncthreads();
}

#define XB_LSUB(j)  (3456 + 64 * (j))
#define XB_LGEN(j)  (3456 + 1024 + 64 * (j))
#define XB_TICKET   (3456 + 2048)
__device__ __forceinline__ void xcd_local_barrier(const XcdBarrier& b) {
    asm volatile("s_waitcnt vmcnt(0)" ::: "memory");
    __syncthreads();
    if (threadIdx.x == 0) {
        unsigned* bar = b.bar; unsigned bx_ = b.x; asm volatile("" : "+s"(bar), "+s"(bx_));
        const unsigned nloc = b.st[0];
        const unsigned old = xb_add(&bar[XB_LSUB(bx_)], 1u);
        const unsigned gen = old / nloc;
        if (old + 1u == (gen + 1u) * nloc) xb_add(&bar[XB_LGEN(bx_)], 1u);
        else XB_SPIN(xb_ld(&bar[XB_LGEN(bx_)]) == gen, bar);
        __builtin_amdgcn_fence(__ATOMIC_ACQUIRE, "agent");
        asm volatile("s_waitcnt vmcnt(0)" ::: "memory");
    }
    __syncthreads();
}

#define XB_TEAM(x, c) (8192 + 512 * (x) + 64 * (c))
#define XB_HFREE(x)   (16384 + 64 * (x))
__device__ __forceinline__ void xcd_team_barrier(const XcdBarrier& b, unsigned team) {
    asm volatile("s_waitcnt vmcnt(0)" ::: "memory");
    __syncthreads();
    if (threadIdx.x == 0) {
        unsigned* bar = b.bar; unsigned bx_ = b.x; asm volatile("" : "+s"(bar), "+s"(bx_));
        unsigned* w = &bar[XB_TEAM(bx_, team)];
        const unsigned target = (xb_add(w, 1u) / 4u + 1u) * 4u;
        XB_SPIN(xb_ld(w) < target, bar);
        __builtin_amdgcn_fence(__ATOMIC_ACQUIRE, "agent");
        asm volatile("s_waitcnt vmcnt(0)" ::: "memory");
    }
    __syncthreads();
}
#define XB_P4DONE(x)  (17408 + 64 * (x))
__device__ __forceinline__ void xcd_cnt_arrive(const XcdBarrier& b, unsigned word0) {
    if (threadIdx.x == 0) { unsigned* bar = b.bar; unsigned bx_ = b.x; asm volatile("" : "+s"(bar), "+s"(bx_)); xb_add(&bar[word0 + 64u * bx_], 1u); }
}
__device__ __forceinline__ void xcd_cnt_wait(const XcdBarrier& b, unsigned word0, unsigned target) {
    if (threadIdx.x == 0) { unsigned* bar = b.bar; unsigned bx_ = b.x; asm volatile("" : "+s"(bar), "+s"(bx_)); XB_SPIN(xb_ld(&bar[word0 + 64u * bx_]) < target, bar); }
    __syncthreads();
}

__device__ __forceinline__ float wave_sum(float v) {
    v += __builtin_bit_cast(float, __builtin_amdgcn_ds_swizzle(__builtin_bit_cast(int, v), 0x041F));
    v += __builtin_bit_cast(float, __builtin_amdgcn_ds_swizzle(__builtin_bit_cast(int, v), 0x081F));
    v += __builtin_bit_cast(float, __builtin_amdgcn_ds_swizzle(__builtin_bit_cast(int, v), 0x101F));
    v += __builtin_bit_cast(float, __builtin_amdgcn_ds_swizzle(__builtin_bit_cast(int, v), 0x201F));
    return add_xor32(add_xor16(v));
}
__device__ __forceinline__ unsigned off_b(unsigned row, unsigned ch) { return 256u * row + 16u * (ch ^ (((row & 3u) << 2) | ((row >> 2) & 3u))); }
__device__ __forceinline__ unsigned tr_addr_nat(unsigned lane, unsigned c, unsigned ks, unsigned t) {
    const unsigned h = lane >> 5, blk = (lane >> 4) & 1u, q = (lane & 15u) >> 2, p = lane & 3u;
    return off_b(16u * ks + 8u * h + 4u * t + q, 4u * c + 2u * blk + (p >> 1)) + 8u * (p & 1u);
}
__device__ __forceinline__ unsigned tr_addr_perm(unsigned lane, unsigned c, unsigned ks, unsigned t) {
    const unsigned h = lane >> 5, blk = (lane >> 4) & 1u, q = (lane & 15u) >> 2, p = lane & 3u;
    return off_b(16u * ks + 8u * t + 4u * h + q, 4u * c + 2u * blk + (p >> 1)) + 8u * (p & 1u);
}
__device__ __forceinline__ unsigned tr_addr16(unsigned lane, unsigned c, unsigned ks, unsigned t) {
    const unsigned g = lane >> 4, q = (lane & 15u) >> 2, p = lane & 3u;
    return off_b(32u * ks + 8u * g + 4u * t + q, 2u * c + (p >> 1)) + 8u * (p & 1u);
}
__device__ __forceinline__ void glds16(const void* gsrc, unsigned lds_dst) { unsigned keep;
    asm volatile("s_mov_b32 %0, m0\n\ts_mov_b32 m0, %2\n\ts_nop 0\n\tglobal_load_lds_dwordx4 %1, off\n\ts_mov_b32 m0, %0" : "=&s"(keep) : "v"(gsrc), "s"(lds_dst) : "memory"); }
typedef short v4i16_t __attribute__((ext_vector_type(4)));
__device__ __forceinline__ s16x4 tr_read(LAS unsigned char* p) { return __builtin_bit_cast(s16x4, __builtin_amdgcn_ds_read_tr16_b64_v4i16((LAS v4i16_t*)p)); }
__device__ __forceinline__ bf16x8 cat4(s16x4 a, s16x4 b) { return (bf16x8){a[0], a[1], a[2], a[3], b[0], b[1], b[2], b[3]}; }
__device__ __forceinline__ unsigned cvtpk(float lo, float hi) { return pg8::cvt_pk_bf16(lo, hi); }
__device__ __forceinline__ int crow(int r, int hi) { return (r & 3) + 8 * (r >> 2) + 4 * hi; }
__device__ __forceinline__ bf16x8 pack_acc(const f32x16& a, int s) {
    v4u w; w.x = cvtpk(a[8 * s + 0], a[8 * s + 1]); w.y = cvtpk(a[8 * s + 2], a[8 * s + 3]); w.z = cvtpk(a[8 * s + 4], a[8 * s + 5]); w.w = cvtpk(a[8 * s + 6], a[8 * s + 7]);
    return __builtin_bit_cast(bf16x8, w);
}

__device__ __forceinline__ void tr_item(const float* W, int ldw, int srccol0, int k0, const float* gain, float scal, bf16* WT, int K, int dstrow0, LAS float* scr, int lane) {
    float r[32], gv[32];
    const float* wp = W + (size_t)(k0 + (lane >> 5)) * ldw + srccol0 + (lane & 31);
#pragma unroll
    for (int i = 0; i < 32; ++i) r[i] = __builtin_nontemporal_load(wp + (size_t)(2 * i) * ldw);
    if (gain) {
#pragma unroll
        for (int i = 0; i < 32; ++i) gv[i] = gain[k0 + 2 * i + (lane >> 5)] * scal;
    } else {
#pragma unroll
        for (int i = 0; i < 32; ++i) gv[i] = scal;
    }
#pragma unroll
    for (int i = 0; i < 32; ++i) scr[(2 * i + (lane >> 5)) * 33 + (lane & 31)] = r[i] * gv[i];
    LDS_WAIT(); asm volatile("" ::: "memory");
    const int c = lane & 7;
#pragma unroll
    for (int j = 0; j < 4; ++j) { const int n = (lane >> 3) + 8 * j; const LAS float* s = scr + (8 * c) * 33 + n;
        v4u o; o.x = pk2(s[0 * 33], s[1 * 33]); o.y = pk2(s[2 * 33], s[3 * 33]); o.z = pk2(s[4 * 33], s[5 * 33]); o.w = pk2(s[6 * 33], s[7 * 33]);
        *(GAS v4u*)(WT + (size_t)(dstrow0 + n) * K + k0 + 8 * c) = o; }
    LDS_WAIT(); asm volatile("" ::: "memory");
}

struct Args { const float* x; const float* p; const int* pos; const float* g_mix; const float* w_in; const float* pool_w; const float* pool_scale; const float* w_out; const float* g_ffn;
              const float* w_gate; const float* w_up; const float* w_down; const float* g_ple; const float* w_ple_gate; const float* w_ple_proj; const float* g_final; float* out; unsigned char* ws; };

template <int W> __device__ __forceinline__ void pool_rows(const bf16* uw, bf16* mix, int b, int s0, int c0) {
    constexpr int NR = W - 1 + 16;
    v2u xr[NR];
#pragma unroll
    for (int i = 0; i < NR; ++i) { const int s = s0 - (W - 1) + i;
        xr[i] = (s >= 0) ? *(const GAS v2u*)(uw + (size_t)(b * SEQ + s) * 512 + c0) : (v2u){0u, 0u}; }
    float sum[4];
#pragma unroll
    for (int j = 0; j < 4; ++j) sum[j] = 0.f;
#pragma unroll
    for (int i = 0; i < W - 1; ++i)
#pragma unroll
        for (int j = 0; j < 2; ++j) { sum[2 * j] += bf_lo(xr[i][j]); sum[2 * j + 1] += bf_hi(xr[i][j]); }
#pragma unroll
    for (int i = 0; i < 16; ++i) {
        const int s = s0 + i; const float inv = 1.0f / (float)((s + 1 < W) ? (s + 1) : W);
        float o[4];
#pragma unroll
        for (int j = 0; j < 2; ++j) { const float a = bf_lo(xr[W - 1 + i][j]), c = bf_hi(xr[W - 1 + i][j]);
            sum[2 * j] += a; sum[2 * j + 1] += c; o[2 * j] = sum[2 * j] * inv - a; o[2 * j + 1] = sum[2 * j + 1] * inv - c;
            sum[2 * j] -= bf_lo(xr[i][j]); sum[2 * j + 1] -= bf_hi(xr[i][j]); }
        *(GAS v2u*)(mix + (size_t)(b * SEQ + s) * 1024 + 512 + c0) = (v2u){pk2(o[0], o[1]), pk2(o[2], o[3])};
    }
}

__global__ void __launch_bounds__(NWAVES * 64, 2) fwd(Args a_in) {
    extern __shared__ __attribute__((aligned(16))) unsigned char lds_raw[];
    LAS unsigned char* lds = (LAS unsigned char*)lds_raw;
    volatile LAS unsigned* MISC = (volatile LAS unsigned*)(lds + MISC_OFF);
    const int tid = threadIdx.x, lane = tid & 63, wave = __builtin_amdgcn_readfirstlane(tid >> 6);
    const int G = gridDim.x, bx = blockIdx.x;
    const int gw = bx * NWAVES + wave, NGW = G * NWAVES;
    typedef const __attribute__((address_space(4))) Args CArgs;
#define PHASE_ENVB(bi_) CArgs* ap_ = (CArgs*)__builtin_amdgcn_kernarg_segment_ptr(); asm volatile("" : "+s"(ap_)); CArgs& a = *ap_; \
    unsigned char* const ws = a.ws; float* const ssqA = (float*)(ws + WS_SSQA) + (size_t)(bi_) * SEQ * 16; float* const ssqB = (float*)(ws + WS_SSQB) + (size_t)(bi_) * SEQ * 16; \
    bf16* const xb = (bf16*)(ws + WS_XB) + (size_t)(bi_) * SEQ * D; bf16* const xb1 = (bf16*)(ws + WS_XB1) + (size_t)(bi_) * SEQ * D; bf16* const pb = (bf16*)(ws + WS_PB) + (size_t)(bi_) * SEQ * PLE; \
    unsigned char* const R = ws + WS_R + (size_t)(bi_) * R_BATCH; \
    bf16* const qb = (bf16*)(R + R_Q); bf16* const kb = (bf16*)(R + R_K); bf16* const vb = (bf16*)(R + R_V); bf16* const gb = (bf16*)(R + R_G); bf16* const uwb = (bf16*)(R + R_UW); \
    bf16* const kvb = (bf16*)(R + R_KV); bf16* const mix = (bf16*)(R + R_MIX); bf16* const hmid = (bf16*)(R + R_H); bf16* const eb = (bf16*)(R + R_E); float* const utmp = (float*)(ws + WS_R + R_UT); \
    (void)ssqA; (void)ssqB; (void)xb; (void)xb1; (void)pb; (void)qb; (void)kb; (void)vb; (void)gb; (void)uwb; (void)kvb; (void)mix; (void)hmid; (void)eb; (void)utmp
#define PHASE_ENV() PHASE_ENVB(batch)
    gu32* ctl = (gu32*)(a_in.ws + WS_CTL);
    for (int u = tid; u < (LDS_BYTES - LDSCTL_OFF) / 4; u += NWAVES * 64) ((LAS unsigned*)(lds + LDSCTL_OFF))[u] = 0u;
    __syncthreads();
    XcdBarrier bar = xcd_barrier_post((unsigned*)(ctl + CW_BAR), MISC + 8);

#ifndef PHMASK
#define PHMASK 0xFFFF
#endif
#define PH(n) ((PHMASK >> (n)) & 1)
#define FRESH_TID(name) int name = threadIdx.x; asm volatile("" : "+v"(name))
    if (PH(0)) { PHASE_ENVB(0);
    for (int task = gw; task < DEPTH * 4 * 2 * 128; task += NGW) {
        const int kb8 = task & 127, dh = (task >> 7) & 1, g = (task >> 8) & 3, L = task >> 10;
        const int d = dh * 64 + lane;
        const float* pw = a.pool_w + (size_t)((L * 4 + g) * 128) * 128 + d;
        typedef const __attribute__((address_space(4))) float CF;
        CF* wi = (CF*)(unsigned long long)(a.w_in + (size_t)(L * 1024 + kb8 * 8) * INW + 2048 + g * 128);
        float acc[8];
#pragma unroll
        for (int i = 0; i < 8; ++i) acc[i] = 0.f;
        float bv[128];
#pragma unroll
        for (int j = 0; j < 128; ++j) bv[j] = pw[(size_t)j * 128];
#pragma unroll
        for (int cb = 0; cb < 128; cb += 8) {
#pragma unroll
            for (int i = 0; i < 8; ++i)
#pragma unroll
                for (int j = 0; j < 8; ++j) acc[i] += wi[(size_t)i * INW + cb + j] * bv[cb + j];
            asm volatile("" ::: "memory");
        }
        const float sc = a.pool_scale[L * 512 + g * 128 + d];
#pragma unroll
        for (int i = 0; i < 8; ++i) utmp[(size_t)(L * 1024 + kb8 * 8 + i) * 512 + g * 128 + d] = acc[i] * sc;
    }
    }
    xcd_barrier(bar);
#ifndef NO_TEAMS
#define NO_TEAMS 0
#endif
#ifndef FORCE_FALLBACK
#define FORCE_FALLBACK 0
#endif
    if (threadIdx.x == 0) {
        unsigned* barw = (unsigned*)(ctl + CW_BAR);
        const unsigned nloc_ = MISC[8], nx_ = MISC[9], rk_ = MISC[10], myx_ = xb_xcc_id();
        unsigned mode_ = 0u, batch_ = 0u, rank_ = 0u, gsz_ = 1u;
        if (nx_ == 8u && !FORCE_FALLBACK) { mode_ = 1u; for (unsigned j = 0; j < 16; ++j) if (j < myx_ && xb_ld(&barw[XB_XCNT(j)]) > 0u) ++batch_; rank_ = rk_; gsz_ = nloc_; }
        else { const unsigned t_ = xb_add(&barw[XB_TICKET], 1u); batch_ = t_ % 8u; rank_ = t_ / 8u; gsz_ = (unsigned)G / 8u + ((batch_ < (unsigned)G % 8u) ? 1u : 0u); }
        MISC[11] = mode_; MISC[12] = batch_; MISC[13] = rank_; MISC[14] = gsz_;
    }
    __syncthreads();
    const int lmode = __builtin_amdgcn_readfirstlane((int)MISC[11]), batch = __builtin_amdgcn_readfirstlane((int)MISC[12]), rank = __builtin_amdgcn_readfirstlane((int)MISC[13]), gsz = __builtin_amdgcn_readfirstlane((int)MISC[14]);
#define LBAR() do { if (lmode) xcd_local_barrier(bar); else xcd_barrier(bar); } while (0)
    const bool tmode = lmode && gsz == 32 && !NO_TEAMS;
#define TBAR() do { if (tmode) xcd_team_barrier(bar, (unsigned)rank & 7u); else LBAR(); } while (0)
#define RET_UNIT(i_) (tmode ? ((i_) < 4 ? (rank >> 3) * 32 + 2 * ((rank & 7) + 8 * ((i_) >> 1)) + ((i_) & 1) : -1) : (rank + (i_) * gsz < NH * NCH ? rank + (i_) * gsz : -1))
#define POOL_ITEM(i_) (tmode ? ((i_) < 1 ? 2 * ((rank & 7) + 8 * (rank >> 4)) + ((rank >> 3) & 1) : -1) : (rank + (i_) * gsz < NCH ? rank + (i_) * gsz : -1))

    if (PH(1)) { PHASE_ENVB(0);
        LAS float* scr = (LAS float*)(lds + wave * 16384);
        constexpr int I_IN = 16 * 80, I_OUT = 16 * 32, I_GU = 16 * 176, I_DN = 44 * 32, I_PG = 16 * 32, I_PP = 4 * 32, I_L = I_IN + I_OUT + I_GU + I_DN + I_PG + I_PP;
        for (int it = gw; it < DEPTH * I_L; it += NGW) {
            const int L = it / I_L; int r = it % I_L;
            unsigned char* wl = ws + WS_W + (size_t)L * W_LAYER;
            if (r < I_IN) { const int kbk = r / 80, nb = r % 80, n0 = 32 * nb, k0 = 64 * kbk; const float* gn = a.g_mix + L * 1024;
                if (n0 < 1024) { const int sec = n0 >> 9, w = n0 & 511, t = w >> 8, bj = (w >> 7) & 1, hh = (w >> 6) & 1, dd0 = w & 63;
                    tr_item(a.w_in + (size_t)L * 1024 * INW, INW, sec * 512 + (2 * t + hh) * 128 + bj * 64 + dd0, k0, gn, sec == 0 ? 0.08838834764831845f : 1.0f, (bf16*)(wl + WO_IN), 1024, n0, scr, lane); }
                else if (n0 < 2048) tr_item(a.w_in + (size_t)L * 1024 * INW, INW, n0, k0, gn, 1.0f, (bf16*)(wl + WO_IN), 1024, n0, scr, lane);
                else tr_item(utmp + (size_t)L * 1024 * 512, 512, n0 - 2048, k0, gn, 1.0f, (bf16*)(wl + WO_IN), 1024, n0, scr, lane);
                continue; } r -= I_IN;
            if (r < I_OUT) { const int kbk = r / 32, nb = r % 32; tr_item(a.w_out + (size_t)L * 1024 * 1024, 1024, 32 * nb, 64 * kbk, nullptr, 1.0f, (bf16*)(wl + WO_OUT), 1024, 32 * nb, scr, lane); continue; } r -= I_OUT;
            if (r < I_GU) { const int kbk = r / 176, nb = r % 176, n0 = 32 * nb, t = n0 >> 8, bj = (n0 >> 7) & 1, j0 = n0 & 127;
                tr_item((bj ? a.w_up : a.w_gate) + (size_t)L * 1024 * FF, FF, 128 * t + j0, 64 * kbk, a.g_ffn + L * 1024, 1.0f, (bf16*)(wl + WO_GU), 1024, n0, scr, lane); continue; } r -= I_GU;
            if (r < I_DN) { const int kbk = r / 32, nb = r % 32; tr_item(a.w_down + (size_t)L * FF * 1024, 1024, 32 * nb, 64 * kbk, nullptr, 1.0f, (bf16*)(wl + WO_DOWN), FF, 32 * nb, scr, lane); continue; } r -= I_DN;
            if (r < I_PG) { const int kbk = r / 32, nb = r % 32; tr_item(a.w_ple_gate + (size_t)L * 1024 * 1024, 1024, 32 * nb, 64 * kbk, a.g_ple + L * 1024, 1.0f, (bf16*)(wl + WO_PG), 1024, 32 * nb, scr, lane); continue; } r -= I_PG;
            { const int kbk = r / 32, nb = r % 32; tr_item(a.w_ple_proj + (size_t)L * PLE * 1024, 1024, 32 * nb, 64 * kbk, nullptr, 1.0f, (bf16*)(wl + WO_PP), PLE, 32 * nb, scr, lane); }
        }
        for (int m = 2 * gw; m < M; m += 2 * NGW) {
            const GAS f32x4* xr = (const GAS f32x4*)(a.x + (size_t)m * D) + lane; GAS v2u* o8 = (GAS v2u*)(xb1 + (size_t)m * D) + lane;
            f32x4 v[8];
#pragma unroll
            for (int j = 0; j < 8; ++j) v[j] = __builtin_nontemporal_load(xr + 64 * j);
            float ss0 = 0.f, ss1 = 0.f;
#pragma unroll
            for (int j = 0; j < 4; ++j) { ss0 += (v[j][0] * v[j][0] + v[j][1] * v[j][1]) + (v[j][2] * v[j][2] + v[j][3] * v[j][3]); o8[64 * j] = (v2u){pk2(v[j][0], v[j][1]), pk2(v[j][2], v[j][3])}; }
#pragma unroll
            for (int j = 4; j < 8; ++j) { ss1 += (v[j][0] * v[j][0] + v[j][1] * v[j][1]) + (v[j][2] * v[j][2] + v[j][3] * v[j][3]); o8[64 * j] = (v2u){pk2(v[j][0], v[j][1]), pk2(v[j][2], v[j][3])}; }
            ss0 = wave_sum(ss0); ss1 = wave_sum(ss1);
            if (lane < 32) ssqB[(size_t)m * 16 + lane] = (lane == 0) ? ss0 : (lane == 16) ? ss1 : 0.f;
        }
        for (size_t i = (size_t)bx * 512 + tid; i < (size_t)M * PLE / 8; i += (size_t)G * 512) {
            const f32x4 v0 = ((const GAS f32x4*)a.p)[2 * i], v1 = ((const GAS f32x4*)a.p)[2 * i + 1];
            ((GAS v4u*)pb)[i] = (v4u){pk2(v0[0], v0[1]), pk2(v0[2], v0[3]), pk2(v1[0], v1[1]), pk2(v1[2], v1[3])};
        }
    }
    xcd_barrier(bar);

    for (int L = 0; L < DEPTH; ++L) {
        if (tmode && L > 0) xcd_cnt_wait(bar, XB_HFREE(0), (unsigned)(gsz * L));

#ifndef REP_P1
#define REP_P1 1
#endif
#pragma unroll 1
        for (int rep_ = 0; rep_ < REP_P1; ++rep_) {
        if (PH(2)) {
            PHASE_ENV(); const unsigned char* wl = ws + WS_W + (size_t)L * W_LAYER; (void)wl; FRESH_TID(ptid); pg8::Gemm g{xb1, (const bf16*)(wl + WO_IN), SEQ, INW, D}; pg8::BatchOrder S; S.init(INW, gsz, rank);
            PG8_LAS float* side = (PG8_LAS float*)(lds + SIDE_OFF); const int npu = (S.nwg + gsz - 1) / gsz;     PG8_LAS float* posf = side + npu * 256; PG8_LAS float* rope = posf + npu * 256;
            pg8::fill_rstd(S, ssqB, side, a.pos + batch * SEQ, posf, ptid); if (ptid < 64) { rope[ptid] = ROPE_HI[ptid]; rope[64 + ptid] = ROPE_LO[ptid]; } __syncthreads();
            pg8::EpiInProj E{side, posf, rope, qb, kb, vb, gb, uwb};
            pg8::gemm_phase<pg8::EpiInProj, pg8::BatchOrder, true, true>(lds, g, S, E, ptid);
        }
        TBAR();


        }
#ifndef REP_RET
#define REP_RET 1
#endif
#pragma unroll 1
        for (int rep_ = 0; rep_ < REP_RET; ++rep_) {
        if (PH(3)) { PHASE_ENV();
            FRESH_TID(t_); const int tid = t_, lane = t_ & 63, wave = __builtin_amdgcn_readfirstlane(t_ >> 6); (void)tid; (void)lane; (void)wave;
            {
                const unsigned ldsb = (unsigned)__builtin_amdgcn_readfirstlane((int)(unsigned)(size_t)lds);
                unsigned soff[4];
#pragma unroll
                for (int p = 0; p < 4; ++p) { const unsigned row = 4u * (unsigned)(wave * 4 + p) + ((unsigned)lane >> 4), pc = (unsigned)lane & 15u; soff[p] = 256u * row + 16u * (pc ^ (((row & 3u) << 2) | ((row >> 2) & 3u))); }
#define P2_DMA(u_, buf_) do { const char* ks_ = (const char*)(kb + (size_t)(u_) * 16384); const char* vs_ = (const char*)(vb + (size_t)(u_) * 16384); \
                    _Pragma("unroll") for (int p_ = 0; p_ < 4; ++p_) { glds16(ks_ + soff[p_], ldsb + (unsigned)((buf_) * 65536 + (wave * 4 + p_) * 1024)); \
                        glds16(vs_ + soff[p_], ldsb + (unsigned)((buf_) * 65536 + 32768 + (wave * 4 + p_) * 1024)); } } while (0)
                int buf = 0;
                if (RET_UNIT(0) >= 0) P2_DMA(RET_UNIT(0), 0);
                asm volatile("s_waitcnt vmcnt(0)" ::: "memory");
                for (int ui = 0; RET_UNIT(ui) >= 0; ++ui, buf ^= 1) {
                    const int u = RET_UNIT(ui), un = RET_UNIT(ui + 1);
                    asm volatile("s_waitcnt vmcnt(4)" ::: "memory"); __builtin_amdgcn_s_barrier(); asm volatile("" ::: "memory");
                    if (un >= 0) P2_DMA(un, buf ^ 1);
                    LAS unsigned char* kl = lds + buf * 65536; LAS unsigned char* vl2 = kl + 32768;
                    const int dt = wave >> 1, et0 = (wave & 1) * 2;
                    f32x16 acc0, acc1;
#pragma unroll
                    for (int r = 0; r < 16; ++r) { acc0[r] = 0.f; acc1[r] = 0.f; }
#pragma unroll
                    for (int ks = 0; ks < 8; ++ks) {
                        const bf16x8 A = cat4(tr_read(kl + tr_addr_nat(lane, dt, ks, 0)), tr_read(kl + tr_addr_nat(lane, dt, ks, 1)));
                        const bf16x8 B0 = cat4(tr_read(vl2 + tr_addr_nat(lane, et0, ks, 0)), tr_read(vl2 + tr_addr_nat(lane, et0, ks, 1)));
                        const bf16x8 B1 = cat4(tr_read(vl2 + tr_addr_nat(lane, et0 + 1, ks, 0)), tr_read(vl2 + tr_addr_nat(lane, et0 + 1, ks, 1)));
                        acc0 = __builtin_amdgcn_mfma_f32_32x32x16_bf16(A, B0, acc0, 0, 0, 0);
                        acc1 = __builtin_amdgcn_mfma_f32_32x32x16_bf16(A, B1, acc1, 0, 0, 0);
                    }
                    bf16* kvt = kvb + (size_t)u * 16384;
#pragma unroll
                    for (int s = 0; s < 2; ++s) {
                        *(GAS bf16x8*)(kvt + ((dt * 4 + et0) * 2 + s) * 512 + lane * 8) = pack_acc(acc0, s);
                        *(GAS bf16x8*)(kvt + ((dt * 4 + et0 + 1) * 2 + s) * 512 + lane * 8) = pack_acc(acc1, s);
                    }
                }
                asm volatile("s_waitcnt vmcnt(0)" ::: "memory"); __syncthreads();
#undef P2_DMA
            }
        }
        LBAR();


        if (PH(4)) { PHASE_ENV(); FRESH_TID(t_); const int tid = t_, lane = t_ & 63, wave = __builtin_amdgcn_readfirstlane(t_ >> 6); (void)tid; (void)lane; (void)wave;
        for (int c = rank * 512 + tid; c < NH * 4096; c += gsz * 512) {
            const int bh = c >> 12; const float cd = __builtin_amdgcn_exp2f(128.0f * lg2gamma(bh & 3));
            GAS v2u* base = (GAS v2u*)(kvb + (size_t)bh * NCH * 16384) + (c & 4095);
            v2u t[NCH];
#pragma unroll
            for (int n = 0; n < NCH; ++n) t[n] = base[(size_t)n * 4096];
            float r0 = 0.f, r1 = 0.f, r2 = 0.f, r3 = 0.f;
#pragma unroll
            for (int n = 0; n < NCH; ++n) {
                const v2u in = t[n];
                base[(size_t)n * 4096] = (v2u){pk2(r0, r1), pk2(r2, r3)};
                r0 = cd * (r0 + bf_lo(in[0])); r1 = cd * (r1 + bf_hi(in[0])); r2 = cd * (r2 + bf_lo(in[1])); r3 = cd * (r3 + bf_hi(in[1]));
            }
        }
            for (int pi = 0; POOL_ITEM(pi) >= 0; ++pi) { const int it = POOL_ITEM(pi);
                const int b = it >> 5, n = it & 31, gi = wave & 3, half = wave >> 2;
#pragma unroll 1
                for (int ps = 0; ps < 2; ++ps) {
                    const int s0 = n * 128 + half * 64 + ps * 32 + (lane >> 5) * 16, c0 = gi * 128 + (lane & 31) * 4;
                    if (gi == 0) pool_rows<2>(uwb, mix, b, s0, c0); else if (gi == 1) pool_rows<4>(uwb, mix, b, s0, c0); else if (gi == 2) pool_rows<8>(uwb, mix, b, s0, c0); else pool_rows<16>(uwb, mix, b, s0, c0);
                }
            }
            if (L > 0) {
                const GAS f32x4* ps = (const GAS f32x4*)(a.p + ((size_t)L * M + (size_t)batch * SEQ) * PLE);
                for (size_t i = (size_t)rank * 512 + tid; i < (size_t)SEQ * PLE / 8; i += (size_t)gsz * 512) {
                    const f32x4 v0 = ps[2 * i], v1 = ps[2 * i + 1];
                    ((GAS v4u*)pb)[i] = (v4u){pk2(v0[0], v0[1]), pk2(v0[2], v0[3]), pk2(v1[0], v1[1]), pk2(v1[2], v1[3])};
                }
            }
        }
        LBAR();

        if (PH(5)) { PHASE_ENV(); FRESH_TID(t_); const int tid = t_, lane = t_ & 63, wave = __builtin_amdgcn_readfirstlane(t_ >> 6);
        LAS float* red = (LAS float*)(lds + SIDE_OFF);
        const unsigned ldsb = (unsigned)__builtin_amdgcn_readfirstlane((int)(unsigned)(size_t)lds);
        unsigned soff[4];
#pragma unroll
        for (int p = 0; p < 4; ++p) { const unsigned row = 4u * (unsigned)(wave * 4 + p) + ((unsigned)lane >> 4), pc = (unsigned)lane & 15u; soff[p] = 256u * row + 16u * (pc ^ (((row & 3u) << 2) | ((row >> 2) & 3u))); }
        const int qt = (wave < 4) ? wave : 7 - wave, eh = wave >> 2;
        v4u sfr[16];
#define P4_TILE(src_, u_, reg_) do { const char* s_ = (const char*)((src_) + (size_t)(u_) * 16384); \
            _Pragma("unroll") for (int p_ = 0; p_ < 4; ++p_) glds16(s_ + soff[p_], ldsb + (unsigned)((reg_) * 32768 + (wave * 4 + p_) * 1024)); } while (0)
#define P4_SF(u_) do { const bf16* st_ = kvb + (size_t)(u_) * 16384 + lane * 8; \
            _Pragma("unroll") for (int k_ = 0; k_ < 16; ++k_) { const int ei_ = k_ >> 3, dt_ = (k_ >> 1) & 3, s_ = k_ & 1; \
                asm volatile("global_load_dwordx4 %0, %1, off" : "=v"(sfr[k_]) : "v"(st_ + ((dt_ * 4 + 2 * eh + ei_) * 2 + s_) * 512) : "memory"); } } while (0)
#define P4_WAIT_SF(n_) asm volatile("s_waitcnt vmcnt(" #n_ ")" : "+v"(sfr[0]), "+v"(sfr[1]), "+v"(sfr[2]), "+v"(sfr[3]), "+v"(sfr[4]), "+v"(sfr[5]), "+v"(sfr[6]), "+v"(sfr[7]), \
            "+v"(sfr[8]), "+v"(sfr[9]), "+v"(sfr[10]), "+v"(sfr[11]), "+v"(sfr[12]), "+v"(sfr[13]), "+v"(sfr[14]), "+v"(sfr[15]) :: "memory")
#define P4_BAR() do { asm volatile("s_waitcnt lgkmcnt(0)" ::: "memory"); __builtin_amdgcn_s_barrier(); asm volatile("" ::: "memory"); } while (0)
        { const int u0 = (RET_UNIT(0) >= 0) ? RET_UNIT(0) : NH * NCH - 1;
          P4_TILE(kb, u0, 0); P4_TILE(qb, u0, 2); P4_SF(u0); P4_TILE(vb, u0, 1); }
        P4_WAIT_SF(0);
        for (int ui = 0; RET_UNIT(ui) >= 0; ++ui) {
            const int u = RET_UNIT(ui), un = RET_UNIT(ui + 1);
            const int bh = u >> 5, n = u & 31, h = bh & 3, b = bh >> 2;
            const bool has_next = (un >= 0);
            P4_WAIT_SF(4); P4_BAR();
            P4_TILE(gb, u, 3);
            int ln = lane; asm volatile("" : "+v"(ln)); const int ql = ln & 31, hh = ln >> 5;
            LAS unsigned char* kzl = lds; LAS unsigned char* vl = lds + 32768; LAS unsigned char* qlds = lds + 65536; LAS unsigned char* glds = lds + 98304;
            bf16x8 qf[4][2];
            { const unsigned qrow = 32u * qt + (unsigned)ql;
#pragma unroll
              for (int dt = 0; dt < 4; ++dt)
#pragma unroll
                for (int s = 0; s < 2; ++s) { const v2u lo = *(const LAS v2u*)(qlds + off_b(qrow, 4 * dt + 2 * s) + 8 * hh), hi = *(const LAS v2u*)(qlds + off_b(qrow, 4 * dt + 2 * s + 1) + 8 * hh);
                    qf[dt][s] = __builtin_bit_cast(bf16x8, (v4u){lo[0], lo[1], hi[0], hi[1]}); } }
            bf16x8 pf[4][2];
#pragma unroll
            for (int kt = 0; kt < 4; ++kt) {
                if (kt <= qt) {
                    f32x16 sa;
#pragma unroll
                    for (int r = 0; r < 16; ++r) sa[r] = 0.f;
                    const unsigned krow = 32 * kt + ql;
#pragma unroll
                    for (int dt = 0; dt < 4; ++dt)
#pragma unroll
                        for (int s = 0; s < 2; ++s) {
                            const v2u lo = *(const LAS v2u*)(kzl + off_b(krow, 4 * dt + 2 * s) + 8 * hh), hi = *(const LAS v2u*)(kzl + off_b(krow, 4 * dt + 2 * s + 1) + 8 * hh);
                            sa = __builtin_amdgcn_mfma_f32_32x32x16_bf16(__builtin_bit_cast(bf16x8, (v4u){lo[0], lo[1], hi[0], hi[1]}), qf[dt][s], sa, 0, 0, 0); }
                    if (kt == qt) {
#pragma unroll
                        for (int r = 0; r < 16; ++r) sa[r] = (crow(r, hh) > ql) ? 0.f : sa[r];
                    }
                    pf[kt][0] = pack_acc(sa, 0); pf[kt][1] = pack_acc(sa, 1);
                } else { pf[kt][0] = (bf16x8){0, 0, 0, 0, 0, 0, 0, 0}; pf[kt][1] = (bf16x8){0, 0, 0, 0, 0, 0, 0, 0}; }
            }
            P4_BAR();
            if (has_next) { P4_TILE(kb, un, 0); P4_TILE(qb, un, 2); }
            f32x16 oacc[2]; int ln2 = lane; asm volatile("" : "+v"(ln2));
#pragma unroll
            for (int ei = 0; ei < 2; ++ei) {
                f32x16 o;
#pragma unroll
                for (int r = 0; r < 16; ++r) o[r] = 0.f;
#pragma unroll
                for (int dt = 0; dt < 4; ++dt)
#pragma unroll
                    for (int s = 0; s < 2; ++s) o = __builtin_amdgcn_mfma_f32_32x32x16_bf16(__builtin_bit_cast(bf16x8, sfr[ei * 8 + dt * 2 + s]), qf[dt][s], o, 0, 0, 0);
                oacc[ei] = o;
            }
#pragma unroll
            for (int ei = 0; ei < 2; ++ei) {
                const int et = 2 * eh + ei; f32x16 o = oacc[ei];
#pragma unroll
                for (int kt = 0; kt < 4; ++kt) {
                    if (kt <= qt) {
#pragma unroll
                        for (int s = 0; s < 2; ++s) {
                            const bf16x8 vf = cat4(tr_read(vl + tr_addr_perm(ln2, et, 2 * kt + s, 0)), tr_read(vl + tr_addr_perm(ln2, et, 2 * kt + s, 1)));
                            o = __builtin_amdgcn_mfma_f32_32x32x16_bf16(vf, pf[kt][s], o, 0, 0, 0); }
                    }
                }
                oacc[ei] = o;
            }
            const float rsc = __builtin_amdgcn_exp2f((float)(32 * qt + ql - 127) * lg2gamma(h));
            float ss = 0.f;
#pragma unroll
            for (int ei = 0; ei < 2; ++ei)
#pragma unroll
                for (int r = 0; r < 16; ++r) { const float y = oacc[ei][r] * rsc; oacc[ei][r] = y; ss += y * y; }
            ss = add_xor32(ss);
            if (hh == 0) red[eh * 128 + 32 * qt + ql] = ss;
            if (has_next) asm volatile("s_waitcnt vmcnt(8)" ::: "memory"); else asm volatile("s_waitcnt vmcnt(0)" ::: "memory");
            P4_BAR();
            if (has_next) { P4_SF(un); P4_TILE(vb, un, 1); }
            int ln3 = lane; asm volatile("" : "+v"(ln3)); const int ql3 = ln3 & 31, hh3 = ln3 >> 5;
            const float rn = rsqrtf((red[32 * qt + ql3] + red[128 + 32 * qt + ql3]) * (1.0f / 128.0f) + EPS);
            { const unsigned yrow = 32u * qt + (unsigned)ql3;
#pragma unroll
              for (int ei = 0; ei < 2; ++ei)
#pragma unroll
                for (int rg = 0; rg < 4; ++rg) {
                    const unsigned e0 = 32u * (2 * eh + ei) + 8u * rg + 4u * hh3, ch = e0 >> 3, sub = (e0 & 7u) * 2u;
                    const v2u gv = *(const LAS v2u*)(glds + off_b(yrow, ch) + sub);
                    float o[4];
#pragma unroll
                    for (int j = 0; j < 4; ++j) { const float gt = (j & 1) ? bf_hi(gv[j >> 1]) : bf_lo(gv[j >> 1]);
                        o[j] = gt * __builtin_amdgcn_rcpf(1.0f + __builtin_amdgcn_exp2f(-1.4426950408889634f * gt)) * (oacc[ei][4 * rg + j] * rn); }
                    *(LAS v2u*)(glds + off_b(yrow, ch) + sub) = (v2u){pk2(o[0], o[1]), pk2(o[2], o[3])};
                } }
            P4_BAR();
            { bf16* orow = mix + ((size_t)b * SEQ + n * 128) * 1024 + h * 128;
              int t4 = tid; asm volatile("" : "+v"(t4));
#pragma unroll
              for (int i = 0; i < 4; ++i) { const unsigned c = t4 + 512 * i, row = c >> 4, ch = c & 15; *(GAS v4u*)(orow + (size_t)row * 1024 + ch * 8) = *(const LAS v4u*)(glds + off_b(row, ch)); } }
        }
        asm volatile("s_waitcnt vmcnt(0)" ::: "memory"); __syncthreads();
#undef P4_TILE
#undef P4_SF
#undef P4_WAIT_SF
#undef P4_BAR
        }
        TBAR(); if (tmode) xcd_cnt_arrive(bar, XB_P4DONE(0));

        }
        if (PH(6)) {
            PHASE_ENV(); const unsigned char* wl = ws + WS_W + (size_t)L * W_LAYER; (void)wl; FRESH_TID(ptid); pg8::Gemm g{mix, (const bf16*)(wl + WO_OUT), SEQ, D, D}; pg8::BatchOrder S; S.init(D, gsz, rank);
            pg8::EpiResid E{xb1, xb, ssqA};
            pg8::gemm_phase<pg8::EpiResid, pg8::BatchOrder, true, true>(lds, g, S, E, ptid);
        }
        TBAR();


#ifndef REP_P6
#define REP_P6 1
#endif
#pragma unroll 1
        for (int rep_ = 0; rep_ < REP_P6; ++rep_) {
        if (tmode) xcd_cnt_wait(bar, XB_P4DONE(0), (unsigned)(gsz * (L + 1)));
        if (PH(7)) {
            PHASE_ENV(); const unsigned char* wl = ws + WS_W + (size_t)L * W_LAYER; (void)wl; FRESH_TID(ptid); pg8::Gemm g{xb, (const bf16*)(wl + WO_GU), SEQ, 2 * FF, D}; pg8::BatchOrder S; S.init(2 * FF, gsz, rank);
            PG8_LAS float* side = (PG8_LAS float*)(lds + SIDE_OFF); pg8::fill_rstd(S, ssqA, side, (const int*)nullptr, (PG8_LAS float*)nullptr, ptid); __syncthreads();
            pg8::EpiSwiGLU E{side, hmid};
            pg8::gemm_phase<pg8::EpiSwiGLU, pg8::BatchOrder, true, true>(lds, g, S, E, ptid);
        }
        TBAR();

        }
        if (PH(8)) {
            PHASE_ENV(); const unsigned char* wl = ws + WS_W + (size_t)L * W_LAYER; (void)wl; FRESH_TID(ptid); pg8::Gemm g{hmid, (const bf16*)(wl + WO_DOWN), SEQ, D, FF}; pg8::BatchOrder S; S.init(D, gsz, rank);
            pg8::EpiResid E{xb, xb, ssqA};
            pg8::gemm_phase<pg8::EpiResid, pg8::BatchOrder, true, true>(lds, g, S, E, ptid);
        }
#ifndef REP_PE
#define REP_PE 1
#endif
#pragma unroll 1
        for (int rep_ = 0; rep_ < REP_PE; ++rep_)
        if (PH(9)) {
            PHASE_ENV(); const unsigned char* wl = ws + WS_W + (size_t)L * W_LAYER; (void)wl; FRESH_TID(ptid); pg8::Gemm g{pb, (const bf16*)(wl + WO_PP), SEQ, D, PLE}; pg8::BatchOrder S; S.init(D, gsz, rank);
            pg8::EpiPlain E{eb, D};
            pg8::gemm_phase<pg8::EpiPlain, pg8::BatchOrder, true, true>(lds, g, S, E, ptid);
        }
        TBAR(); if (tmode) xcd_cnt_arrive(bar, XB_HFREE(0));

        if (PH(10)) {
            PHASE_ENV(); const unsigned char* wl = ws + WS_W + (size_t)L * W_LAYER; (void)wl; FRESH_TID(ptid); pg8::Gemm g{xb, (const bf16*)(wl + WO_PG), SEQ, D, D}; pg8::BatchOrder S; S.init(D, gsz, rank);
            PG8_LAS float* side = (PG8_LAS float*)(lds + SIDE_OFF); pg8::fill_rstd(S, ssqA, side, (const int*)nullptr, (PG8_LAS float*)nullptr, ptid); __syncthreads();
            pg8::EpiPle E{side, eb, xb, xb1, ssqB};
            pg8::gemm_phase<pg8::EpiPle, pg8::BatchOrder, true, true>(lds, g, S, E, ptid);
        }
        TBAR();
    }

    if (tmode) LBAR();
    if (PH(11)) { PHASE_ENV(); FRESH_TID(t_); const int lane = t_ & 63, gw = rank * NWAVES + __builtin_amdgcn_readfirstlane(t_ >> 6);
        const unsigned tmo = __hip_atomic_load((unsigned*)(ws + WS_CTL) + CW_BAR + XB_TMO, RLX_AGENT);
        for (int m = gw; m < SEQ; m += gsz * NWAVES) {
            float s = (lane < 16) ? ssqB[(size_t)m * 16 + lane] : 0.f; s = wave_sum(s);
            float rs = rsqrtf(s * (1.0f / 1024.0f) + EPS); if (tmo) rs = __builtin_nanf("");
#pragma unroll
            for (int j = 0; j < 2; ++j) { const v4u w = ((const GAS v4u*)(xb1 + (size_t)m * D))[lane + 64 * j]; const GAS f32x4* gp = (const GAS f32x4*)(a.g_final + (lane + 64 * j) * 8);
                f32x4 v0, v1; pg8::unpack8(w, v0, v1); GAS f32x4* op = (GAS f32x4*)(a.out + ((size_t)batch * SEQ + m) * D + (lane + 64 * j) * 8);
                op[0] = v0 * rs * gp[0]; op[1] = v1 * rs * gp[1]; }
        }
    }
}

extern "C" void kernel_launch(void* const* d_in, const int* in_sizes, int n_in, void* d_out, int out_size, void* d_ws, size_t ws_size, hipStream_t stream) {
    static int grid = 0;
    if (grid == 0) {
        if (n_in != 16 || in_sizes[0] != M * D || out_size != M * D || ws_size < WS_END) { fprintf(stderr, "kernel_launch: unexpected shapes (n_in %d, in0 %d, out %d, ws %zu < %zu)\n", n_in, n_in > 0 ? in_sizes[0] : -1, out_size, ws_size, (size_t)WS_END); grid = -1; return; }
        int dev = 0, cus = 0, per_cu = 0;
        if (hipGetDevice(&dev) != hipSuccess || hipDeviceGetAttribute(&cus, hipDeviceAttributeMultiprocessorCount, dev) != hipSuccess) { grid = -1; return; }
        if (hipFuncSetAttribute((const void*)fwd, hipFuncAttributeMaxDynamicSharedMemorySize, LDS_BYTES) != hipSuccess) { fprintf(stderr, "kernel_launch: hipFuncSetAttribute failed\n"); grid = -1; return; }
        if (hipOccupancyMaxActiveBlocksPerMultiprocessor(&per_cu, (const void*)fwd, NWAVES * 64, LDS_BYTES) != hipSuccess || per_cu < 1) fprintf(stderr, "kernel_launch: occupancy query reports %d\n", per_cu);
        (void)hipGetLastError();
        grid = cus;
    }
    if (grid < 0) return;
    if (hipMemsetAsync((char*)d_ws + WS_CTL, 0, CTL_ZERO_BYTES, stream) != hipSuccess) return;
    Args a{};
    a.x = (const float*)d_in[0]; a.p = (const float*)d_in[1]; a.pos = (const int*)d_in[2]; a.g_mix = (const float*)d_in[3]; a.w_in = (const float*)d_in[4]; a.pool_w = (const float*)d_in[5];
    a.pool_scale = (const float*)d_in[6]; a.w_out = (const float*)d_in[7]; a.g_ffn = (const float*)d_in[8]; a.w_gate = (const float*)d_in[9]; a.w_up = (const float*)d_in[10]; a.w_down = (const float*)d_in[11];
    a.g_ple = (const float*)d_in[12]; a.w_ple_gate = (const float*)d_in[13]; a.w_ple_proj = (const float*)d_in[14]; a.g_final = (const float*)d_in[15]; a.out = (float*)d_out; a.ws = (unsigned char*)d_ws;
    hipLaunchKernelGGL(fwd, dim3(grid), dim3(NWAVES * 64), LDS_BYTES, stream, a);
}
```
